# Optimizing an MI355X kernel written in HIP

```python
import jax, jax.numpy as jnp
from jax import lax
import numpy as np

D_MODEL = 2048
BATCH = 2
SEQ = 8192
DEPTH = 1

D_MIX = D_MODEL
RWKV_WIDTH = D_MIX // 2
SB_WIDTH = D_MIX - RWKV_WIDTH
HEAD_DIM = 64
RWKV_HEADS = RWKV_WIDTH // HEAD_DIM
SB_HEADS = SB_WIDTH // HEAD_DIM
DECAY_LORA = 64
ICLR_LORA = 64
PLE_DIM = 256
SB_BLOCK = 128
RMS_EPS = 1e-6
LNX_EPS = 64e-5
L2_EPS = 1e-12
SHIFT_WIDTH = 3 * RWKV_WIDTH + DECAY_LORA + ICLR_LORA
IN_WIDTH = SHIFT_WIDTH + RWKV_WIDTH + 4 * SB_WIDTH

kernel_name = "hymba_rwkv7_stickbreaking_layer"


def rms_norm(x, gain):
    xf = x.astype(jnp.float32)
    y = xf * lax.rsqrt(jnp.mean(xf * xf, axis=-1, keepdims=True) + RMS_EPS)
    return (y * gain.astype(jnp.float32)).astype(x.dtype)


def token_shift(u, mu):
    u_prev = jnp.pad(u, ((0, 0), (1, 0), (0, 0)))[:, :-1]
    return u + (u_prev - u) * mu


def split_heads(t):
    b, s, w = t.shape
    return t.reshape(b, s, w // HEAD_DIM, HEAD_DIM)


def rwkv7_scan(r, decay, k, v, kk, a):
    b, s, h, n = r.shape

    def step(state, inp):
        r_t, w_t, k_t, v_t, kk_t, a_t = inp
        sa = jnp.einsum('bhvk,bhk->bhv', state, kk_t)
        state = (state * w_t[:, :, None, :]
                 - sa[..., None] * (a_t * kk_t)[:, :, None, :]
                 + v_t[..., None] * k_t[:, :, None, :])
        y_t = jnp.einsum('bhvk,bhk->bhv', state, r_t)
        return state, y_t

    xs = (r.transpose(1, 0, 2, 3), decay.transpose(1, 0, 2, 3), k.transpose(1, 0, 2, 3),
          v.transpose(1, 0, 2, 3), kk.transpose(1, 0, 2, 3), a.transpose(1, 0, 2, 3))
    s0 = jnp.zeros((b, h, n, n), jnp.float32)
    _, y = lax.scan(step, s0, xs)
    return y.transpose(1, 0, 2, 3)


def rwkv7_time_mix(u_shift, g_lin, w0, w_up, a0, a_up, k_k, k_a, r_k, lnx_w, lnx_b):
    f32 = jnp.float32
    W = RWKV_WIDTH
    u = u_shift.astype(f32)
    r = u[..., :W]
    k = u[..., W:2 * W]
    v = u[..., 2 * W:3 * W]
    wd = u[..., 3 * W:3 * W + DECAY_LORA]
    ad = u[..., 3 * W + DECAY_LORA:]
    w_log = -jax.nn.softplus(-(w0.astype(f32) + jnp.tanh(wd) @ w_up.astype(f32))) - 0.5
    decay = jnp.exp(-jnp.exp(w_log))
    a = jax.nn.sigmoid(a0.astype(f32) + ad @ a_up.astype(f32))
    kk = split_heads(k * k_k.astype(f32))
    kk = kk * lax.rsqrt(jnp.sum(kk * kk, axis=-1, keepdims=True) + L2_EPS)
    k = k * (1.0 + (a - 1.0) * k_a.astype(f32))
    rh, kh, vh = split_heads(r), split_heads(k), split_heads(v)
    y = rwkv7_scan(rh, split_heads(decay), kh, vh, kk, split_heads(a))
    mean = jnp.mean(y, axis=-1, keepdims=True)
    var = jnp.mean(jnp.square(y - mean), axis=-1, keepdims=True)
    y = (y - mean) * lax.rsqrt(var + LNX_EPS)
    b, s = y.shape[:2]
    y = y.reshape(b, s, W) * lnx_w.astype(f32) + lnx_b.astype(f32)
    bonus = jnp.sum(rh * kh * split_heads(jnp.broadcast_to(r_k.astype(f32), r.shape)), axis=-1, keepdims=True) * vh
    y = y + bonus.reshape(b, s, W)
    return y * jax.nn.silu(g_lin.astype(f32))


def stick_breaking_attention(q, k, v):
    f32 = jnp.float32
    scale = HEAD_DIM ** -0.5
    qh = q.astype(f32).transpose(0, 2, 1, 3)
    kh = k.astype(f32).transpose(0, 2, 1, 3)
    vh = v.astype(f32).transpose(0, 2, 1, 3)
    s_len = qh.shape[2]
    outs = []
    for blk in range(s_len // SB_BLOCK):
        t0 = blk * SB_BLOCK
        end = t0 + SB_BLOCK
        qb = qh[:, :, t0:end]
        kb = kh[:, :, :end]
        vb = vh[:, :, :end]
        z = jnp.einsum('bhqd,bhkd->bhqk', qb, kb) * scale
        t_pos = t0 + jnp.arange(SB_BLOCK)[:, None]
        s_pos = jnp.arange(end)[None, :]
        strict = s_pos < t_pos
        log_beta = jax.nn.log_sigmoid(z)
        log_1mb = jnp.where(strict, jax.nn.log_sigmoid(-z), 0.0)
        suffix = lax.cumsum(log_1mb, axis=3, reverse=True) - log_1mb
        attn = jnp.where(strict, jnp.exp(log_beta + suffix), 0.0)
        outs.append(jnp.einsum('bhqk,bhkd->bhqd', attn, vb))
    o = jnp.concatenate(outs, axis=2)
    b = o.shape[0]
    return o.transpose(0, 2, 1, 3).reshape(b, s_len, SB_HEADS * HEAD_DIM)


def setup_inputs(seed: int = 0) -> dict:
    key = jax.random.key(seed)
    ks = jax.random.split(key, 20)
    f32 = jnp.float32
    nrm = lambda k, shape, s: jax.random.normal(k, shape, f32) * s
    return {
        "x": nrm(ks[0], (BATCH, SEQ, D_MODEL), 1.0),
        "p": nrm(ks[1], (DEPTH, BATCH, SEQ, PLE_DIM), 1.0),
        "g_pre": 1.0 + nrm(ks[2], (DEPTH, D_MODEL), 0.1),
        "w_in": nrm(ks[3], (DEPTH, D_MODEL, IN_WIDTH), D_MODEL ** -0.5),
        "mu_shift": jax.random.uniform(ks[4], (DEPTH, SHIFT_WIDTH), f32),
        "w0": jax.random.uniform(ks[5], (DEPTH, RWKV_WIDTH), f32, -4.0, 0.0),
        "w_up": nrm(ks[6], (DEPTH, DECAY_LORA, RWKV_WIDTH), 0.5 * DECAY_LORA ** -0.5),
        "a0": nrm(ks[7], (DEPTH, RWKV_WIDTH), 0.1),
        "a_up": nrm(ks[8], (DEPTH, ICLR_LORA, RWKV_WIDTH), 0.5 * ICLR_LORA ** -0.5),
        "k_k": 0.85 + nrm(ks[9], (DEPTH, RWKV_WIDTH), 0.05),
        "k_a": 1.0 + nrm(ks[10], (DEPTH, RWKV_WIDTH), 0.05),
        "r_k": nrm(ks[11], (DEPTH, RWKV_WIDTH), 0.1),
        "lnx_w": 1.0 + nrm(ks[12], (DEPTH, RWKV_WIDTH), 0.1),
        "lnx_b": nrm(ks[13], (DEPTH, RWKV_WIDTH), 0.02),
        "w_out": nrm(ks[14], (DEPTH, D_MIX, D_MODEL), D_MIX ** -0.5),
        "g_post": 1.0 + nrm(ks[15], (DEPTH, D_MODEL), 0.1),
        "w_ple": nrm(ks[16], (DEPTH, PLE_DIM, D_MODEL), PLE_DIM ** -0.5),
        "w_plg": nrm(ks[17], (DEPTH, D_MODEL, D_MODEL), D_MODEL ** -0.5),
        "g_ple": 1.0 + nrm(ks[18], (DEPTH, D_MODEL), 0.1),
    }


def reference(x, p, g_pre, w_in, mu_shift, w0, w_up, a0, a_up, k_k, k_a, r_k,
              lnx_w, lnx_b, w_out, g_post, w_ple, w_plg, g_ple):
    h = x
    for i in range(DEPTH):
        xn = rms_norm(h, g_pre[i])
        u = xn @ w_in[i]
        u_shift = token_shift(u[..., :SHIFT_WIDTH], mu_shift[i])
        o = SHIFT_WIDTH
        g_rwkv = u[..., o:o + RWKV_WIDTH]; o += RWKV_WIDTH
        q_sb = u[..., o:o + SB_WIDTH]; o += SB_WIDTH
        k_sb = u[..., o:o + SB_WIDTH]; o += SB_WIDTH
        v_sb = u[..., o:o + SB_WIDTH]; o += SB_WIDTH
        g_sb = u[..., o:o + SB_WIDTH]
        y_a = rwkv7_time_mix(u_shift, g_rwkv, w0[i], w_up[i], a0[i], a_up[i],
                             k_k[i], k_a[i], r_k[i], lnx_w[i], lnx_b[i])
        y_b = stick_breaking_attention(split_heads(q_sb), split_heads(k_sb), split_heads(v_sb))
        y_b = y_b * jax.nn.silu(g_sb.astype(jnp.float32))
        mix = jnp.concatenate([y_a, y_b], axis=-1).astype(h.dtype) @ w_out[i]
        h = h + rms_norm(mix, g_post[i])
        ple = rms_norm(p[i] @ w_ple[i], g_ple[i])
        h = h + ple * jax.nn.sigmoid(h @ w_plg[i])
    return h
```

```cpp
#include <hip/hip_runtime.h>
#include <cstdio>
#include <cstdint>
namespace pg8 {
#define PG8_LAS __attribute__((address_space(3)))
typedef unsigned short bf16_t;
typedef short bf16x8 __attribute__((ext_vector_type(8)));
typedef float f32x4 __attribute__((ext_vector_type(4)));
typedef unsigned u32x4 __attribute__((ext_vector_type(4)));
constexpr int BM = 256, BK = 64, HALF = 128, HTB = HALF * BK * 2  , STAGE_BYTES = 8 * HTB, NXCD = 8, WGM = 8;

__host__ __device__ __forceinline__ int lds_byte(int r, int c) { const int st = (r >> 4) * 2 + (c >> 5), rr = r & 15, cc = c & 31, ob = rr * 64 + cc * 2; return st * 1024 + (ob ^ (((ob >> 9) & 1) << 5)); }
__host__ __device__ __forceinline__ void stage_rc(int b, int& R, int& C) { const int st = b / 1024, sb = b % 1024, swz = sb ^ (((sb >> 9) & 1) << 5); R = (st >> 1) * 16 + swz / 64; C = (st & 1) * 32 + (swz % 64) / 2; }
__host__ __device__ __forceinline__ int perm32(int rho) { const int n = rho >> 4, i = rho & 15; return 8 * (i >> 2) + 4 * n + (i & 3); }

struct Unit { int pm, pn; };
struct Gemm { const bf16_t* A; const bf16_t* Bt; int M, N, K; };

struct StaticOrder {
    int nM, nN, nwg, G, c;
    __host__ __device__ void init(int M, int N, int G_, int c_) { nM = M / BM; nN = N / BM; nwg = nM * nN; G = G_; c = c_; }
    __host__ __device__ bool next(int i, Unit& u) const {
        const long L = (long)i * G + c; if (L >= nwg) return false;
        int wgid = (int)L; { const int q = nwg / NXCD, r = nwg % NXCD, xcd = wgid % NXCD, off = wgid / NXCD; wgid = (xcd < r ? xcd * (q + 1) : r * (q + 1) + (xcd - r) * q) + off; }
        const int nig = WGM * nN, gid = wgid / nig, fm = gid * WGM, gsz = (nM - fm) < WGM ? (nM - fm) : WGM;
        u.pm = fm + ((wgid % nig) % gsz); u.pn = (wgid % nig) / gsz; return true;
    }
    __device__ __forceinline__ void a_ready(const Unit&) const {}
    __device__ __forceinline__ void done(const Unit&) const {}
};

__device__ __forceinline__ unsigned cvt_pk_bf16(float lo, float hi) { unsigned r; asm volatile("v_cvt_pk_bf16_f32 %0, %1, %2" : "=v"(r) : "v"(lo), "v"(hi)); return r; }
typedef float f32x2 __attribute__((ext_vector_type(2)));
struct EpiF32 {
    static constexpr bool PERM = false, AFTER_DRAIN = false;
    float* C; int ldc;
    __device__ __forceinline__ void operator()(const f32x4 (&acc)[2][2][4][2], const Unit& u, int wr, int wc, int fr, int fq) const {
        const int row0 = u.pm * BM + wr * 64 + fr, col0 = u.pn * BM + wc * 32 + 4 * fq;
#pragma unroll
        for (int ai = 0; ai < 2; ++ai)
#pragma unroll
            for (int m = 0; m < 4; ++m) { float* rowp = C + (size_t)(row0 + ai * HALF + m * 16) * ldc + col0;
#pragma unroll
                for (int bj = 0; bj < 2; ++bj)
#pragma unroll
                    for (int n = 0; n < 2; ++n) *(f32x4*)(rowp + bj * HALF + n * 16) = acc[ai][bj][m][n]; }
    }
};
struct EpiIn {
    static constexpr bool PERM = true, AFTER_DRAIN = false;
    unsigned char* ws; size_t off_r, off_q, off_lora, off_vt;
    __device__ __forceinline__ void operator()(const f32x4 (&acc)[2][2][4][2], const Unit& u, int wr, int wc, int fr, int fq) const {
        bf16_t* base; int ldc, rowt, colt; float sc = 1.f;
        if (u.pn >= 64) { const int tile = u.pn - 64, grp = tile >> 2; rowt = u.pm * BM; colt = (tile & 3) * BM; ldc = 1024;
            size_t off;
            if (grp < 4) off = off_r + (size_t)grp * (32u << 20);
            else if (grp == 4) { off = off_q; sc = 0.125f; }
            else if (grp == 5) off = off_q + (32u << 20);
            else if (grp == 6) off = off_q + (96u << 20);
            else { off = off_lora; ldc = 256; colt = 0; }
            base = (bf16_t*)(ws + off);
        } else { base = (bf16_t*)(ws + off_vt); ldc = 16384; rowt = (u.pm - 93) * BM; colt = u.pn * BM; }
        const int row0 = rowt + wr * 64 + fr, col0 = colt + wc * 32 + 8 * fq;
#pragma unroll
        for (int ai = 0; ai < 2; ++ai)
#pragma unroll
            for (int m = 0; m < 4; ++m) { bf16_t* rowp = base + (size_t)(row0 + ai * HALF + m * 16) * ldc + col0;
#pragma unroll
                for (int bj = 0; bj < 2; ++bj) { f32x4 v0 = acc[ai][bj][m][0] * sc, v1 = acc[ai][bj][m][1] * sc;
                    u32x4 w; w.x = cvt_pk_bf16(v0[0], v0[1]); w.y = cvt_pk_bf16(v0[2], v0[3]); w.z = cvt_pk_bf16(v1[0], v1[1]); w.w = cvt_pk_bf16(v1[2], v1[3]);
                    *(u32x4*)(rowp + bj * HALF) = w; } }
    }
};
struct SchedIn {
    int G, c;
    __device__ __forceinline__ bool next(int i, Unit& u) const {
        const int L = i * G + c; if (L >= 2112) return false;
        if (L < 1856) { const int nwg = 1856, nM = 64, nN = 29; int wgid = L; { const int q = nwg / NXCD, r = nwg % NXCD, xcd = wgid % NXCD, off = wgid / NXCD; wgid = (xcd < r ? xcd * (q + 1) : r * (q + 1) + (xcd - r) * q) + off; }
            const int nig = WGM * nN, gid = wgid / nig, fm = gid * WGM, gsz = (nM - fm) < WGM ? (nM - fm) : WGM;
            u.pm = fm + ((wgid % nig) % gsz); u.pn = 64 + (wgid % nig) / gsz; }
        else { const int l2 = L - 1856; u.pm = 93 + (l2 & 3); u.pn = l2 >> 2; }
        return true;
    }
    __device__ __forceinline__ void a_ready(const Unit&) const {}
    __device__ __forceinline__ void done(const Unit&) const {}
};
struct EpiFinal {
    static constexpr bool PERM = false, AFTER_DRAIN = false;
    float* out; const bf16_t* ple; int ldc;
    __device__ __forceinline__ void operator()(const f32x4 (&acc)[2][2][4][2], const Unit& u, int wr, int wc, int fr, int fq) const {
        typedef unsigned u32x2v __attribute__((ext_vector_type(2)));
        const int row0 = u.pm * BM + wr * 64 + fr, col0 = u.pn * BM + wc * 32 + 4 * fq;
#pragma unroll
        for (int ai = 0; ai < 2; ++ai)
#pragma unroll
            for (int m = 0; m < 4; ++m) { const size_t ro = (size_t)(row0 + ai * HALF + m * 16) * ldc + col0;
#pragma unroll
                for (int bj = 0; bj < 2; ++bj)
#pragma unroll
                    for (int n = 0; n < 2; ++n) { const size_t o = ro + bj * HALF + n * 16; const f32x4 h = *(const f32x4*)(out + o); const u32x2v pw = *(const u32x2v*)(ple + o);
                        const f32x4 a = acc[ai][bj][m][n]; f32x4 pl; pl[0] = __uint_as_float(pw.x << 16); pl[1] = __uint_as_float(pw.x & 0xffff0000u); pl[2] = __uint_as_float(pw.y << 16); pl[3] = __uint_as_float(pw.y & 0xffff0000u);
                        f32x4 r;
#pragma unroll
                        for (int e = 0; e < 4; ++e) r[e] = h[e] + pl[e] * (1.0f / (1.0f + __expf(-a[e])));
                        *(f32x4*)(out + o) = r; } }
    }
};
template <class Epi, class Sched, bool ALIGN_EPI = false, bool SP2 = false>
__device__ __forceinline__ void gemm_phase(PG8_LAS unsigned char* lds, const Gemm g, const Sched& S, const Epi& E) {
    const int tid = threadIdx.x, wid = __builtin_amdgcn_readfirstlane(tid >> 6), lane = tid & 63, wr = wid >> 2, wc = wid & 3, fr = lane & 15, fq = lane >> 4;
    const int K = g.K, nt = K / BK;
    unsigned voffA[2], voffB[2];
#pragma unroll
    for (int i = 0; i < 2; ++i) { int R, C; stage_rc(tid * 16 + i * 8192, R, C); const int Rb = Epi::PERM ? ((R & ~31) + perm32(R & 31)) : R;
        voffA[i] = (unsigned)(R * K + C) * 2u; voffB[i] = (unsigned)(Rb * K + C) * 2u; }
    const size_t kstep = (size_t)(BK * 2);
    const size_t hstep = (size_t)HALF * K * 2;
    const size_t tstep = 2 * hstep;
    const unsigned ldsw = (unsigned)wid * 1024u;
    const int aoff = lds_byte(wr * 64 + fr, fq * 8), boff = lds_byte(wc * 32 + fr, fq * 8);
#define PG8_SA(b, h) (((b) * 2 + (h)) * HTB)
#define PG8_SB(b, h) ((4 + (b) * 2 + (h)) * HTB)
#define PG8_STAGE(bufoff, gbase, voff) do { _Pragma("unroll") for (int _i = 0; _i < 2; ++_i) \
        __builtin_amdgcn_global_load_lds((const unsigned*)((const char*)(gbase) + (voff)[_i]), (PG8_LAS unsigned*)(lds + (bufoff) + ldsw + _i * 8192), 16, 0, 0); } while (0)
#define PG8_LDA(dst, b, h) do { _Pragma("unroll") for (int m = 0; m < 4; ++m) _Pragma("unroll") for (int k = 0; k < 2; ++k) dst[m][k] = *(const PG8_LAS bf16x8*)(lds + PG8_SA(b, h) + aoff + m * 2048 + k * 1024); } while (0)
#define PG8_LDB(dst, b, h) do { _Pragma("unroll") for (int n = 0; n < 2; ++n) _Pragma("unroll") for (int k = 0; k < 2; ++k) dst[n][k] = *(const PG8_LAS bf16x8*)(lds + PG8_SB(b, h) + boff + n * 2048 + k * 1024); } while (0)
#define PG8_MMA(ai, bj, At, Bt) do { __builtin_amdgcn_s_setprio(1); _Pragma("unroll") for (int m = 0; m < 4; ++m) _Pragma("unroll") for (int n = 0; n < 2; ++n) _Pragma("unroll") for (int k = 0; k < 2; ++k) \
        acc[ai][bj][m][n] = __builtin_amdgcn_mfma_f32_16x16x32_bf16(Bt[n][k], At[m][k], acc[ai][bj][m][n], 0, 0, 0); __builtin_amdgcn_s_setprio(0); } while (0)
#define PG8_WAIT_V(n) asm volatile("s_waitcnt vmcnt(" #n ")" ::: "memory")
#define PG8_WAIT_L(n) asm volatile("s_waitcnt lgkmcnt(" #n ")" ::: "memory")
#define PG8_BAR __builtin_amdgcn_s_barrier()
#define PG8_SCHED __builtin_amdgcn_sched_barrier(0)
    Unit cur, nxt; int ui = 0;
    if (!S.next(0, cur)) return;
    f32x4 acc[2][2][4][2];
#pragma unroll
    for (int a = 0; a < 2; ++a)
#pragma unroll
        for (int b = 0; b < 2; ++b)
#pragma unroll
            for (int m = 0; m < 4; ++m)
#pragma unroll
                for (int n = 0; n < 2; ++n) acc[a][b][m][n] = (f32x4){0.f, 0.f, 0.f, 0.f};
    bf16x8 At[4][2], B0[2][2], B1[2][2];
    const char* cA = (const char*)g.A + (size_t)cur.pm * tstep; const char* cB = (const char*)g.Bt + (size_t)cur.pn * tstep;
    S.a_ready(cur);
    if constexpr (SP2) {
        PG8_STAGE(PG8_SB(0, 0), cB, voffB); PG8_STAGE(PG8_SB(0, 1), cB + hstep, voffB); PG8_STAGE(PG8_SA(0, 0), cA, voffA); PG8_STAGE(PG8_SA(0, 1), cA + hstep, voffA);
        if (wr == 1) PG8_BAR;
        PG8_WAIT_V(2); PG8_BAR;
        PG8_STAGE(PG8_SB(1, 0), cB + kstep, voffB); PG8_STAGE(PG8_SA(1, 0), cA + kstep, voffA); PG8_STAGE(PG8_SB(1, 1), cB + hstep + kstep, voffB);
        PG8_WAIT_V(6); PG8_BAR;
    } else {
        PG8_STAGE(PG8_SB(0, 0), cB, voffB); PG8_STAGE(PG8_SA(0, 0), cA, voffA); PG8_STAGE(PG8_SB(0, 1), cB + hstep, voffB); PG8_STAGE(PG8_SA(0, 1), cA + hstep, voffA);
        if (wr == 1) PG8_BAR;
        PG8_WAIT_V(4); PG8_BAR;
        PG8_STAGE(PG8_SB(1, 0), cB + kstep, voffB); PG8_STAGE(PG8_SA(1, 0), cA + kstep, voffA); PG8_STAGE(PG8_SB(1, 1), cB + hstep + kstep, voffB);
        PG8_WAIT_V(6); PG8_BAR;
    }
    for (;;) {
        const bool has_next = S.next(ui + 1, nxt);
        const char* nA = has_next ? (const char*)g.A + (size_t)nxt.pm * tstep : cA; const char* nB = has_next ? (const char*)g.Bt + (size_t)nxt.pn * tstep : cB;
        for (int t = 0; t < nt; t += 2) {
            const bool last = (t == nt - 2);
            const char* a1 = cA + (size_t)(t + 1) * kstep;
            const char* a2 = last ? nA : cA + (size_t)(t + 2) * kstep; const char* b2 = last ? nB : cB + (size_t)(t + 2) * kstep;
            const char* a3 = a2 + kstep; const char* b3 = b2 + kstep;
            if (last && has_next) S.a_ready(nxt);
            if constexpr (SP2) {
            PG8_LDB(B0, 0, 0); PG8_LDB(B1, 0, 1); PG8_SCHED; PG8_LDA(At, 0, 0); PG8_STAGE(PG8_SA(1, 1), a1 + hstep, voffA);
            PG8_WAIT_V(8); PG8_WAIT_L(0); PG8_BAR; PG8_MMA(0, 0, At, B0); PG8_MMA(0, 1, At, B1); PG8_BAR; PG8_SCHED;
            PG8_LDA(At, 0, 1); PG8_STAGE(PG8_SB(0, 0), b2, voffB); PG8_STAGE(PG8_SB(0, 1), b2 + hstep, voffB); PG8_STAGE(PG8_SA(0, 0), a2, voffA);
            PG8_WAIT_V(8); PG8_WAIT_L(0); PG8_BAR; PG8_MMA(1, 0, At, B0); PG8_MMA(1, 1, At, B1); PG8_BAR; PG8_SCHED;
            PG8_LDB(B0, 1, 0); PG8_LDB(B1, 1, 1); PG8_SCHED; PG8_LDA(At, 1, 0); PG8_STAGE(PG8_SA(0, 1), a2 + hstep, voffA);
            PG8_WAIT_V(8); PG8_WAIT_L(0); PG8_BAR; PG8_MMA(0, 0, At, B0); PG8_MMA(0, 1, At, B1); PG8_BAR; PG8_SCHED;
            PG8_LDA(At, 1, 1); PG8_STAGE(PG8_SB(1, 0), b3, voffB); PG8_STAGE(PG8_SB(1, 1), b3 + hstep, voffB); PG8_STAGE(PG8_SA(1, 0), a3, voffA);
            PG8_WAIT_V(8); PG8_WAIT_L(0); PG8_BAR; PG8_MMA(1, 0, At, B0); PG8_MMA(1, 1, At, B1); PG8_BAR; PG8_SCHED;
            } else {
            PG8_LDB(B0, 0, 0); PG8_SCHED; PG8_LDA(At, 0, 0); PG8_STAGE(PG8_SA(1, 1), a1 + hstep, voffA);
            PG8_WAIT_L(8); PG8_BAR; PG8_WAIT_L(0); PG8_MMA(0, 0, At, B0); PG8_BAR; PG8_SCHED;
            PG8_LDB(B1, 0, 1); PG8_STAGE(PG8_SB(0, 0), b2, voffB);
            PG8_BAR; PG8_WAIT_L(0); PG8_MMA(0, 1, At, B1); PG8_BAR;
            PG8_LDA(At, 0, 1); PG8_STAGE(PG8_SA(0, 0), a2, voffA);
            PG8_BAR; PG8_WAIT_L(0); PG8_MMA(1, 0, At, B0); PG8_BAR; PG8_SCHED;
            PG8_STAGE(PG8_SB(0, 1), b2 + hstep, voffB);
            PG8_WAIT_V(6); PG8_BAR; PG8_MMA(1, 1, At, B1); PG8_BAR;
            PG8_LDB(B0, 1, 0); PG8_SCHED; PG8_LDA(At, 1, 0); PG8_STAGE(PG8_SA(0, 1), a2 + hstep, voffA);
            PG8_WAIT_L(8); PG8_BAR; PG8_WAIT_L(0); PG8_MMA(0, 0, At, B0); PG8_BAR; PG8_SCHED;
            PG8_LDB(B1, 1, 1); PG8_STAGE(PG8_SB(1, 0), b3, voffB);
            PG8_BAR; PG8_WAIT_L(0); PG8_MMA(0, 1, At, B1); PG8_BAR;
            PG8_LDA(At, 1, 1); PG8_STAGE(PG8_SA(1, 0), a3, voffA);
            PG8_BAR; PG8_WAIT_L(0); PG8_MMA(1, 0, At, B0); PG8_BAR; PG8_SCHED;
            PG8_STAGE(PG8_SB(1, 1), b3 + hstep, voffB);
            PG8_WAIT_V(6); PG8_BAR; PG8_MMA(1, 1, At, B1); PG8_BAR;
            }
        }
        if constexpr (ALIGN_EPI) { if (wr == 0) PG8_BAR; }
        if constexpr (!Epi::AFTER_DRAIN) { E(acc, cur, wr, wc, fr, fq); S.done(cur); }
        if (!has_next) break;
#pragma unroll
        for (int a = 0; a < 2; ++a)
#pragma unroll
            for (int b = 0; b < 2; ++b)
#pragma unroll
                for (int m = 0; m < 4; ++m)
#pragma unroll
                    for (int n = 0; n < 2; ++n) acc[a][b][m][n] = (f32x4){0.f, 0.f, 0.f, 0.f};
        cur = nxt; cA = nA; cB = nB; ++ui;
        if constexpr (ALIGN_EPI) { if (wr == 1) PG8_BAR; }
    }
    PG8_WAIT_V(0);
    if constexpr (!ALIGN_EPI) { if (wr == 0) PG8_BAR; }
    PG8_BAR;
    if constexpr (Epi::AFTER_DRAIN) { E.fused(acc, cur, wr, wc, fr, fq, lds, wid, lane); S.done(cur); }
#undef PG8_SA
#undef PG8_SB
#undef PG8_STAGE
#undef PG8_LDA
#undef PG8_LDB
#undef PG8_MMA
#undef PG8_WAIT_V
#undef PG8_WAIT_L
#undef PG8_BAR
#undef PG8_SCHED
}
}

constexpr int NWAVES = 8;
constexpr int BATCH = 2, SEQ = 8192, DM = 2048, M = BATCH * SEQ, RW = 1024, NH = 16, HD = 64, PLE_DIM = 256, INW = 8320;
constexpr float RMS_EPS = 1e-6f, LNX_EPS = 64e-5f, L2_EPS = 1e-12f;
constexpr float SB_CUT = -104.0f;
#ifndef MK_N_LAUNCHES
#define MK_N_LAUNCHES 8
#endif
constexpr int N_PHASES = 8;
constexpr size_t MiB = 1u << 20;
constexpr size_t WS_CTL = 0, CTL_ZERO_BYTES = 64 * 1024;
constexpr size_t WS_Z = 1 * MiB;
constexpr size_t WS_WDEC = WS_Z, WS_ACO = WS_Z + 64 * MiB;
constexpr size_t WS_H1B = WS_Z;
constexpr size_t WS_W2T = 98 * MiB, WS_W3T = 106 * MiB, WS_WPT = 114 * MiB, WS_PB = 115 * MiB;
constexpr size_t WS_R = 123 * MiB, WS_K = 155 * MiB, WS_V = 187 * MiB, WS_G = 219 * MiB;
constexpr size_t WS_Q = 251 * MiB, WS_KS = 283 * MiB, WS_VT = 315 * MiB, WS_GS = 347 * MiB;
constexpr size_t WS_LORA = 379 * MiB;
constexpr size_t WS_MIX = 387 * MiB;
constexpr size_t WS_YRAW = WS_Q;
constexpr size_t WS_MIXOUT = WS_R;
constexpr size_t WS_PLERAW = WS_Q;
constexpr size_t WS_PLEN = WS_MIX;
constexpr size_t WS_END = 451 * MiB;
constexpr int CW_BAR = 1024;
constexpr int RING_OFF = 0, RING_BYTES = 131072;
constexpr int LDSCTL_OFF = RING_BYTES, MISC_OFF = LDSCTL_OFF + 320;
constexpr int LDS_BYTES = 147456;

#define GAS __attribute__((address_space(1)))
#define LAS __attribute__((address_space(3)))
typedef unsigned short bf16;
typedef unsigned v4u __attribute__((ext_vector_type(4)));
typedef float f32x4 __attribute__((ext_vector_type(4)));
typedef short bf16x8 __attribute__((ext_vector_type(8)));
typedef GAS unsigned gu32;
typedef GAS unsigned long long gu64;
#define RLX_AGENT __ATOMIC_RELAXED, __HIP_MEMORY_SCOPE_AGENT
#define LDS_WAIT() asm volatile("s_waitcnt lgkmcnt(0)" ::: "memory")
#define VM_WAIT() asm volatile("s_waitcnt vmcnt(0)" ::: "memory")
__device__ __forceinline__ unsigned long long rt() { return __builtin_amdgcn_s_memrealtime(); }
__device__ __forceinline__ unsigned f2bf(float f) { unsigned u = __builtin_bit_cast(unsigned, f); return (u + 0x7fffu + ((u >> 16) & 1u)) >> 16; }
__device__ __forceinline__ unsigned pk2(float lo, float hi) { return f2bf(lo) | (f2bf(hi) << 16); }

#define XB_TMO      128
#define XB_XCNT(j)  (256  + 64 * (j))
#define XB_XSUB(j)  (1280 + 64 * (j))
#define XB_XGEN(j)  (2304 + 64 * (j))
#define XB_TOP      3328
#define XB_TOPGEN   3392
#define XCD_BAR_WORDS 3456
#define XB_SPIN_CAP (1u << 18)

__device__ __forceinline__ unsigned xb_ld(unsigned* p)              { return __hip_atomic_load(p, __ATOMIC_RELAXED, __HIP_MEMORY_SCOPE_AGENT); }
__device__ __forceinline__ unsigned xb_add(unsigned* p, unsigned v) { return __hip_atomic_fetch_add(p, v, __ATOMIC_RELAXED, __HIP_MEMORY_SCOPE_AGENT); }
__device__ __forceinline__ unsigned xb_xcc_id() { return (unsigned)__builtin_amdgcn_s_getreg((3 << 11) | 20) & 0xFu; }
#define XB_SPIN(cond, bar) do { unsigned _sp = 0; while (cond) { __builtin_amdgcn_s_sleep(1); \
    if ((++_sp & 255u) == 0u) { if (xb_ld(&(bar)[XB_TMO])) break; if (_sp > XB_SPIN_CAP) { atomicAdd(&(bar)[XB_TMO], 1u); break; } } } } while (0)

struct XcdBarrier {
    unsigned* bar; unsigned x;
    volatile LAS unsigned* st;
};

__device__ __forceinline__ XcdBarrier xcd_barrier_post(unsigned* bar, volatile LAS unsigned* st) {
    XcdBarrier b; b.bar = bar; b.x = xb_xcc_id(); b.st = st;
    if (threadIdx.x == 0) (void)xb_add(&bar[XB_XCNT(b.x)], 1u);
    return b;
}
__device__ __forceinline__ void xcd_barrier_complete(unsigned* bar, unsigned x, unsigned& nloc, unsigned& nx) {
    const unsigned G = gridDim.x * gridDim.y * gridDim.z;
    unsigned sum, cnt, mine, sp = 0u;
    for (;;) {
        sum = 0u; cnt = 0u; mine = 0u;
#pragma unroll
        for (unsigned j = 0; j < 16; ++j) { const unsigned c = xb_ld(&bar[XB_XCNT(j)]); sum += c; cnt += (c > 0u) ? 1u : 0u; mine = (j == x) ? c : mine; }
        if (sum == G) break;
        __builtin_amdgcn_s_sleep(1);
        if ((++sp & 255u) == 0u) { if (xb_ld(&bar[XB_TMO])) break; if (sp > XB_SPIN_CAP) { atomicAdd(&bar[XB_TMO], 1u); break; } }
    }
    nloc = mine > 0u ? mine : 1u; nx = cnt > 0u ? cnt : 1u;
}

__device__ __forceinline__ void xcd_barrier(const XcdBarrier& b) {
    asm volatile("s_waitcnt vmcnt(0)" ::: "memory");
    __syncthreads();
    if (threadIdx.x == 0) {
        unsigned* bar = b.bar;
        __builtin_amdgcn_s_waitcnt(0);
        unsigned nloc = b.st[0], nx = b.st[1];
        if (nloc == 0u) { xcd_barrier_complete(bar, b.x, nloc, nx); b.st[0] = nloc; b.st[1] = nx; }
        const unsigned old = xb_add(&bar[XB_XSUB(b.x)], 1u);
        const unsigned gen = old / nloc;
        if (old + 1u == (gen + 1u) * nloc) {
            __builtin_amdgcn_fence(__ATOMIC_RELEASE, "agent");
            asm volatile("s_waitcnt vmcnt(0)" ::: "memory");
            const unsigned og = xb_add(&bar[XB_TOP], 1u);
            const unsigned tg = og / nx;
            if (og + 1u == (tg + 1u) * nx) xb_add(&bar[XB_TOPGEN], 1u);
            else XB_SPIN(xb_ld(&bar[XB_TOPGEN]) == tg, bar);
            __builtin_amdgcn_fence(__ATOMIC_ACQUIRE, "agent");
            xb_add(&bar[XB_XGEN(b.x)], 1u);
            asm volatile("s_waitcnt vmcnt(0)" ::: "memory");
        } else {
            XB_SPIN(xb_ld(&bar[XB_XGEN(b.x)]) == gen, bar);
            __builtin_amdgcn_fence(__ATOMIC_ACQUIRE, "agent");
            asm volatile("s_waitcnt vmcnt(0)" ::: "memory");
        }
    }
    __syncthreads();
}

typedef float f32x16 __attribute__((ext_vector_type(16)));
typedef unsigned u32x2 __attribute__((ext_vector_type(2)));
typedef unsigned u32x4 __attribute__((ext_vector_type(4)));
struct Frame {
    LAS unsigned char* lds; volatile LAS unsigned* MISC; gu32* ctl;
    int tid, lane, wave, vcu, G;
};
__device__ __forceinline__ float bf2f(bf16 b) { return __uint_as_float((unsigned)b << 16); }
__device__ __forceinline__ float bflo(unsigned w) { return __uint_as_float(w << 16); }
__device__ __forceinline__ float bfhi(unsigned w) { return __uint_as_float(w & 0xffff0000u); }
template <int CTRL, int RMASK> __device__ __forceinline__ float dppadd(float x) {
    const int m = __builtin_amdgcn_update_dpp(0, __builtin_bit_cast(int, x), CTRL, RMASK, 0xF, false);
    return x + __builtin_bit_cast(float, m);
}
__device__ __forceinline__ float dpp_sum63(float x) {
    x = dppadd<0xB1, 0xF>(x); x = dppadd<0x4E, 0xF>(x); x = dppadd<0x141, 0xF>(x); x = dppadd<0x140, 0xF>(x);
    x = dppadd<0x142, 0xA>(x); x = dppadd<0x143, 0xC>(x); return x;
}
__device__ __forceinline__ float rdlane(float x, int l) { return __builtin_bit_cast(float, __builtin_amdgcn_readlane(__builtin_bit_cast(int, x), l)); }
__device__ __forceinline__ float wave_allsum(float x) { return rdlane(dpp_sum63(x), 63); }
__device__ __forceinline__ float row16_allsum(float x) { x = dppadd<0xB1, 0xF>(x); x = dppadd<0x4E, 0xF>(x); x = dppadd<0x141, 0xF>(x); x = dppadd<0x140, 0xF>(x); return x; }

__device__ __forceinline__ void p0_transpose_tile(const float* W, int ldw, int k0, int sn0, bf16* WT, int K, int dn0, LAS float* scr, int lane) {
#pragma unroll 8
    for (int i = 0; i < 32; ++i) { const int kk = 2 * i + (lane >> 5); scr[kk * 33 + (lane & 31)] = sn0 >= 0 ? W[(size_t)(k0 + kk) * ldw + sn0 + (lane & 31)] : 0.f; }
    LDS_WAIT(); asm volatile("" ::: "memory");
    const int c = lane & 7;
#pragma unroll
    for (int j = 0; j < 4; ++j) { const int n = (lane >> 3) + 8 * j; const LAS float* s = scr + (8 * c) * 33 + n;
        v4u o; o.x = pk2(s[0 * 33], s[1 * 33]); o.y = pk2(s[2 * 33], s[3 * 33]); o.z = pk2(s[4 * 33], s[5 * 33]); o.w = pk2(s[6 * 33], s[7 * 33]);
        *(GAS v4u*)(WT + (size_t)(dn0 + n) * K + k0 + 8 * c) = o; }
    LDS_WAIT(); asm volatile("" ::: "memory");
}
__device__ __forceinline__ int w1_src_col(int n) {
    if (n < 3072) return n;
    if (n < 4096) return 3200 + (n - 3072);
    if (n < 5120) return 4224 + (n - 4096);
    if (n < 6144) return 5248 + (n - 5120);
    if (n < 7168) return 7296 + (n - 6144);
    if (n < 7296) return 3072 + (n - 7168);
    if (n < 7424) return -1;
    return 6272 + (n - 7424);
}
struct In { const float *x, *p, *g_pre, *w_in, *mu, *w0, *w_up, *a0, *a_up, *k_k, *k_a, *r_k, *lnx_w, *lnx_b, *w_out, *g_post, *w_ple, *w_plg, *g_ple; };

__device__ __forceinline__ void p0_prologue(Frame& F, const In& I, unsigned char* ws) {
    LAS float* scr = (LAS float*)(F.lds + RING_OFF + F.wave * 16384);
    const int gw = F.vcu * NWAVES + F.wave, NGW = F.G * NWAVES, lane = F.lane;
    bf16* Z = (bf16*)(ws + WS_Z); bf16* W1T = Z + (size_t)64 * 256 * DM;
    constexpr int I_1 = 264 * 32, I_2 = 64 * 32, I_3 = 64 * 32, I_P = 64 * 4;
    constexpr int NITEMS = I_1 + I_2 + I_3 + I_P;
    for (int it = gw; it < NITEMS; it += NGW) {
        int r = it;
        if (r < I_1) { const int nb = r % 264, kb = r / 264; p0_transpose_tile(I.w_in, INW, kb * 64, w1_src_col(nb * 32), W1T, DM, nb * 32, scr, lane); continue; } r -= I_1;
        if (r < I_2) { const int nb = r % 64, kb = r / 64; p0_transpose_tile(I.w_out, DM, kb * 64, nb * 32, (bf16*)(ws + WS_W2T), DM, nb * 32, scr, lane); continue; } r -= I_2;
        if (r < I_3) { const int nb = r % 64, kb = r / 64; p0_transpose_tile(I.w_plg, DM, kb * 64, nb * 32, (bf16*)(ws + WS_W3T), DM, nb * 32, scr, lane); continue; } r -= I_3;
        { const int nb = r % 64, kb = r / 64; p0_transpose_tile(I.w_ple, DM, kb * 64, nb * 32, (bf16*)(ws + WS_WPT), PLE_DIM, nb * 32, scr, lane); }
    }
    for (int m = gw; m < M; m += NGW) {
        const GAS f32x4* xr = (const GAS f32x4*)(I.x + (size_t)m * DM) + lane; const GAS f32x4* gr = (const GAS f32x4*)I.g_pre + lane;
        f32x4 v[8]; float s = 0.f;
#pragma unroll
        for (int j = 0; j < 8; ++j) { v[j] = xr[64 * j]; s += (v[j].x * v[j].x + v[j].y * v[j].y) + (v[j].z * v[j].z + v[j].w * v[j].w); }
        const float rinv = 1.0f / sqrtf(wave_allsum(s) * (1.0f / DM) + RMS_EPS);
        GAS u32x2* o8 = (GAS u32x2*)(Z + (size_t)m * DM) + lane;
#pragma unroll
        for (int j = 0; j < 8; ++j) { const f32x4 g = gr[64 * j]; u32x2 o; o.x = pk2(v[j].x * rinv * g.x, v[j].y * rinv * g.y); o.y = pk2(v[j].z * rinv * g.z, v[j].w * rinv * g.w); o8[64 * j] = o; }
    }
    { const GAS f32x4* pr = (const GAS f32x4*)I.p; GAS u32x2* po = (GAS u32x2*)(ws + WS_PB); const int n4 = M * PLE_DIM / 4;
      for (int i = gw * 64 + lane; i < n4; i += NGW * 64) { const f32x4 v = pr[i]; u32x2 o; o.x = pk2(v.x, v.y); o.y = pk2(v.z, v.w); po[i] = o; } }
}

__device__ __forceinline__ void p2_lora(Frame& F, const In& I, unsigned char* ws) {
    LAS float* th = (LAS float*)(F.lds + RING_OFF); LAS float* ad = th + 64 * 64;
    const bf16* LORA = (const bf16*)(ws + WS_LORA); float* WDEC = (float*)(ws + WS_WDEC); bf16* ACO = (bf16*)(ws + WS_ACO);
    const int tid = F.tid;
    for (int it = F.vcu; it < M / 64; it += F.G) {
        const int row0 = it * 64;
        __syncthreads();
        for (int e = tid; e < 64 * 128; e += NWAVES * 64) { const int tok = e >> 7, j = e & 127; const int row = row0 + tok;
            const float cur = bf2f(LORA[(size_t)row * 256 + j]); const float prev = (row % SEQ) ? bf2f(LORA[(size_t)(row - 1) * 256 + j]) : 0.f;
            const float sv = cur + (prev - cur) * I.mu[3072 + j];
            if (j < 64) { const float e2 = __expf(2.0f * sv); th[tok * 64 + j] = 1.0f - 2.0f / (e2 + 1.0f); } else ad[tok * 64 + (j - 64)] = sv; }
        __syncthreads();
#pragma unroll 1
        for (int cc = 0; cc < 2; ++cc) { const int c = tid + cc * 512;
            float wc[64];
#pragma unroll
            for (int j = 0; j < 64; ++j) wc[j] = I.w_up[j * RW + c];
            const float b0 = I.w0[c];
#pragma unroll 2
            for (int tok = 0; tok < 64; ++tok) { float acc0 = b0, acc1 = 0.f;
#pragma unroll
                for (int j = 0; j < 64; j += 8) { const f32x4 t0 = *(const LAS f32x4*)(th + tok * 64 + j), t1 = *(const LAS f32x4*)(th + tok * 64 + j + 4);
                    acc0 += t0.x * wc[j] + t0.y * wc[j + 1] + t0.z * wc[j + 2] + t0.w * wc[j + 3]; acc1 += t1.x * wc[j + 4] + t1.y * wc[j + 5] + t1.z * wc[j + 6] + t1.w * wc[j + 7]; }
                const float xw = acc0 + acc1; const float sg = 1.0f / (1.0f + __expf(-xw));
                WDEC[(size_t)(row0 + tok) * RW + c] = __expf(-0.60653065971263342f * sg); }
#pragma unroll
            for (int j = 0; j < 64; ++j) wc[j] = I.a_up[j * RW + c];
            const float b1 = I.a0[c];
#pragma unroll 2
            for (int tok = 0; tok < 64; ++tok) { float acc0 = b1, acc1 = 0.f;
#pragma unroll
                for (int j = 0; j < 64; j += 8) { const f32x4 t0 = *(const LAS f32x4*)(ad + tok * 64 + j), t1 = *(const LAS f32x4*)(ad + tok * 64 + j + 4);
                    acc0 += t0.x * wc[j] + t0.y * wc[j + 1] + t0.z * wc[j + 2] + t0.w * wc[j + 3]; acc1 += t1.x * wc[j + 4] + t1.y * wc[j + 5] + t1.z * wc[j + 6] + t1.w * wc[j + 7]; }
                const float xa = acc0 + acc1;
                ACO[(size_t)(row0 + tok) * RW + c] = (bf16)f2bf(1.0f / (1.0f + __expf(-xa))); }
        }
    }
    __syncthreads();
}

__device__ __forceinline__ int crow(int r, int hi) { return (r & 3) + 8 * (r >> 2) + 4 * hi; }
__device__ __forceinline__ float softplusf(float z) { return fmaxf(z, 0.f) + __logf(1.0f + __expf(-fabsf(z))); }
__device__ __forceinline__ void attn_tile(const bf16* Q, const bf16* KS, const bf16* VT, const bf16* GS, bf16* MIX, int b, int h, int qt, int lane) {
    const int r32 = lane & 31, hi = lane >> 5, t0 = qt * 32; const size_t rowb = (size_t)b * SEQ;
    bf16x8 qf[4];
    { const bf16* qp = Q + (rowb + t0 + r32) * 1024 + h * 64 + hi * 8;
#pragma unroll
      for (int d0 = 0; d0 < 4; ++d0) qf[d0] = *(const GAS bf16x8*)(qp + d0 * 16); }
    f32x16 o0 = {}, o1 = {}; float R = 0.f;
    const bf16* vt0 = VT + (size_t)(h * 64 + r32) * M + rowb + 4 * hi;
    for (int kb = qt; kb >= 0; --kb) {
        const int s0 = kb * 32;
        bf16x8 kf[4];
        { const bf16* kp = KS + (rowb + s0 + r32) * 1024 + h * 64 + hi * 8;
#pragma unroll
          for (int d0 = 0; d0 < 4; ++d0) kf[d0] = *(const GAS bf16x8*)(kp + d0 * 16); }
        u32x2 va[2][2][2];
#pragma unroll
        for (int dt = 0; dt < 2; ++dt)
#pragma unroll
            for (int s = 0; s < 2; ++s)
#pragma unroll
                for (int hf = 0; hf < 2; ++hf) va[dt][s][hf] = *(const GAS u32x2*)(vt0 + (size_t)dt * 32 * M + s0 + 16 * s + 8 * hf);
        f32x16 p = {};
#pragma unroll
        for (int d0 = 0; d0 < 4; ++d0) p = __builtin_amdgcn_mfma_f32_32x32x16_bf16(kf[d0], qf[d0], p, 0, 0, 0);
        const bool diag = (kb == qt);
        float l1[16], lb[16];
#pragma unroll
        for (int r = 0; r < 16; ++r) { const float z = p[r]; const float sp = softplusf(z); const bool valid = !diag || (crow(r, hi) < r32); l1[r] = valid ? -sp : 0.f; lb[r] = valid ? (z - sp) : -INFINITY; }
        float mine[4], oth[4], tot[4];
#pragma unroll
        for (int g = 0; g < 4; ++g) { mine[g] = (l1[4 * g] + l1[4 * g + 1]) + (l1[4 * g + 2] + l1[4 * g + 3]);
            auto rr = __builtin_amdgcn_permlane32_swap(__float_as_uint(mine[g]), __float_as_uint(mine[g]), false, false);
            const float lo = __uint_as_float(rr[0]), up = __uint_as_float(rr[1]); oth[g] = hi ? lo : up; tot[g] = lo + up; }
        float T[4]; T[3] = 0.f; T[2] = tot[3]; T[1] = T[2] + tot[2]; T[0] = T[1] + tot[1];
        float w[16];
#pragma unroll
        for (int g = 0; g < 4; ++g) { float e = T[g] + (hi ? 0.f : oth[g]) + R;
            w[4 * g + 3] = __expf(lb[4 * g + 3] + e); e += l1[4 * g + 3];
            w[4 * g + 2] = __expf(lb[4 * g + 2] + e); e += l1[4 * g + 2];
            w[4 * g + 1] = __expf(lb[4 * g + 1] + e); e += l1[4 * g + 1];
            w[4 * g + 0] = __expf(lb[4 * g + 0] + e); }
        R += T[0] + tot[0];
        u32x4 pb0, pb1;
        pb0.x = pk2(w[0], w[1]); pb0.y = pk2(w[2], w[3]); pb0.z = pk2(w[4], w[5]); pb0.w = pk2(w[6], w[7]);
        pb1.x = pk2(w[8], w[9]); pb1.y = pk2(w[10], w[11]); pb1.z = pk2(w[12], w[13]); pb1.w = pk2(w[14], w[15]);
        const bf16x8 pB0 = __builtin_bit_cast(bf16x8, pb0), pB1 = __builtin_bit_cast(bf16x8, pb1);
#define VA(dt, s) __builtin_bit_cast(bf16x8, (u32x4){va[dt][s][0].x, va[dt][s][0].y, va[dt][s][1].x, va[dt][s][1].y})
        o0 = __builtin_amdgcn_mfma_f32_32x32x16_bf16(VA(0, 0), pB0, o0, 0, 0, 0); o0 = __builtin_amdgcn_mfma_f32_32x32x16_bf16(VA(0, 1), pB1, o0, 0, 0, 0);
        o1 = __builtin_amdgcn_mfma_f32_32x32x16_bf16(VA(1, 0), pB0, o1, 0, 0, 0); o1 = __builtin_amdgcn_mfma_f32_32x32x16_bf16(VA(1, 1), pB1, o1, 0, 0, 0);
#undef VA
        if (__all(R < SB_CUT)) break;
    }
    const size_t row = rowb + t0 + r32;
#pragma unroll
    for (int dt = 0; dt < 2; ++dt)
#pragma unroll
        for (int g = 0; g < 4; ++g) { const int d = dt * 32 + 8 * g + 4 * hi; const u32x2 gw = *(const GAS u32x2*)(GS + row * 1024 + h * 64 + d);
            float gv[4] = {bflo(gw.x), bfhi(gw.x), bflo(gw.y), bfhi(gw.y)}; float ov[4];
#pragma unroll
            for (int e = 0; e < 4; ++e) { const float o = dt ? o1[4 * g + e] : o0[4 * g + e]; ov[e] = o * gv[e] / (1.0f + __expf(-gv[e])); }
            u32x2 st; st.x = pk2(ov[0], ov[1]); st.y = pk2(ov[2], ov[3]); *(GAS u32x2*)(MIX + row * 2048 + 1024 + h * 64 + d) = st; }
}
__device__ __forceinline__ void p2_attention(Frame& F, unsigned char* ws) {
    const bf16 *Q = (const bf16*)(ws + WS_Q), *KS = (const bf16*)(ws + WS_KS), *VT = (const bf16*)(ws + WS_VT), *GS = (const bf16*)(ws + WS_GS); bf16* MIX = (bf16*)(ws + WS_MIX);
    const int gw = F.vcu * NWAVES + F.wave, NGW = F.G * NWAVES;
    for (int u = gw; u < BATCH * NH * (SEQ / 32); u += NGW) { const int qt = u & 255, bh = u >> 8; attn_tile(Q, KS, VT, GS, MIX, bh >> 4, bh & 15, qt, F.lane); }
}

constexpr int TC = 32;
constexpr int SC_VEC = 0, SC_R = TC * 64 * 16, SC_V = SC_R + TC * 64 * 4, SC_BUF = SC_V + TC * 8 * 4;
struct ScanRegs { u32x2 rc, rp, kc, kp, ac; f32x4 wv; unsigned vc, vp; };
__device__ __forceinline__ void p3_scan(Frame& F, const In& I, unsigned char* ws) {
    const int tid = F.tid, lane = F.lane, wave = F.wave;
    const bf16 *Rb = (const bf16*)(ws + WS_R), *Kb = (const bf16*)(ws + WS_K), *Vb = (const bf16*)(ws + WS_V), *ACO = (const bf16*)(ws + WS_ACO); const float* WDEC = (const float*)(ws + WS_WDEC);
    float* YRAW = (float*)(ws + WS_YRAW);
    for (int unit = blockIdx.x; unit < 256; unit += F.G) {
        const int xcd = unit & 7, slot = unit >> 3, bh = xcd * 4 + (slot >> 3), rg = slot & 7, b = bh >> 4, h = bh & 15;
        const size_t rowb = (size_t)b * SEQ;
        const int sj = tid >> 4, kq = tid & 15, c0 = h * 64 + 4 * kq;
        float mur[4], muk[4], kkc[4], kac[4];
#pragma unroll
        for (int e = 0; e < 4; ++e) { mur[e] = I.mu[c0 + e]; muk[e] = I.mu[1024 + c0 + e]; kkc[e] = I.k_k[c0 + e]; kac[e] = I.k_a[c0 + e]; }
        const int vsj = (tid >> 3) & 31, vri = tid & 7, vc = h * 64 + rg * 8 + vri; const float muv = I.mu[2048 + vc];
        auto LOAD = [&](int ch, ScanRegs& g) {
            const int t = ch * TC + sj; const size_t row = rowb + t;
            g.rc = *(const GAS u32x2*)(Rb + row * 1024 + c0); g.kc = *(const GAS u32x2*)(Kb + row * 1024 + c0); g.ac = *(const GAS u32x2*)(ACO + row * 1024 + c0);
            g.wv = *(const GAS f32x4*)(WDEC + row * 1024 + c0);
            if (t > 0) { g.rp = *(const GAS u32x2*)(Rb + (row - 1) * 1024 + c0); g.kp = *(const GAS u32x2*)(Kb + (row - 1) * 1024 + c0); } else { g.rp = (u32x2){0u, 0u}; g.kp = (u32x2){0u, 0u}; }
            if (tid < 256) { const int tv = ch * TC + vsj; const size_t rv = rowb + tv; g.vc = Vb[rv * 1024 + vc]; g.vp = tv > 0 ? (unsigned)Vb[(rv - 1) * 1024 + vc] : 0u; }
        };
        auto STAGE = [&](int buf, const ScanRegs& g) {
            LAS unsigned char* base = F.lds + RING_OFF + buf * SC_BUF;
            const float rc[4] = {bflo(g.rc.x), bfhi(g.rc.x), bflo(g.rc.y), bfhi(g.rc.y)}, rp[4] = {bflo(g.rp.x), bfhi(g.rp.x), bflo(g.rp.y), bfhi(g.rp.y)};
            const float kc[4] = {bflo(g.kc.x), bfhi(g.kc.x), bflo(g.kc.y), bfhi(g.kc.y)}, kp[4] = {bflo(g.kp.x), bfhi(g.kp.x), bflo(g.kp.y), bfhi(g.kp.y)};
            const float av[4] = {bflo(g.ac.x), bfhi(g.ac.x), bflo(g.ac.y), bfhi(g.ac.y)};
            float rs[4], ks[4], kr[4]; float ss = 0.f;
#pragma unroll
            for (int e = 0; e < 4; ++e) { rs[e] = rc[e] + (rp[e] - rc[e]) * mur[e]; ks[e] = kc[e] + (kp[e] - kc[e]) * muk[e]; kr[e] = ks[e] * kkc[e]; ss += kr[e] * kr[e]; }
            ss = row16_allsum(ss); const float inv = 1.0f / sqrtf(ss + L2_EPS);
#pragma unroll
            for (int e = 0; e < 4; ++e) { const float kk = kr[e] * inv; f32x4 o; o.x = g.wv[e]; o.y = kk; o.z = av[e] * kk; o.w = ks[e] * (1.0f + (av[e] - 1.0f) * kac[e]);
                *(LAS f32x4*)(base + SC_VEC + (sj * 64 + 4 * kq + e) * 16) = o; }
            *(LAS f32x4*)(base + SC_R + (sj * 64 + 4 * kq) * 4) = (f32x4){rs[0], rs[1], rs[2], rs[3]};
            if (tid < 256) { const float vcur = bf2f((bf16)g.vc), vprev = bf2f((bf16)g.vp); *(LAS float*)(base + SC_V + (vsj * 8 + vri) * 4) = vcur + (vprev - vcur) * muv; }
        };
        ScanRegs g;
        __syncthreads();
        LOAD(0, g); STAGE(0, g);
        __syncthreads();
        float S = 0.f;
        const int vrow = h * 64 + rg * 8 + wave;
        for (int ch = 0; ch < SEQ / TC; ++ch) {
            const int buf = ch & 1;
            if (ch + 1 < SEQ / TC) LOAD(ch + 1, g);
            const LAS unsigned char* base = F.lds + RING_OFF + buf * SC_BUF;
            const float vv = *(const LAS float*)(base + SC_V + ((lane & 31) * 8 + wave) * 4);
            float yv = 0.f;
#pragma unroll
            for (int j = 0; j < TC; ++j) {
                const f32x4 f4 = *(const LAS f32x4*)(base + SC_VEC + (j * 64 + lane) * 16);
                const float rr = *(const LAS float*)(base + SC_R + (j * 64 + lane) * 4);
                const float vt = rdlane(vv, j);
                const float sa = rdlane(dpp_sum63(S * f4.y), 63);
                S = fmaf(S, f4.x, fmaf(-sa, f4.z, vt * f4.w));
                const float yy = rdlane(dpp_sum63(S * rr), 63);
                yv = (lane == j) ? yy : yv;
            }
            if (lane < TC) YRAW[(rowb + ch * TC + lane) * 1024 + vrow] = yv;
            if (ch + 1 < SEQ / TC) STAGE(buf ^ 1, g);
            __syncthreads();
        }
    }
}

__device__ __forceinline__ void p4_rwkv_out(Frame& F, const In& I, unsigned char* ws) {
    const bf16 *Rb = (const bf16*)(ws + WS_R), *Kb = (const bf16*)(ws + WS_K), *Vb = (const bf16*)(ws + WS_V), *Gb = (const bf16*)(ws + WS_G), *ACO = (const bf16*)(ws + WS_ACO);
    const float* YRAW = (const float*)(ws + WS_YRAW); bf16* MIX = (bf16*)(ws + WS_MIX);
    const int gw = F.vcu * NWAVES + F.wave, NGW = F.G * NWAVES, lane = F.lane;
    for (int i = gw; i < M * NH; i += NGW) {
        const int row = i >> 4, h = i & 15, c = h * 64 + lane; const bool first = (row % SEQ) == 0;
        const float y = YRAW[(size_t)row * 1024 + c];
        const float mean = wave_allsum(y) * (1.0f / 64.0f); const float d = y - mean; const float var = wave_allsum(d * d) * (1.0f / 64.0f);
        const float yn = d * (1.0f / sqrtf(var + LNX_EPS)) * I.lnx_w[c] + I.lnx_b[c];
        const size_t o = (size_t)row * 1024 + c;
        const float rc = bf2f(Rb[o]), kc = bf2f(Kb[o]), vcur = bf2f(Vb[o]);
        const float rp = first ? 0.f : bf2f(Rb[o - 1024]), kp = first ? 0.f : bf2f(Kb[o - 1024]), vp = first ? 0.f : bf2f(Vb[o - 1024]);
        const float rs = rc + (rp - rc) * I.mu[c], ks = kc + (kp - kc) * I.mu[1024 + c], vs = vcur + (vp - vcur) * I.mu[2048 + c];
        const float a = bf2f(ACO[o]); const float k2 = ks * (1.0f + (a - 1.0f) * I.k_a[c]);
        const float bon = wave_allsum(rs * k2 * I.r_k[c]);
        const float g = bf2f(Gb[o]);
        const float out = (yn + bon * vs) * (g / (1.0f + __expf(-g)));
        MIX[(size_t)row * 2048 + c] = (bf16)f2bf(out);
    }
}

__device__ __forceinline__ void p6_rows(Frame& F, const In& I, unsigned char* ws, float* out) {
    const float *MIXOUT = (const float*)(ws + WS_MIXOUT), *PLERAW = (const float*)(ws + WS_PLERAW); bf16 *H1B = (bf16*)(ws + WS_H1B), *PLEN = (bf16*)(ws + WS_PLEN);
    const int gw = F.vcu * NWAVES + F.wave, NGW = F.G * NWAVES, lane = F.lane;
    for (int m = gw; m < M; m += NGW) {
        { const GAS f32x4* mr = (const GAS f32x4*)(MIXOUT + (size_t)m * DM) + lane; const GAS f32x4* xr = (const GAS f32x4*)(I.x + (size_t)m * DM) + lane; const GAS f32x4* gr = (const GAS f32x4*)I.g_post + lane;
          f32x4 v[8]; float s = 0.f;
#pragma unroll
          for (int j = 0; j < 8; ++j) { v[j] = mr[64 * j]; s += (v[j].x * v[j].x + v[j].y * v[j].y) + (v[j].z * v[j].z + v[j].w * v[j].w); }
          const float rinv = 1.0f / sqrtf(wave_allsum(s) * (1.0f / DM) + RMS_EPS);
          GAS f32x4* orow = (GAS f32x4*)(out + (size_t)m * DM) + lane; GAS u32x2* hb = (GAS u32x2*)(H1B + (size_t)m * DM) + lane;
#pragma unroll
          for (int j = 0; j < 8; ++j) { const f32x4 g = gr[64 * j], x = xr[64 * j]; f32x4 hh; hh.x = x.x + v[j].x * rinv * g.x; hh.y = x.y + v[j].y * rinv * g.y; hh.z = x.z + v[j].z * rinv * g.z; hh.w = x.w + v[j].w * rinv * g.w;
              orow[64 * j] = hh; u32x2 o; o.x = pk2(hh.x, hh.y); o.y = pk2(hh.z, hh.w); hb[64 * j] = o; } }
        { const GAS f32x4* pr = (const GAS f32x4*)(PLERAW + (size_t)m * DM) + lane; const GAS f32x4* gr = (const GAS f32x4*)I.g_ple + lane;
          f32x4 v[8]; float s = 0.f;
#pragma unroll
          for (int j = 0; j < 8; ++j) { v[j] = pr[64 * j]; s += (v[j].x * v[j].x + v[j].y * v[j].y) + (v[j].z * v[j].z + v[j].w * v[j].w); }
          const float rinv = 1.0f / sqrtf(wave_allsum(s) * (1.0f / DM) + RMS_EPS);
          GAS u32x2* pn = (GAS u32x2*)(PLEN + (size_t)m * DM) + lane;
#pragma unroll
          for (int j = 0; j < 8; ++j) { const f32x4 g = gr[64 * j]; u32x2 o; o.x = pk2(v[j].x * rinv * g.x, v[j].y * rinv * g.y); o.y = pk2(v[j].z * rinv * g.z, v[j].w * rinv * g.w); pn[64 * j] = o; } }
    }
}

struct Args { const float* in[19]; float* out; unsigned char* ws; int ph_lo, ph_hi, li, pad; };
__global__ void __launch_bounds__(NWAVES * 64, 2) hymba_fwd(Args args) {
    extern __shared__ __attribute__((aligned(16))) unsigned char lds[];
    Frame F;
    F.lds = (LAS unsigned char*)lds; F.MISC = (volatile LAS unsigned*)(F.lds + MISC_OFF);
    F.tid = threadIdx.x; F.lane = F.tid & 63; F.wave = __builtin_amdgcn_readfirstlane(F.tid >> 6);
    F.G = gridDim.x; { const int bx = blockIdx.x; F.vcu = (F.G % 8 == 0) ? (bx % 8) * (F.G / 8) + bx / 8 : bx; }
    unsigned char* ws = args.ws; F.ctl = (gu32*)(ws + WS_CTL);
    In I; I.x = args.in[0]; I.p = args.in[1]; I.g_pre = args.in[2]; I.w_in = args.in[3]; I.mu = args.in[4]; I.w0 = args.in[5]; I.w_up = args.in[6]; I.a0 = args.in[7]; I.a_up = args.in[8];
    I.k_k = args.in[9]; I.k_a = args.in[10]; I.r_k = args.in[11]; I.lnx_w = args.in[12]; I.lnx_b = args.in[13]; I.w_out = args.in[14]; I.g_post = args.in[15]; I.w_ple = args.in[16]; I.w_plg = args.in[17]; I.g_ple = args.in[18];
    for (int u = F.tid; u < (LDS_BYTES - LDSCTL_OFF) / 4; u += NWAVES * 64) ((LAS unsigned*)(F.lds + LDSCTL_OFF))[u] = 0u;
    __syncthreads();
    const bool multi = (args.ph_hi - args.ph_lo) > 1;
    XcdBarrier bar; bar.bar = (unsigned*)(F.ctl + CW_BAR); bar.x = 0; bar.st = nullptr;
    if (multi) bar = xcd_barrier_post((unsigned*)(F.ctl + CW_BAR), F.MISC + 8);
    const int lo = args.ph_lo, hi = args.ph_hi;
#define IN(k) (lo <= (k) && (k) < hi)
#define BOTH(k) (IN(k) && IN((k) + 1))
    bf16* Z = (bf16*)(ws + WS_Z);
    if (IN(0)) { p0_prologue(F, I, ws); if (BOTH(0)) xcd_barrier(bar); }
    if (IN(1)) {
        pg8::Gemm g{Z, Z, M, 8448, DM}; pg8::SchedIn S{F.G, (int)blockIdx.x};
        pg8::EpiIn E{ws, WS_R, WS_Q, WS_LORA, WS_VT};
        pg8::gemm_phase<pg8::EpiIn, pg8::SchedIn, true, true>(F.lds + RING_OFF, g, S, E);
        if (BOTH(1)) xcd_barrier(bar);
    }
    if (IN(2)) { p2_lora(F, I, ws); p2_attention(F, ws); if (BOTH(2)) xcd_barrier(bar); }
    if (IN(3)) { p3_scan(F, I, ws); if (BOTH(3)) xcd_barrier(bar); }
    if (IN(4)) { p4_rwkv_out(F, I, ws); if (BOTH(4)) xcd_barrier(bar); }
    if (IN(5)) {
        { pg8::Gemm g{(const bf16*)(ws + WS_MIX), (const bf16*)(ws + WS_W2T), M, DM, DM}; pg8::StaticOrder S; S.init(M, DM, F.G, (int)blockIdx.x);
          pg8::EpiF32 E{(float*)(ws + WS_MIXOUT), DM};
          pg8::gemm_phase<pg8::EpiF32, pg8::StaticOrder, true, true>(F.lds + RING_OFF, g, S, E); }
        __syncthreads();
        { pg8::Gemm g{(const bf16*)(ws + WS_PB), (const bf16*)(ws + WS_WPT), M, DM, PLE_DIM}; pg8::StaticOrder S; S.init(M, DM, F.G, (int)blockIdx.x);
          pg8::EpiF32 E{(float*)(ws + WS_PLERAW), DM};
          pg8::gemm_phase<pg8::EpiF32, pg8::StaticOrder, true, true>(F.lds + RING_OFF, g, S, E); }
        if (BOTH(5)) xcd_barrier(bar);
    }
    if (IN(6)) { p6_rows(F, I, ws, args.out); if (BOTH(6)) xcd_barrier(bar); }
    if (IN(7)) {
        pg8::Gemm g{(const bf16*)(ws + WS_H1B), (const bf16*)(ws + WS_W3T), M, DM, DM}; pg8::StaticOrder S; S.init(M, DM, F.G, (int)blockIdx.x);
        pg8::EpiFinal E{args.out, (const bf16*)(ws + WS_PLEN), DM};
        pg8::gemm_phase<pg8::EpiFinal, pg8::StaticOrder, true, true>(F.lds + RING_OFF, g, S, E);
    }
#undef IN
#undef BOTH
}

extern "C" void kernel_launch(void* const* d_in, const int* in_sizes, int n_in, void* d_out, int out_size, void* d_ws, size_t ws_size, hipStream_t stream) {
    static int grid = 0;
    if (grid == 0) {
        if (n_in != 19 || in_sizes[0] != M * DM || out_size != M * DM || ws_size < WS_END) { fprintf(stderr, "kernel_launch: unexpected shapes (n_in %d, in0 %d, out %d, ws %zu); nothing launched\n", n_in, n_in > 0 ? in_sizes[0] : -1, out_size, ws_size); grid = -1; return; }
        int dev = 0, cus = 0, per_cu = 0;
        if (hipGetDevice(&dev) != hipSuccess || hipDeviceGetAttribute(&cus, hipDeviceAttributeMultiprocessorCount, dev) != hipSuccess) { grid = -1; return; }
        if (hipFuncSetAttribute((const void*)hymba_fwd, hipFuncAttributeMaxDynamicSharedMemorySize, LDS_BYTES) != hipSuccess) { fprintf(stderr, "kernel_launch: hipFuncSetAttribute failed\n"); grid = -1; return; }
        if (hipOccupancyMaxActiveBlocksPerMultiprocessor(&per_cu, (const void*)hymba_fwd, NWAVES * 64, LDS_BYTES) != hipSuccess || per_cu < 1) { fprintf(stderr, "kernel_launch: occupancy query says %d\n", per_cu); }
        (void)hipGetLastError();
        grid = cus;
    }
    if (grid < 0) return;
    if (hipMemsetAsync((char*)d_ws + WS_CTL, 0, CTL_ZERO_BYTES, stream) != hipSuccess) return;
    Args a{};
    for (int i = 0; i < 19; ++i) a.in[i] = (const float*)d_in[i];
    a.out = (float*)d_out; a.ws = (unsigned char*)d_ws;
    constexpr int NL = MK_N_LAUNCHES;
    for (int li = 0; li < NL; ++li) {
        a.ph_lo = (NL == 1) ? 0 : li; a.ph_hi = (NL == 1) ? N_PHASES : li + 1; a.li = li;
        hipLaunchKernelGGL(hymba_fwd, dim3(grid), dim3(NWAVES * 64), LDS_BYTES, stream, a);
    }
}
```

```cpp
#include <hip/hip_runtime.h>
#include <cstdio>
#include <cstdint>
namespace pg8 {
#define PG8_LAS __attribute__((address_space(3)))
typedef unsigned short bf16_t;
typedef short bf16x8 __attribute__((ext_vector_type(8)));
typedef float f32x4 __attribute__((ext_vector_type(4)));
typedef unsigned u32x4 __attribute__((ext_vector_type(4)));
constexpr int BM = 256, BK = 64, HALF = 128, HTB = HALF * BK * 2  , STAGE_BYTES = 8 * HTB, NXCD = 8, WGM = 8;

__host__ __device__ __forceinline__ int lds_byte(int r, int c) { const int st = (r >> 4) * 2 + (c >> 5), rr = r & 15, cc = c & 31, ob = rr * 64 + cc * 2; return st * 1024 + (ob ^ (((ob >> 9) & 1) << 5)); }
__host__ __device__ __forceinline__ void stage_rc(int b, int& R, int& C) { const int st = b / 1024, sb = b % 1024, swz = sb ^ (((sb >> 9) & 1) << 5); R = (st >> 1) * 16 + swz / 64; C = (st & 1) * 32 + (swz % 64) / 2; }
__host__ __device__ __forceinline__ int perm32(int rho) { const int n = rho >> 4, i = rho & 15; return 8 * (i >> 2) + 4 * n + (i & 3); }

struct Unit { int pm, pn; };
struct Gemm { const bf16_t* A; const bf16_t* Bt; int M, N, K; };

struct StaticOrder {
    int nM, nN, nwg, G, c;
    __host__ __device__ void init(int M, int N, int G_, int c_) { nM = M / BM; nN = N / BM; nwg = nM * nN; G = G_; c = c_; }
    __host__ __device__ bool next(int i, Unit& u) const {
        const long L = (long)i * G + c; if (L >= nwg) return false;
        int wgid = (int)L; { const int q = nwg / NXCD, r = nwg % NXCD, xcd = wgid % NXCD, off = wgid / NXCD; wgid = (xcd < r ? xcd * (q + 1) : r * (q + 1) + (xcd - r) * q) + off; }
        const int nig = WGM * nN, gid = wgid / nig, fm = gid * WGM, gsz = (nM - fm) < WGM ? (nM - fm) : WGM;
        u.pm = fm + ((wgid % nig) % gsz); u.pn = (wgid % nig) / gsz; return true;
    }
    __device__ __forceinline__ void a_ready(const Unit&) const {}
    __device__ __forceinline__ void done(const Unit&) const {}
};

__device__ __forceinline__ unsigned cvt_pk_bf16(float lo, float hi) { unsigned r; asm volatile("v_cvt_pk_bf16_f32 %0, %1, %2" : "=v"(r) : "v"(lo), "v"(hi)); return r; }
typedef float f32x2 __attribute__((ext_vector_type(2)));
struct EpiF32 {
    static constexpr bool PERM = false, AFTER_DRAIN = false;
    float* C; int ldc;
    __device__ __forceinline__ void operator()(const f32x4 (&acc)[2][2][4][2], const Unit& u, int wr, int wc, int fr, int fq) const {
        const int row0 = u.pm * BM + wr * 64 + fr, col0 = u.pn * BM + wc * 32 + 4 * fq;
#pragma unroll
        for (int ai = 0; ai < 2; ++ai)
#pragma unroll
            for (int m = 0; m < 4; ++m) { float* rowp = C + (size_t)(row0 + ai * HALF + m * 16) * ldc + col0;
#pragma unroll
                for (int bj = 0; bj < 2; ++bj)
#pragma unroll
                    for (int n = 0; n < 2; ++n) *(f32x4*)(rowp + bj * HALF + n * 16) = acc[ai][bj][m][n]; }
    }
};
struct EpiIn {
    static constexpr bool PERM = true, AFTER_DRAIN = false;
    unsigned char* ws; size_t off_r, off_q, off_lora, off_vt;
    __device__ __forceinline__ void operator()(const f32x4 (&acc)[2][2][4][2], const Unit& u, int wr, int wc, int fr, int fq) const {
        bf16_t* base; int ldc, rowt, colt; float sc = 1.f;
        if (u.pn >= 64) { const int tile = u.pn - 64, grp = tile >> 2; rowt = u.pm * BM; colt = (tile & 3) * BM; ldc = 1024;
            size_t off;
            if (grp < 4) off = off_r + (size_t)grp * (32u << 20);
            else if (grp == 4) { off = off_q; sc = 0.125f; }
            else if (grp == 5) off = off_q + (32u << 20);
            else if (grp == 6) off = off_q + (96u << 20);
            else { off = off_lora; ldc = 256; colt = 0; }
            base = (bf16_t*)(ws + off);
        } else { base = (bf16_t*)(ws + off_vt); ldc = 16384; rowt = (u.pm - 93) * BM; colt = u.pn * BM; }
        const int row0 = rowt + wr * 64 + fr, col0 = colt + wc * 32 + 8 * fq;
#pragma unroll
        for (int ai = 0; ai < 2; ++ai)
#pragma unroll
            for (int m = 0; m < 4; ++m) { bf16_t* rowp = base + (size_t)(row0 + ai * HALF + m * 16) * ldc + col0;
#pragma unroll
                for (int bj = 0; bj < 2; ++bj) { f32x4 v0 = acc[ai][bj][m][0] * sc, v1 = acc[ai][bj][m][1] * sc;
                    u32x4 w; w.x = cvt_pk_bf16(v0[0], v0[1]); w.y = cvt_pk_bf16(v0[2], v0[3]); w.z = cvt_pk_bf16(v1[0], v1[1]); w.w = cvt_pk_bf16(v1[2], v1[3]);
                    *(u32x4*)(rowp + bj * HALF) = w; } }
    }
};
struct SchedIn {
    int G, c;
    __device__ __forceinline__ bool next(int i, Unit& u) const {
        const int L = i * G + c; if (L >= 2112) return false;
        if (L < 1856) { const int nwg = 1856, nM = 64, nN = 29; int wgid = L; { const int q = nwg / NXCD, r = nwg % NXCD, xcd = wgid % NXCD, off = wgid / NXCD; wgid = (xcd < r ? xcd * (q + 1) : r * (q + 1) + (xcd - r) * q) + off; }
            const int nig = WGM * nN, gid = wgid / nig, fm = gid * WGM, gsz = (nM - fm) < WGM ? (nM - fm) : WGM;
            u.pm = fm + ((wgid % nig) % gsz); u.pn = 64 + (wgid % nig) / gsz; }
        else { const int l2 = L - 1856; u.pm = 93 + (l2 & 3); u.pn = l2 >> 2; }
        return true;
    }
    __device__ __forceinline__ void a_ready(const Unit&) const {}
    __device__ __forceinline__ void done(const Unit&) const {}
};
struct EpiFinal {
    static constexpr bool PERM = false, AFTER_DRAIN = false;
    float* out; const bf16_t* ple; int ldc;
    __device__ __forceinline__ void operator()(const f32x4 (&acc)[2][2][4][2], const Unit& u, int wr, int wc, int fr, int fq) const {
        typedef unsigned u32x2v __attribute__((ext_vector_type(2)));
        const int row0 = u.pm * BM + wr * 64 + fr, col0 = u.pn * BM + wc * 32 + 4 * fq;
#pragma unroll
        for (int ai = 0; ai < 2; ++ai)
#pragma unroll
            for (int m = 0; m < 4; ++m) { const size_t ro = (size_t)(row0 + ai * HALF + m * 16) * ldc + col0;
#pragma unroll
                for (int bj = 0; bj < 2; ++bj)
#pragma unroll
                    for (int n = 0; n < 2; ++n) { const size_t o = ro + bj * HALF + n * 16; const f32x4 h = *(const f32x4*)(out + o); const u32x2v pw = *(const u32x2v*)(ple + o);
                        const f32x4 a = acc[ai][bj][m][n]; f32x4 pl; pl[0] = __uint_as_float(pw.x << 16); pl[1] = __uint_as_float(pw.x & 0xffff0000u); pl[2] = __uint_as_float(pw.y << 16); pl[3] = __uint_as_float(pw.y & 0xffff0000u);
                        f32x4 r;
#pragma unroll
                        for (int e = 0; e < 4; ++e) r[e] = h[e] + pl[e] * (1.0f / (1.0f + __expf(-a[e])));
                        *(f32x4*)(out + o) = r; } }
    }
};
template <class Epi, class Sched, bool ALIGN_EPI = false, bool SP2 = false>
__device__ __forceinline__ void gemm_phase(PG8_LAS unsigned char* lds, const Gemm g, const Sched& S, const Epi& E) {
    const int tid = threadIdx.x, wid = __builtin_amdgcn_readfirstlane(tid >> 6), lane = tid & 63, wr = wid >> 2, wc = wid & 3, fr = lane & 15, fq = lane >> 4;
    const int K = g.K, nt = K / BK;
    unsigned voffA[2], voffB[2];
#pragma unroll
    for (int i = 0; i < 2; ++i) { int R, C; stage_rc(tid * 16 + i * 8192, R, C); const int Rb = Epi::PERM ? ((R & ~31) + perm32(R & 31)) : R;
        voffA[i] = (unsigned)(R * K + C) * 2u; voffB[i] = (unsigned)(Rb * K + C) * 2u; }
    const size_t kstep = (size_t)(BK * 2);
    const size_t hstep = (size_t)HALF * K * 2;
    const size_t tstep = 2 * hstep;
    const unsigned ldsw = (unsigned)wid * 1024u;
    const int aoff = lds_byte(wr * 64 + fr, fq * 8), boff = lds_byte(wc * 32 + fr, fq * 8);
#define PG8_SA(b, h) (((b) * 2 + (h)) * HTB)
#define PG8_SB(b, h) ((4 + (b) * 2 + (h)) * HTB)
#define PG8_STAGE(bufoff, gbase, voff) do { _Pragma("unroll") for (int _i = 0; _i < 2; ++_i) \
        __builtin_amdgcn_global_load_lds((const unsigned*)((const char*)(gbase) + (voff)[_i]), (PG8_LAS unsigned*)(lds + (bufoff) + ldsw + _i * 8192), 16, 0, 0); } while (0)
#define PG8_LDA(dst, b, h) do { _Pragma("unroll") for (int m = 0; m < 4; ++m) _Pragma("unroll") for (int k = 0; k < 2; ++k) dst[m][k] = *(const PG8_LAS bf16x8*)(lds + PG8_SA(b, h) + aoff + m * 2048 + k * 1024); } while (0)
#define PG8_LDB(dst, b, h) do { _Pragma("unroll") for (int n = 0; n < 2; ++n) _Pragma("unroll") for (int k = 0; k < 2; ++k) dst[n][k] = *(const PG8_LAS bf16x8*)(lds + PG8_SB(b, h) + boff + n * 2048 + k * 1024); } while (0)
#define PG8_MMA(ai, bj, At, Bt) do { __builtin_amdgcn_s_setprio(1); _Pragma("unroll") for (int m = 0; m < 4; ++m) _Pragma("unroll") for (int n = 0; n < 2; ++n) _Pragma("unroll") for (int k = 0; k < 2; ++k) \
        acc[ai][bj][m][n] = __builtin_amdgcn_mfma_f32_16x16x32_bf16(Bt[n][k], At[m][k], acc[ai][bj][m][n], 0, 0, 0); __builtin_amdgcn_s_setprio(0); } while (0)
#define PG8_WAIT_V(n) asm volatile("s_waitcnt vmcnt(" #n ")" ::: "memory")
#define PG8_WAIT_L(n) asm volatile("s_waitcnt lgkmcnt(" #n ")" ::: "memory")
#define PG8_BAR __builtin_amdgcn_s_barrier()
#define PG8_SCHED __builtin_amdgcn_sched_barrier(0)
    Unit cur, nxt; int ui = 0;
    if (!S.next(0, cur)) return;
    f32x4 acc[2][2][4][2];
#pragma unroll
    for (int a = 0; a < 2; ++a)
#pragma unroll
        for (int b = 0; b < 2; ++b)
#pragma unroll
            for (int m = 0; m < 4; ++m)
#pragma unroll
                for (int n = 0; n < 2; ++n) acc[a][b][m][n] = (f32x4){0.f, 0.f, 0.f, 0.f};
    bf16x8 At[4][2], B0[2][2], B1[2][2];
    const char* cA = (const char*)g.A + (size_t)cur.pm * tstep; const char* cB = (const char*)g.Bt + (size_t)cur.pn * tstep;
    S.a_ready(cur);
    if constexpr (SP2) {
        PG8_STAGE(PG8_SB(0, 0), cB, voffB); PG8_STAGE(PG8_SB(0, 1), cB + hstep, voffB); PG8_STAGE(PG8_SA(0, 0), cA, voffA); PG8_STAGE(PG8_SA(0, 1), cA + hstep, voffA);
        if (wr == 1) PG8_BAR;
        PG8_WAIT_V(2); PG8_BAR;
        PG8_STAGE(PG8_SB(1, 0), cB + kstep, voffB); PG8_STAGE(PG8_SA(1, 0), cA + kstep, voffA); PG8_STAGE(PG8_SB(1, 1), cB + hstep + kstep, voffB);
        PG8_WAIT_V(6); PG8_BAR;
    } else {
        PG8_STAGE(PG8_SB(0, 0), cB, voffB); PG8_STAGE(PG8_SA(0, 0), cA, voffA); PG8_STAGE(PG8_SB(0, 1), cB + hstep, voffB); PG8_STAGE(PG8_SA(0, 1), cA + hstep, voffA);
        if (wr == 1) PG8_BAR;
        PG8_WAIT_V(4); PG8_BAR;
        PG8_STAGE(PG8_SB(1, 0), cB + kstep, voffB); PG8_STAGE(PG8_SA(1, 0), cA + kstep, voffA); PG8_STAGE(PG8_SB(1, 1), cB + hstep + kstep, voffB);
        PG8_WAIT_V(6); PG8_BAR;
    }
    for (;;) {
        const bool has_next = S.next(ui + 1, nxt);
        const char* nA = has_next ? (const char*)g.A + (size_t)nxt.pm * tstep : cA; const char* nB = has_next ? (const char*)g.Bt + (size_t)nxt.pn * tstep : cB;
        for (int t = 0; t < nt; t += 2) {
            const bool last = (t == nt - 2);
            const char* a1 = cA + (size_t)(t + 1) * kstep;
            const char* a2 = last ? nA : cA + (size_t)(t + 2) * kstep; const char* b2 = last ? nB : cB + (size_t)(t + 2) * kstep;
            const char* a3 = a2 + kstep; const char* b3 = b2 + kstep;
            if (last && has_next) S.a_ready(nxt);
            if constexpr (SP2) {
            PG8_LDB(B0, 0, 0); PG8_LDB(B1, 0, 1); PG8_SCHED; PG8_LDA(At, 0, 0); PG8_STAGE(PG8_SA(1, 1), a1 + hstep, voffA);
            PG8_WAIT_V(8); PG8_WAIT_L(0); PG8_BAR; PG8_MMA(0, 0, At, B0); PG8_MMA(0, 1, At, B1); PG8_BAR; PG8_SCHED;
            PG8_LDA(At, 0, 1); PG8_STAGE(PG8_SB(0, 0), b2, voffB); PG8_STAGE(PG8_SB(0, 1), b2 + hstep, voffB); PG8_STAGE(PG8_SA(0, 0), a2, voffA);
            PG8_WAIT_V(8); PG8_WAIT_L(0); PG8_BAR; PG8_MMA(1, 0, At, B0); PG8_MMA(1, 1, At, B1); PG8_BAR; PG8_SCHED;
            PG8_LDB(B0, 1, 0); PG8_LDB(B1, 1, 1); PG8_SCHED; PG8_LDA(At, 1, 0); PG8_STAGE(PG8_SA(0, 1), a2 + hstep, voffA);
            PG8_WAIT_V(8); PG8_WAIT_L(0); PG8_BAR; PG8_MMA(0, 0, At, B0); PG8_MMA(0, 1, At, B1); PG8_BAR; PG8_SCHED;
            PG8_LDA(At, 1, 1); PG8_STAGE(PG8_SB(1, 0), b3, voffB); PG8_STAGE(PG8_SB(1, 1), b3 + hstep, voffB); PG8_STAGE(PG8_SA(1, 0), a3, voffA);
            PG8_WAIT_V(8); PG8_WAIT_L(0); PG8_BAR; PG8_MMA(1, 0, At, B0); PG8_MMA(1, 1, At, B1); PG8_BAR; PG8_SCHED;
            } else {
            PG8_LDB(B0, 0, 0); PG8_SCHED; PG8_LDA(At, 0, 0); PG8_STAGE(PG8_SA(1, 1), a1 + hstep, voffA);
            PG8_WAIT_L(8); PG8_BAR; PG8_WAIT_L(0); PG8_MMA(0, 0, At, B0); PG8_BAR; PG8_SCHED;
            PG8_LDB(B1, 0, 1); PG8_STAGE(PG8_SB(0, 0), b2, voffB);
            PG8_BAR; PG8_WAIT_L(0); PG8_MMA(0, 1, At, B1); PG8_BAR;
            PG8_LDA(At, 0, 1); PG8_STAGE(PG8_SA(0, 0), a2, voffA);
            PG8_BAR; PG8_WAIT_L(0); PG8_MMA(1, 0, At, B0); PG8_BAR; PG8_SCHED;
            PG8_STAGE(PG8_SB(0, 1), b2 + hstep, voffB);
            PG8_WAIT_V(6); PG8_BAR; PG8_MMA(1, 1, At, B1); PG8_BAR;
            PG8_LDB(B0, 1, 0); PG8_SCHED; PG8_LDA(At, 1, 0); PG8_STAGE(PG8_SA(0, 1), a2 + hstep, voffA);
            PG8_WAIT_L(8); PG8_BAR; PG8_WAIT_L(0); PG8_MMA(0, 0, At, B0); PG8_BAR; PG8_SCHED;
            PG8_LDB(B1, 1, 1); PG8_STAGE(PG8_SB(1, 0), b3, voffB);
            PG8_BAR; PG8_WAIT_L(0); PG8_MMA(0, 1, At, B1); PG8_BAR;
            PG8_LDA(At, 1, 1); PG8_STAGE(PG8_SA(1, 0), a3, voffA);
            PG8_BAR; PG8_WAIT_L(0); PG8_MMA(1, 0, At, B0); PG8_BAR; PG8_SCHED;
            PG8_STAGE(PG8_SB(1, 1), b3 + hstep, voffB);
            PG8_WAIT_V(6); PG8_BAR; PG8_MMA(1, 1, At, B1); PG8_BAR;
            }
        }
        if constexpr (ALIGN_EPI) { if (wr == 0) PG8_BAR; }
        if constexpr (!Epi::AFTER_DRAIN) { E(acc, cur, wr, wc, fr, fq); S.done(cur); }
        if (!has_next) break;
#pragma unroll
        for (int a = 0; a < 2; ++a)
#pragma unroll
            for (int b = 0; b < 2; ++b)
#pragma unroll
                for (int m = 0; m < 4; ++m)
#pragma unroll
                    for (int n = 0; n < 2; ++n) acc[a][b][m][n] = (f32x4){0.f, 0.f, 0.f, 0.f};
        cur = nxt; cA = nA; cB = nB; ++ui;
        if constexpr (ALIGN_EPI) { if (wr == 1) PG8_BAR; }
    }
    PG8_WAIT_V(0);
    if constexpr (!ALIGN_EPI) { if (wr == 0) PG8_BAR; }
    PG8_BAR;
    if constexpr (Epi::AFTER_DRAIN) { E.fused(acc, cur, wr, wc, fr, fq, lds, wid, lane); S.done(cur); }
#undef PG8_SA
#undef PG8_SB
#undef PG8_STAGE
#undef PG8_LDA
#undef PG8_LDB
#undef PG8_MMA
#undef PG8_WAIT_V
#undef PG8_WAIT_L
#undef PG8_BAR
#undef PG8_SCHED
}
}

constexpr int NWAVES = 8;
constexpr int BATCH = 2, SEQ = 8192, DM = 2048, M = BATCH * SEQ, RW = 1024, NH = 16, HD = 64, PLE_DIM = 256, INW = 8320;
constexpr float RMS_EPS = 1e-6f, LNX_EPS = 64e-5f, L2_EPS = 1e-12f;
constexpr float SB_CUT = -104.0f;
#ifndef MK_N_LAUNCHES
#define MK_N_LAUNCHES 1
#endif
constexpr int N_PHASES = 8;
constexpr size_t MiB = 1u << 20;
constexpr size_t WS_CTL = 0, CTL_ZERO_BYTES = 64 * 1024;
constexpr size_t WS_Z = 1 * MiB;
constexpr size_t WS_WDEC = WS_Z, WS_ACO = WS_Z + 64 * MiB;
constexpr size_t WS_H1B = WS_Z;
constexpr size_t WS_W2T = 98 * MiB, WS_W3T = 106 * MiB, WS_WPT = 114 * MiB, WS_PB = 115 * MiB;
constexpr size_t WS_R = 123 * MiB, WS_K = 155 * MiB, WS_V = 187 * MiB, WS_G = 219 * MiB;
constexpr size_t WS_Q = 251 * MiB, WS_KS = 283 * MiB, WS_VT = 315 * MiB, WS_GS = 347 * MiB;
constexpr size_t WS_LORA = 379 * MiB;
constexpr size_t WS_MIX = 387 * MiB;
constexpr size_t WS_YRAW = WS_Q;
constexpr size_t WS_MIXOUT = WS_R;
constexpr size_t WS_PLERAW = WS_Q;
constexpr size_t WS_PLEN = WS_MIX;
constexpr size_t WS_END = 451 * MiB;
constexpr int CW_BAR = 1024;
constexpr int RING_OFF = 0, RING_BYTES = 131072;
constexpr int LDSCTL_OFF = RING_BYTES, MISC_OFF = LDSCTL_OFF + 320;
constexpr int LDS_BYTES = 147456;

#define GAS __attribute__((address_space(1)))
#define LAS __attribute__((address_space(3)))
typedef unsigned short bf16;
typedef unsigned v4u __attribute__((ext_vector_type(4)));
typedef float f32x4 __attribute__((ext_vector_type(4)));
typedef short bf16x8 __attribute__((ext_vector_type(8)));
typedef GAS unsigned gu32;
typedef GAS unsigned long long gu64;
#define RLX_AGENT __ATOMIC_RELAXED, __HIP_MEMORY_SCOPE_AGENT
#define LDS_WAIT() asm volatile("s_waitcnt lgkmcnt(0)" ::: "memory")
#define VM_WAIT() asm volatile("s_waitcnt vmcnt(0)" ::: "memory")
__device__ __forceinline__ unsigned long long rt() { return __builtin_amdgcn_s_memrealtime(); }
__device__ __forceinline__ unsigned f2bf(float f) { unsigned u = __builtin_bit_cast(unsigned, f); return (u + 0x7fffu + ((u >> 16) & 1u)) >> 16; }
__device__ __forceinline__ unsigned pk2(float lo, float hi) { return f2bf(lo) | (f2bf(hi) << 16); }

#define XB_TMO      128
#define XB_XCNT(j)  (256  + 64 * (j))
#define XB_XSUB(j)  (1280 + 64 * (j))
#define XB_XGEN(j)  (2304 + 64 * (j))
#define XB_TOP      3328
#define XB_TOPGEN   3392
#define XCD_BAR_WORDS 3456
#define XB_SPIN_CAP (1u << 18)

__device__ __forceinline__ unsigned xb_ld(unsigned* p)              { return __hip_atomic_load(p, __ATOMIC_RELAXED, __HIP_MEMORY_SCOPE_AGENT); }
__device__ __forceinline__ unsigned xb_add(unsigned* p, unsigned v) { return __hip_atomic_fetch_add(p, v, __ATOMIC_RELAXED, __HIP_MEMORY_SCOPE_AGENT); }
__device__ __forceinline__ unsigned xb_xcc_id() { return (unsigned)__builtin_amdgcn_s_getreg((3 << 11) | 20) & 0xFu; }
#define XB_SPIN(cond, bar) do { unsigned _sp = 0; while (cond) { __builtin_amdgcn_s_sleep(1); \
    if ((++_sp & 255u) == 0u) { if (xb_ld(&(bar)[XB_TMO])) break; if (_sp > XB_SPIN_CAP) { atomicAdd(&(bar)[XB_TMO], 1u); break; } } } } while (0)

struct XcdBarrier {
    unsigned* bar; unsigned x;
    volatile LAS unsigned* st;
};

__device__ __forceinline__ XcdBarrier xcd_barrier_post(unsigned* bar, volatile LAS unsigned* st) {
    XcdBarrier b; b.bar = bar; b.x = xb_xcc_id(); b.st = st;
    if (threadIdx.x == 0) (void)xb_add(&bar[XB_XCNT(b.x)], 1u);
    return b;
}
__device__ __forceinline__ void xcd_barrier_complete(unsigned* bar, unsigned x, unsigned& nloc, unsigned& nx) {
    const unsigned G = gridDim.x * gridDim.y * gridDim.z;
    unsigned sum, cnt, mine, sp = 0u;
    for (;;) {
        sum = 0u; cnt = 0u; mine = 0u;
#pragma unroll
        for (unsigned j = 0; j < 16; ++j) { const unsigned c = xb_ld(&bar[XB_XCNT(j)]); sum += c; cnt += (c > 0u) ? 1u : 0u; mine = (j == x) ? c : mine; }
        if (sum == G) break;
        __builtin_amdgcn_s_sleep(1);
        if ((++sp & 255u) == 0u) { if (xb_ld(&bar[XB_TMO])) break; if (sp > XB_SPIN_CAP) { atomicAdd(&bar[XB_TMO], 1u); break; } }
    }
    nloc = mine > 0u ? mine : 1u; nx = cnt > 0u ? cnt : 1u;
}

__device__ __forceinline__ void xcd_barrier(const XcdBarrier& b) {
    asm volatile("s_waitcnt vmcnt(0)" ::: "memory");
    __syncthreads();
    if (threadIdx.x == 0) {
        unsigned* bar = b.bar;
        __builtin_amdgcn_s_waitcnt(0);
        unsigned nloc = b.st[0], nx = b.st[1];
        if (nloc == 0u) { xcd_barrier_complete(bar, b.x, nloc, nx); b.st[0] = nloc; b.st[1] = nx; }
        const unsigned old = xb_add(&bar[XB_XSUB(b.x)], 1u);
        const unsigned gen = old / nloc;
        if (old + 1u == (gen + 1u) * nloc) {
            __builtin_amdgcn_fence(__ATOMIC_RELEASE, "agent");
            asm volatile("s_waitcnt vmcnt(0)" ::: "memory");
            const unsigned og = xb_add(&bar[XB_TOP], 1u);
            const unsigned tg = og / nx;
            if (og + 1u == (tg + 1u) * nx) xb_add(&bar[XB_TOPGEN], 1u);
            else XB_SPIN(xb_ld(&bar[XB_TOPGEN]) == tg, bar);
            __builtin_amdgcn_fence(__ATOMIC_ACQUIRE, "agent");
            xb_add(&bar[XB_XGEN(b.x)], 1u);
            asm volatile("s_waitcnt vmcnt(0)" ::: "memory");
        } else {
            XB_SPIN(xb_ld(&bar[XB_XGEN(b.x)]) == gen, bar);
            __builtin_amdgcn_fence(__ATOMIC_ACQUIRE, "agent");
            asm volatile("s_waitcnt vmcnt(0)" ::: "memory");
        }
    }
    __syncthreads();
}

typedef float f32x16 __attribute__((ext_vector_type(16)));
typedef unsigned u32x2 __attribute__((ext_vector_type(2)));
typedef unsigned u32x4 __attribute__((ext_vector_type(4)));
struct Frame {
    LAS unsigned char* lds; volatile LAS unsigned* MISC; gu32* ctl;
    int tid, lane, wave, vcu, G;
};
__device__ __forceinline__ float bf2f(bf16 b) { return __uint_as_float((unsigned)b << 16); }
__device__ __forceinline__ float bflo(unsigned w) { return __uint_as_float(w << 16); }
__device__ __forceinline__ float bfhi(unsigned w) { return __uint_as_float(w & 0xffff0000u); }
template <int CTRL, int RMASK> __device__ __forceinline__ float dppadd(float x) {
    const int m = __builtin_amdgcn_update_dpp(0, __builtin_bit_cast(int, x), CTRL, RMASK, 0xF, false);
    return x + __builtin_bit_cast(float, m);
}
__device__ __forceinline__ float dpp_sum63(float x) {
    x = dppadd<0xB1, 0xF>(x); x = dppadd<0x4E, 0xF>(x); x = dppadd<0x141, 0xF>(x); x = dppadd<0x140, 0xF>(x);
    x = dppadd<0x142, 0xA>(x); x = dppadd<0x143, 0xC>(x); return x;
}
__device__ __forceinline__ float rdlane(float x, int l) { return __builtin_bit_cast(float, __builtin_amdgcn_readlane(__builtin_bit_cast(int, x), l)); }
__device__ __forceinline__ float wave_allsum(float x) { return rdlane(dpp_sum63(x), 63); }
__device__ __forceinline__ float row16_allsum(float x) { x = dppadd<0xB1, 0xF>(x); x = dppadd<0x4E, 0xF>(x); x = dppadd<0x141, 0xF>(x); x = dppadd<0x140, 0xF>(x); return x; }

__device__ __forceinline__ void p0_transpose_tile(const float* W, int ldw, int k0, int sn0, bf16* WT, int K, int dn0, LAS float* scr, int lane) {
#pragma unroll 8
    for (int i = 0; i < 32; ++i) { const int kk = 2 * i + (lane >> 5); scr[kk * 33 + (lane & 31)] = sn0 >= 0 ? W[(size_t)(k0 + kk) * ldw + sn0 + (lane & 31)] : 0.f; }
    LDS_WAIT(); asm volatile("" ::: "memory");
    const int c = lane & 7;
#pragma unroll
    for (int j = 0; j < 4; ++j) { const int n = (lane >> 3) + 8 * j; const LAS float* s = scr + (8 * c) * 33 + n;
        v4u o; o.x = pk2(s[0 * 33], s[1 * 33]); o.y = pk2(s[2 * 33], s[3 * 33]); o.z = pk2(s[4 * 33], s[5 * 33]); o.w = pk2(s[6 * 33], s[7 * 33]);
        *(GAS v4u*)(WT + (size_t)(dn0 + n) * K + k0 + 8 * c) = o; }
    LDS_WAIT(); asm volatile("" ::: "memory");
}
__device__ __forceinline__ int w1_src_col(int n) {
    if (n < 3072) return n;
    if (n < 4096) return 3200 + (n - 3072);
    if (n < 5120) return 4224 + (n - 4096);
    if (n < 6144) return 5248 + (n - 5120);
    if (n < 7168) return 7296 + (n - 6144);
    if (n < 7296) return 3072 + (n - 7168);
    if (n < 7424) return -1;
    return 6272 + (n - 7424);
}
struct In { const float *x, *p, *g_pre, *w_in, *mu, *w0, *w_up, *a0, *a_up, *k_k, *k_a, *r_k, *lnx_w, *lnx_b, *w_out, *g_post, *w_ple, *w_plg, *g_ple; };

__device__ __forceinline__ void p0_prologue(Frame& F, const In& I, unsigned char* ws) {
    LAS float* scr = (LAS float*)(F.lds + RING_OFF + F.wave * 16384);
    const int gw = F.vcu * NWAVES + F.wave, NGW = F.G * NWAVES, lane = F.lane;
    bf16* Z = (bf16*)(ws + WS_Z); bf16* W1T = Z + (size_t)64 * 256 * DM;
    constexpr int I_1 = 264 * 32, I_2 = 64 * 32, I_3 = 64 * 32, I_P = 64 * 4;
    constexpr int NITEMS = I_1 + I_2 + I_3 + I_P;
    for (int it = gw; it < NITEMS; it += NGW) {
        int r = it;
        if (r < I_1) { const int nb = r % 264, kb = r / 264; p0_transpose_tile(I.w_in, INW, kb * 64, w1_src_col(nb * 32), W1T, DM, nb * 32, scr, lane); continue; } r -= I_1;
        if (r < I_2) { const int nb = r % 64, kb = r / 64; p0_transpose_tile(I.w_out, DM, kb * 64, nb * 32, (bf16*)(ws + WS_W2T), DM, nb * 32, scr, lane); continue; } r -= I_2;
        if (r < I_3) { const int nb = r % 64, kb = r / 64; p0_transpose_tile(I.w_plg, DM, kb * 64, nb * 32, (bf16*)(ws + WS_W3T), DM, nb * 32, scr, lane); continue; } r -= I_3;
        { const int nb = r % 64, kb = r / 64; p0_transpose_tile(I.w_ple, DM, kb * 64, nb * 32, (bf16*)(ws + WS_WPT), PLE_DIM, nb * 32, scr, lane); }
    }
    for (int m = gw; m < M; m += NGW) {
        const GAS f32x4* xr = (const GAS f32x4*)(I.x + (size_t)m * DM) + lane; const GAS f32x4* gr = (const GAS f32x4*)I.g_pre + lane;
        f32x4 v[8]; float s = 0.f;
#pragma unroll
        for (int j = 0; j < 8; ++j) { v[j] = xr[64 * j]; s += (v[j].x * v[j].x + v[j].y * v[j].y) + (v[j].z * v[j].z + v[j].w * v[j].w); }
        const float rinv = 1.0f / sqrtf(wave_allsum(s) * (1.0f / DM) + RMS_EPS);
        GAS u32x2* o8 = (GAS u32x2*)(Z + (size_t)m * DM) + lane;
#pragma unroll
        for (int j = 0; j < 8; ++j) { const f32x4 g = gr[64 * j]; u32x2 o; o.x = pk2(v[j].x * rinv * g.x, v[j].y * rinv * g.y); o.y = pk2(v[j].z * rinv * g.z, v[j].w * rinv * g.w); o8[64 * j] = o; }
    }
    { const GAS f32x4* pr = (const GAS f32x4*)I.p; GAS u32x2* po = (GAS u32x2*)(ws + WS_PB); const int n4 = M * PLE_DIM / 4;
      for (int i = gw * 64 + lane; i < n4; i += NGW * 64) { const f32x4 v = pr[i]; u32x2 o; o.x = pk2(v.x, v.y); o.y = pk2(v.z, v.w); po[i] = o; } }
}

__device__ __forceinline__ void p2_lora(Frame& F, const In& I, unsigned char* ws) {
    LAS float* th = (LAS float*)(F.lds + RING_OFF); LAS float* ad = th + 64 * 64;
    const bf16* LORA = (const bf16*)(ws + WS_LORA); float* WDEC = (float*)(ws + WS_WDEC); bf16* ACO = (bf16*)(ws + WS_ACO);
    const int tid = F.tid;
    for (int it = F.vcu; it < M / 64; it += F.G) {
        const int row0 = it * 64;
        __syncthreads();
        for (int e = tid; e < 64 * 128; e += NWAVES * 64) { const int tok = e >> 7, j = e & 127; const int row = row0 + tok;
            const float cur = bf2f(LORA[(size_t)row * 256 + j]); const float prev = (row % SEQ) ? bf2f(LORA[(size_t)(row - 1) * 256 + j]) : 0.f;
            const float sv = cur + (prev - cur) * I.mu[3072 + j];
            if (j < 64) { const float e2 = __expf(2.0f * sv); th[tok * 64 + j] = 1.0f - 2.0f / (e2 + 1.0f); } else ad[tok * 64 + (j - 64)] = sv; }
        __syncthreads();
#pragma unroll 1
        for (int cc = 0; cc < 2; ++cc) { const int c = tid + cc * 512;
            float wc[64];
#pragma unroll
            for (int j = 0; j < 64; ++j) wc[j] = I.w_up[j * RW + c];
            const float b0 = I.w0[c];
#pragma unroll 2
            for (int tok = 0; tok < 64; ++tok) { float acc0 = b0, acc1 = 0.f;
#pragma unroll
                for (int j = 0; j < 64; j += 8) { const f32x4 t0 = *(const LAS f32x4*)(th + tok * 64 + j), t1 = *(const LAS f32x4*)(th + tok * 64 + j + 4);
                    acc0 += t0.x * wc[j] + t0.y * wc[j + 1] + t0.z * wc[j + 2] + t0.w * wc[j + 3]; acc1 += t1.x * wc[j + 4] + t1.y * wc[j + 5] + t1.z * wc[j + 6] + t1.w * wc[j + 7]; }
                const float xw = acc0 + acc1; const float sg = 1.0f / (1.0f + __expf(-xw));
                WDEC[(size_t)(row0 + tok) * RW + c] = __expf(-0.60653065971263342f * sg); }
#pragma unroll
            for (int j = 0; j < 64; ++j) wc[j] = I.a_up[j * RW + c];
            const float b1 = I.a0[c];
#pragma unroll 2
            for (int tok = 0; tok < 64; ++tok) { float acc0 = b1, acc1 = 0.f;
#pragma unroll
                for (int j = 0; j < 64; j += 8) { const f32x4 t0 = *(const LAS f32x4*)(ad + tok * 64 + j), t1 = *(const LAS f32x4*)(ad + tok * 64 + j + 4);
                    acc0 += t0.x * wc[j] + t0.y * wc[j + 1] + t0.z * wc[j + 2] + t0.w * wc[j + 3]; acc1 += t1.x * wc[j + 4] + t1.y * wc[j + 5] + t1.z * wc[j + 6] + t1.w * wc[j + 7]; }
                const float xa = acc0 + acc1;
                ACO[(size_t)(row0 + tok) * RW + c] = (bf16)f2bf(1.0f / (1.0f + __expf(-xa))); }
        }
    }
    __syncthreads();
}

__device__ __forceinline__ int crow(int r, int hi) { return (r & 3) + 8 * (r >> 2) + 4 * hi; }
__device__ __forceinline__ float softplusf(float z) { return fmaxf(z, 0.f) + __logf(1.0f + __expf(-fabsf(z))); }
__device__ __forceinline__ void attn_tile(const bf16* Q, const bf16* KS, const bf16* VT, const bf16* GS, bf16* MIX, int b, int h, int qt, int lane) {
    const int r32 = lane & 31, hi = lane >> 5, t0 = qt * 32; const size_t rowb = (size_t)b * SEQ;
    bf16x8 qf[4];
    { const bf16* qp = Q + (rowb + t0 + r32) * 1024 + h * 64 + hi * 8;
#pragma unroll
      for (int d0 = 0; d0 < 4; ++d0) qf[d0] = *(const GAS bf16x8*)(qp + d0 * 16); }
    f32x16 o0 = {}, o1 = {}; float R = 0.f;
    const bf16* vt0 = VT + (size_t)(h * 64 + r32) * M + rowb + 4 * hi;
    for (int kb = qt; kb >= 0; --kb) {
        const int s0 = kb * 32;
        bf16x8 kf[4];
        { const bf16* kp = KS + (rowb + s0 + r32) * 1024 + h * 64 + hi * 8;
#pragma unroll
          for (int d0 = 0; d0 < 4; ++d0) kf[d0] = *(const GAS bf16x8*)(kp + d0 * 16); }
        u32x2 va[2][2][2];
#pragma unroll
        for (int dt = 0; dt < 2; ++dt)
#pragma unroll
            for (int s = 0; s < 2; ++s)
#pragma unroll
                for (int hf = 0; hf < 2; ++hf) va[dt][s][hf] = *(const GAS u32x2*)(vt0 + (size_t)dt * 32 * M + s0 + 16 * s + 8 * hf);
        f32x16 p = {};
#pragma unroll
        for (int d0 = 0; d0 < 4; ++d0) p = __builtin_amdgcn_mfma_f32_32x32x16_bf16(kf[d0], qf[d0], p, 0, 0, 0);
        const bool diag = (kb == qt);
        float l1[16], lb[16];
#pragma unroll
        for (int r = 0; r < 16; ++r) { const float z = p[r]; const float sp = softplusf(z); const bool valid = !diag || (crow(r, hi) < r32); l1[r] = valid ? -sp : 0.f; lb[r] = valid ? (z - sp) : -INFINITY; }
        float mine[4], oth[4], tot[4];
#pragma unroll
        for (int g = 0; g < 4; ++g) { mine[g] = (l1[4 * g] + l1[4 * g + 1]) + (l1[4 * g + 2] + l1[4 * g + 3]);
            auto rr = __builtin_amdgcn_permlane32_swap(__float_as_uint(mine[g]), __float_as_uint(mine[g]), false, false);
            const float lo = __uint_as_float(rr[0]), up = __uint_as_float(rr[1]); oth[g] = hi ? lo : up; tot[g] = lo + up; }
        float T[4]; T[3] = 0.f; T[2] = tot[3]; T[1] = T[2] + tot[2]; T[0] = T[1] + tot[1];
        float w[16];
#pragma unroll
        for (int g = 0; g < 4; ++g) { float e = T[g] + (hi ? 0.f : oth[g]) + R;
            w[4 * g + 3] = __expf(lb[4 * g + 3] + e); e += l1[4 * g + 3];
            w[4 * g + 2] = __expf(lb[4 * g + 2] + e); e += l1[4 * g + 2];
            w[4 * g + 1] = __expf(lb[4 * g + 1] + e); e += l1[4 * g + 1];
            w[4 * g + 0] = __expf(lb[4 * g + 0] + e); }
        R += T[0] + tot[0];
        u32x4 pb0, pb1;
        pb0.x = pk2(w[0], w[1]); pb0.y = pk2(w[2], w[3]); pb0.z = pk2(w[4], w[5]); pb0.w = pk2(w[6], w[7]);
        pb1.x = pk2(w[8], w[9]); pb1.y = pk2(w[10], w[11]); pb1.z = pk2(w[12], w[13]); pb1.w = pk2(w[14], w[15]);
        const bf16x8 pB0 = __builtin_bit_cast(bf16x8, pb0), pB1 = __builtin_bit_cast(bf16x8, pb1);
#define VA(dt, s) __builtin_bit_cast(bf16x8, (u32x4){va[dt][s][0].x, va[dt][s][0].y, va[dt][s][1].x, va[dt][s][1].y})
        o0 = __builtin_amdgcn_mfma_f32_32x32x16_bf16(VA(0, 0), pB0, o0, 0, 0, 0); o0 = __builtin_amdgcn_mfma_f32_32x32x16_bf16(VA(0, 1), pB1, o0, 0, 0, 0);
        o1 = __builtin_amdgcn_mfma_f32_32x32x16_bf16(VA(1, 0), pB0, o1, 0, 0, 0); o1 = __builtin_amdgcn_mfma_f32_32x32x16_bf16(VA(1, 1), pB1, o1, 0, 0, 0);
#undef VA
        if (__all(R < SB_CUT)) break;
    }
    const size_t row = rowb + t0 + r32;
#pragma unroll
    for (int dt = 0; dt < 2; ++dt)
#pragma unroll
        for (int g = 0; g < 4; ++g) { const int d = dt * 32 + 8 * g + 4 * hi; const u32x2 gw = *(const GAS u32x2*)(GS + row * 1024 + h * 64 + d);
            float gv[4] = {bflo(gw.x), bfhi(gw.x), bflo(gw.y), bfhi(gw.y)}; float ov[4];
#pragma unroll
            for (int e = 0; e < 4; ++e) { const float o = dt ? o1[4 * g + e] : o0[4 * g + e]; ov[e] = o * gv[e] / (1.0f + __expf(-gv[e])); }
            u32x2 st; st.x = pk2(ov[0], ov[1]); st.y = pk2(ov[2], ov[3]); *(GAS u32x2*)(MIX + row * 2048 + 1024 + h * 64 + d) = st; }
}
__device__ __forceinline__ void p2_attention(Frame& F, unsigned char* ws) {
    const bf16 *Q = (const bf16*)(ws + WS_Q), *KS = (const bf16*)(ws + WS_KS), *VT = (const bf16*)(ws + WS_VT), *GS = (const bf16*)(ws + WS_GS); bf16* MIX = (bf16*)(ws + WS_MIX);
    const int gw = F.vcu * NWAVES + F.wave, NGW = F.G * NWAVES;
    for (int u = gw; u < BATCH * NH * (SEQ / 32); u += NGW) { const int qt = u & 255, bh = u >> 8; attn_tile(Q, KS, VT, GS, MIX, bh >> 4, bh & 15, qt, F.lane); }
}

constexpr int TC = 32;
constexpr int SC_VEC = 0, SC_R = TC * 64 * 16, SC_V = SC_R + TC * 64 * 4, SC_BUF = SC_V + TC * 8 * 4;
struct ScanRegs { u32x2 rc, rp, kc, kp, ac; f32x4 wv; unsigned vc, vp; };
__device__ __forceinline__ void p3_scan(Frame& F, const In& I, unsigned char* ws) {
    const int tid = F.tid, lane = F.lane, wave = F.wave;
    const bf16 *Rb = (const bf16*)(ws + WS_R), *Kb = (const bf16*)(ws + WS_K), *Vb = (const bf16*)(ws + WS_V), *ACO = (const bf16*)(ws + WS_ACO); const float* WDEC = (const float*)(ws + WS_WDEC);
    float* YRAW = (float*)(ws + WS_YRAW);
    for (int unit = blockIdx.x; unit < 256; unit += F.G) {
        const int xcd = unit & 7, slot = unit >> 3, bh = xcd * 4 + (slot >> 3), rg = slot & 7, b = bh >> 4, h = bh & 15;
        const size_t rowb = (size_t)b * SEQ;
        const int sj = tid >> 4, kq = tid & 15, c0 = h * 64 + 4 * kq;
        float mur[4], muk[4], kkc[4], kac[4];
#pragma unroll
        for (int e = 0; e < 4; ++e) { mur[e] = I.mu[c0 + e]; muk[e] = I.mu[1024 + c0 + e]; kkc[e] = I.k_k[c0 + e]; kac[e] = I.k_a[c0 + e]; }
        const int vsj = (tid >> 3) & 31, vri = tid & 7, vc = h * 64 + rg * 8 + vri; const float muv = I.mu[2048 + vc];
        auto LOAD = [&](int ch, ScanRegs& g) {
            const int t = ch * TC + sj; const size_t row = rowb + t;
            g.rc = *(const GAS u32x2*)(Rb + row * 1024 + c0); g.kc = *(const GAS u32x2*)(Kb + row * 1024 + c0); g.ac = *(const GAS u32x2*)(ACO + row * 1024 + c0);
            g.wv = *(const GAS f32x4*)(WDEC + row * 1024 + c0);
            if (t > 0) { g.rp = *(const GAS u32x2*)(Rb + (row - 1) * 1024 + c0); g.kp = *(const GAS u32x2*)(Kb + (row - 1) * 1024 + c0); } else { g.rp = (u32x2){0u, 0u}; g.kp = (u32x2){0u, 0u}; }
            if (tid < 256) { const int tv = ch * TC + vsj; const size_t rv = rowb + tv; g.vc = Vb[rv * 1024 + vc]; g.vp = tv > 0 ? (unsigned)Vb[(rv - 1) * 1024 + vc] : 0u; }
        };
        auto STAGE = [&](int buf, const ScanRegs& g) {
            LAS unsigned char* base = F.lds + RING_OFF + buf * SC_BUF;
            const float rc[4] = {bflo(g.rc.x), bfhi(g.rc.x), bflo(g.rc.y), bfhi(g.rc.y)}, rp[4] = {bflo(g.rp.x), bfhi(g.rp.x), bflo(g.rp.y), bfhi(g.rp.y)};
            const float kc[4] = {bflo(g.kc.x), bfhi(g.kc.x), bflo(g.kc.y), bfhi(g.kc.y)}, kp[4] = {bflo(g.kp.x), bfhi(g.kp.x), bflo(g.kp.y), bfhi(g.kp.y)};
            const float av[4] = {bflo(g.ac.x), bfhi(g.ac.x), bflo(g.ac.y), bfhi(g.ac.y)};
            float rs[4], ks[4], kr[4]; float ss = 0.f;
#pragma unroll
            for (int e = 0; e < 4; ++e) { rs[e] = rc[e] + (rp[e] - rc[e]) * mur[e]; ks[e] = kc[e] + (kp[e] - kc[e]) * muk[e]; kr[e] = ks[e] * kkc[e]; ss += kr[e] * kr[e]; }
            ss = row16_allsum(ss); const float inv = 1.0f / sqrtf(ss + L2_EPS);
#pragma unroll
            for (int e = 0; e < 4; ++e) { const float kk = kr[e] * inv; f32x4 o; o.x = g.wv[e]; o.y = kk; o.z = av[e] * kk; o.w = ks[e] * (1.0f + (av[e] - 1.0f) * kac[e]);
                *(LAS f32x4*)(base + SC_VEC + (sj * 64 + 4 * kq + e) * 16) = o; }
            *(LAS f32x4*)(base + SC_R + (sj * 64 + 4 * kq) * 4) = (f32x4){rs[0], rs[1], rs[2], rs[3]};
            if (tid < 256) { const float vcur = bf2f((bf16)g.vc), vprev = bf2f((bf16)g.vp); *(LAS float*)(base + SC_V + (vsj * 8 + vri) * 4) = vcur + (vprev - vcur) * muv; }
        };
        ScanRegs g;
        __syncthreads();
        LOAD(0, g); STAGE(0, g);
        __syncthreads();
        float S = 0.f;
        const int vrow = h * 64 + rg * 8 + wave;
        for (int ch = 0; ch < SEQ / TC; ++ch) {
            const int buf = ch & 1;
            if (ch + 1 < SEQ / TC) LOAD(ch + 1, g);
            const LAS unsigned char* base = F.lds + RING_OFF + buf * SC_BUF;
            const float vv = *(const LAS float*)(base + SC_V + ((lane & 31) * 8 + wave) * 4);
            float yv = 0.f;
#pragma unroll
            for (int j = 0; j < TC; ++j) {
                const f32x4 f4 = *(const LAS f32x4*)(base + SC_VEC + (j * 64 + lane) * 16);
                const float rr = *(const LAS float*)(base + SC_R + (j * 64 + lane) * 4);
                const float vt = rdlane(vv, j);
                const float sa = rdlane(dpp_sum63(S * f4.y), 63);
                S = fmaf(S, f4.x, fmaf(-sa, f4.z, vt * f4.w));
                const float yy = rdlane(dpp_sum63(S * rr), 63);
                yv = (lane == j) ? yy : yv;
            }
            if (lane < TC) YRAW[(rowb + ch * TC + lane) * 1024 + vrow] = yv;
            if (ch + 1 < SEQ / TC) STAGE(buf ^ 1, g);
            __syncthreads();
        }
    }
}

__device__ __forceinline__ void p4_rwkv_out(Frame& F, const In& I, unsigned char* ws) {
    const bf16 *Rb = (const bf16*)(ws + WS_R), *Kb = (const bf16*)(ws + WS_K), *Vb = (const bf16*)(ws + WS_V), *Gb = (const bf16*)(ws + WS_G), *ACO = (const bf16*)(ws + WS_ACO);
    const float* YRAW = (const float*)(ws + WS_YRAW); bf16* MIX = (bf16*)(ws + WS_MIX);
    const int gw = F.vcu * NWAVES + F.wave, NGW = F.G * NWAVES, lane = F.lane;
    for (int i = gw; i < M * NH; i += NGW) {
        const int row = i >> 4, h = i & 15, c = h * 64 + lane; const bool first = (row % SEQ) == 0;
        const float y = YRAW[(size_t)row * 1024 + c];
        const float mean = wave_allsum(y) * (1.0f / 64.0f); const float d = y - mean; const float var = wave_allsum(d * d) * (1.0f / 64.0f);
        const float yn = d * (1.0f / sqrtf(var + LNX_EPS)) * I.lnx_w[c] + I.lnx_b[c];
        const size_t o = (size_t)row * 1024 + c;
        const float rc = bf2f(Rb[o]), kc = bf2f(Kb[o]), vcur = bf2f(Vb[o]);
        const float rp = first ? 0.f : bf2f(Rb[o - 1024]), kp = first ? 0.f : bf2f(Kb[o - 1024]), vp = first ? 0.f : bf2f(Vb[o - 1024]);
        const float rs = rc + (rp - rc) * I.mu[c], ks = kc + (kp - kc) * I.mu[1024 + c], vs = vcur + (vp - vcur) * I.mu[2048 + c];
        const float a = bf2f(ACO[o]); const float k2 = ks * (1.0f + (a - 1.0f) * I.k_a[c]);
        const float bon = wave_allsum(rs * k2 * I.r_k[c]);
        const float g = bf2f(Gb[o]);
        const float out = (yn + bon * vs) * (g / (1.0f + __expf(-g)));
        MIX[(size_t)row * 2048 + c] = (bf16)f2bf(out);
    }
}

__device__ __forceinline__ void p6_rows(Frame& F, const In& I, unsigned char* ws, float* out) {
    const float *MIXOUT = (const float*)(ws + WS_MIXOUT), *PLERAW = (const float*)(ws + WS_PLERAW); bf16 *H1B = (bf16*)(ws + WS_H1B), *PLEN = (bf16*)(ws + WS_PLEN);
    const int gw = F.vcu * NWAVES + F.wave, NGW = F.G * NWAVES, lane = F.lane;
    for (int m = gw; m < M; m += NGW) {
        { const GAS f32x4* mr = (const GAS f32x4*)(MIXOUT + (size_t)m * DM) + lane; const GAS f32x4* xr = (const GAS f32x4*)(I.x + (size_t)m * DM) + lane; const GAS f32x4* gr = (const GAS f32x4*)I.g_post + lane;
          f32x4 v[8]; float s = 0.f;
#pragma unroll
          for (int j = 0; j < 8; ++j) { v[j] = mr[64 * j]; s += (v[j].x * v[j].x + v[j].y * v[j].y) + (v[j].z * v[j].z + v[j].w * v[j].w); }
          const float rinv = 1.0f / sqrtf(wave_allsum(s) * (1.0f / DM) + RMS_EPS);
          GAS f32x4* orow = (GAS f32x4*)(out + (size_t)m * DM) + lane; GAS u32x2* hb = (GAS u32x2*)(H1B + (size_t)m * DM) + lane;
#pragma unroll
          for (int j = 0; j < 8; ++j) { const f32x4 g = gr[64 * j], x = xr[64 * j]; f32x4 hh; hh.x = x.x + v[j].x * rinv * g.x; hh.y = x.y + v[j].y * rinv * g.y; hh.z = x.z + v[j].z * rinv * g.z; hh.w = x.w + v[j].w * rinv * g.w;
              orow[64 * j] = hh; u32x2 o; o.x = pk2(hh.x, hh.y); o.y = pk2(hh.z, hh.w); hb[64 * j] = o; } }
        { const GAS f32x4* pr = (const GAS f32x4*)(PLERAW + (size_t)m * DM) + lane; const GAS f32x4* gr = (const GAS f32x4*)I.g_ple + lane;
          f32x4 v[8]; float s = 0.f;
#pragma unroll
          for (int j = 0; j < 8; ++j) { v[j] = pr[64 * j]; s += (v[j].x * v[j].x + v[j].y * v[j].y) + (v[j].z * v[j].z + v[j].w * v[j].w); }
          const float rinv = 1.0f / sqrtf(wave_allsum(s) * (1.0f / DM) + RMS_EPS);
          GAS u32x2* pn = (GAS u32x2*)(PLEN + (size_t)m * DM) + lane;
#pragma unroll
          for (int j = 0; j < 8; ++j) { const f32x4 g = gr[64 * j]; u32x2 o; o.x = pk2(v[j].x * rinv * g.x, v[j].y * rinv * g.y); o.y = pk2(v[j].z * rinv * g.z, v[j].w * rinv * g.w); pn[64 * j] = o; } }
    }
}

struct Args { const float* in[19]; float* out; unsigned char* ws; int ph_lo, ph_hi, li, pad; };
__global__ void __launch_bounds__(NWAVES * 64, 2) hymba_fwd(Args args) {
    extern __shared__ __attribute__((aligned(16))) unsigned char lds[];
    Frame F;
    F.lds = (LAS unsigned char*)lds; F.MISC = (volatile LAS unsigned*)(F.lds + MISC_OFF);
    F.tid = threadIdx.x; F.lane = F.tid & 63; F.wave = __builtin_amdgcn_readfirstlane(F.tid >> 6);
    F.G = gridDim.x; { const int bx = blockIdx.x; F.vcu = (F.G % 8 == 0) ? (bx % 8) * (F.G / 8) + bx / 8 : bx; }
    unsigned char* ws = args.ws; F.ctl = (gu32*)(ws + WS_CTL);
    In I; I.x = args.in[0]; I.p = args.in[1]; I.g_pre = args.in[2]; I.w_in = args.in[3]; I.mu = args.in[4]; I.w0 = args.in[5]; I.w_up = args.in[6]; I.a0 = args.in[7]; I.a_up = args.in[8];
    I.k_k = args.in[9]; I.k_a = args.in[10]; I.r_k = args.in[11]; I.lnx_w = args.in[12]; I.lnx_b = args.in[13]; I.w_out = args.in[14]; I.g_post = args.in[15]; I.w_ple = args.in[16]; I.w_plg = args.in[17]; I.g_ple = args.in[18];
    for (int u = F.tid; u < (LDS_BYTES - LDSCTL_OFF) / 4; u += NWAVES * 64) ((LAS unsigned*)(F.lds + LDSCTL_OFF))[u] = 0u;
    __syncthreads();
    const bool multi = (args.ph_hi - args.ph_lo) > 1;
    XcdBarrier bar; bar.bar = (unsigned*)(F.ctl + CW_BAR); bar.x = 0; bar.st = nullptr;
    if (multi) bar = xcd_barrier_post((unsigned*)(F.ctl + CW_BAR), F.MISC + 8);
    const int lo = args.ph_lo, hi = args.ph_hi;
#define IN(k) (lo <= (k) && (k) < hi)
#define BOTH(k) (IN(k) && IN((k) + 1))
    bf16* Z = (bf16*)(ws + WS_Z);
    if (IN(0)) { p0_prologue(F, I, ws); if (BOTH(0)) xcd_barrier(bar); }
    if (IN(1)) {
        pg8::Gemm g{Z, Z, M, 8448, DM}; pg8::SchedIn S{F.G, (int)blockIdx.x};
        pg8::EpiIn E{ws, WS_R, WS_Q, WS_LORA, WS_VT};
        pg8::gemm_phase<pg8::EpiIn, pg8::SchedIn, true, true>(F.lds + RING_OFF, g, S, E);
        if (BOTH(1)) xcd_barrier(bar);
    }
    if (IN(2)) { p2_lora(F, I, ws); p2_attention(F, ws); if (BOTH(2)) xcd_barrier(bar); }
    if (IN(3)) { p3_scan(F, I, ws); if (BOTH(3)) xcd_barrier(bar); }
    if (IN(4)) { p4_rwkv_out(F, I, ws); if (BOTH(4)) xcd_barrier(bar); }
    if (IN(5)) {
        { pg8::Gemm g{(const bf16*)(ws + WS_MIX), (const bf16*)(ws + WS_W2T), M, DM, DM}; pg8::StaticOrder S; S.init(M, DM, F.G, (int)blockIdx.x);
          pg8::EpiF32 E{(float*)(ws + WS_MIXOUT), DM};
          pg8::gemm_phase<pg8::EpiF32, pg8::StaticOrder, true, true>(F.lds + RING_OFF, g, S, E); }
        __syncthreads();
        { pg8::Gemm g{(const bf16*)(ws + WS_PB), (const bf16*)(ws + WS_WPT), M, DM, PLE_DIM}; pg8::StaticOrder S; S.init(M, DM, F.G, (int)blockIdx.x);
          pg8::EpiF32 E{(float*)(ws + WS_PLERAW), DM};
          pg8::gemm_phase<pg8::EpiF32, pg8::StaticOrder, true, true>(F.lds + RING_OFF, g, S, E); }
        if (BOTH(5)) xcd_barrier(bar);
    }
    if (IN(6)) { p6_rows(F, I, ws, args.out); if (BOTH(6)) xcd_barrier(bar); }
    if (IN(7)) {
        pg8::Gemm g{(const bf16*)(ws + WS_H1B), (const bf16*)(ws + WS_W3T), M, DM, DM}; pg8::StaticOrder S; S.init(M, DM, F.G, (int)blockIdx.x);
        pg8::EpiFinal E{args.out, (const bf16*)(ws + WS_PLEN), DM};
        pg8::gemm_phase<pg8::EpiFinal, pg8::StaticOrder, true, true>(F.lds + RING_OFF, g, S, E);
    }
#undef IN
#undef BOTH
}

extern "C" void kernel_launch(void* const* d_in, const int* in_sizes, int n_in, void* d_out, int out_size, void* d_ws, size_t ws_size, hipStream_t stream) {
    static int grid = 0;
    if (grid == 0) {
        if (n_in != 19 || in_sizes[0] != M * DM || out_size != M * DM || ws_size < WS_END) { fprintf(stderr, "kernel_launch: unexpected shapes (n_in %d, in0 %d, out %d, ws %zu); nothing launched\n", n_in, n_in > 0 ? in_sizes[0] : -1, out_size, ws_size); grid = -1; return; }
        int dev = 0, cus = 0, per_cu = 0;
        if (hipGetDevice(&dev) != hipSuccess || hipDeviceGetAttribute(&cus, hipDeviceAttributeMultiprocessorCount, dev) != hipSuccess) { grid = -1; return; }
        if (hipFuncSetAttribute((const void*)hymba_fwd, hipFuncAttributeMaxDynamicSharedMemorySize, LDS_BYTES) != hipSuccess) { fprintf(stderr, "kernel_launch: hipFuncSetAttribute failed\n"); grid = -1; return; }
        if (hipOccupancyMaxActiveBlocksPerMultiprocessor(&per_cu, (const void*)hymba_fwd, NWAVES * 64, LDS_BYTES) != hipSuccess || per_cu < 1) { fprintf(stderr, "kernel_launch: occupancy query says %d\n", per_cu); }
        (void)hipGetLastError();
        grid = cus;
    }
    if (grid < 0) return;
    if (hipMemsetAsync((char*)d_ws + WS_CTL, 0, CTL_ZERO_BYTES, stream) != hipSuccess) return;
    Args a{};
    for (int i = 0; i < 19; ++i) a.in[i] = (const float*)d_in[i];
    a.out = (float*)d_out; a.ws = (unsigned char*)d_ws;
    constexpr int NL = MK_N_LAUNCHES;
    for (int li = 0; li < NL; ++li) {
        a.ph_lo = (NL == 1) ? 0 : li; a.ph_hi = (NL == 1) ? N_PHASES : li + 1; a.li = li;
        hipLaunchKernelGGL(hymba_fwd, dim3(grid), dim3(NWAVES * 64), LDS_BYTES, stream, a);
    }
}
```

```cpp
#include <hip/hip_runtime.h>
#include <cstdio>
#include <cstdint>
namespace pg8 {
#define PG8_LAS __attribute__((address_space(3)))
typedef unsigned short bf16_t;
typedef short bf16x8 __attribute__((ext_vector_type(8)));
typedef float f32x4 __attribute__((ext_vector_type(4)));
typedef unsigned u32x4 __attribute__((ext_vector_type(4)));
constexpr int BM = 256, BK = 64, HALF = 128, HTB = HALF * BK * 2  , STAGE_BYTES = 8 * HTB, NXCD = 8, WGM = 8;

__host__ __device__ __forceinline__ int lds_byte(int r, int c) { const int st = (r >> 4) * 2 + (c >> 5), rr = r & 15, cc = c & 31, ob = rr * 64 + cc * 2; return st * 1024 + (ob ^ (((ob >> 9) & 1) << 5)); }
__host__ __device__ __forceinline__ void stage_rc(int b, int& R, int& C) { const int st = b / 1024, sb = b % 1024, swz = sb ^ (((sb >> 9) & 1) << 5); R = (st >> 1) * 16 + swz / 64; C = (st & 1) * 32 + (swz % 64) / 2; }
__host__ __device__ __forceinline__ int perm32(int rho) { const int n = rho >> 4, i = rho & 15; return 8 * (i >> 2) + 4 * n + (i & 3); }

struct Unit { int pm, pn; };
struct Gemm { const bf16_t* A; const bf16_t* Bt; int M, N, K; };

struct StaticOrder {
    int nM, nN, nwg, G, c;
    __host__ __device__ void init(int M, int N, int G_, int c_) { nM = M / BM; nN = N / BM; nwg = nM * nN; G = G_; c = c_; }
    __host__ __device__ bool next(int i, Unit& u) const {
        const long L = (long)i * G + c; if (L >= nwg) return false;
        int wgid = (int)L; { const int q = nwg / NXCD, r = nwg % NXCD, xcd = wgid % NXCD, off = wgid / NXCD; wgid = (xcd < r ? xcd * (q + 1) : r * (q + 1) + (xcd - r) * q) + off; }
        const int nig = WGM * nN, gid = wgid / nig, fm = gid * WGM, gsz = (nM - fm) < WGM ? (nM - fm) : WGM;
        u.pm = fm + ((wgid % nig) % gsz); u.pn = (wgid % nig) / gsz; return true;
    }
    __device__ __forceinline__ void a_ready(const Unit&) const {}
    __device__ __forceinline__ void done(const Unit&) const {}
};

__device__ __forceinline__ unsigned cvt_pk_bf16(float lo, float hi) { unsigned r; asm volatile("v_cvt_pk_bf16_f32 %0, %1, %2" : "=v"(r) : "v"(lo), "v"(hi)); return r; }
typedef float f32x2 __attribute__((ext_vector_type(2)));
struct EpiF32 {
    static constexpr bool PERM = false, AFTER_DRAIN = false;
    float* C; int ldc;
    __device__ __forceinline__ void operator()(const f32x4 (&acc)[2][2][4][2], const Unit& u, int wr, int wc, int fr, int fq) const {
        const int row0 = u.pm * BM + wr * 64 + fr, col0 = u.pn * BM + wc * 32 + 4 * fq;
#pragma unroll
        for (int ai = 0; ai < 2; ++ai)
#pragma unroll
            for (int m = 0; m < 4; ++m) { float* rowp = C + (size_t)(row0 + ai * HALF + m * 16) * ldc + col0;
#pragma unroll
                for (int bj = 0; bj < 2; ++bj)
#pragma unroll
                    for (int n = 0; n < 2; ++n) *(f32x4*)(rowp + bj * HALF + n * 16) = acc[ai][bj][m][n]; }
    }
};
struct EpiIn {
    static constexpr bool PERM = true, AFTER_DRAIN = false;
    unsigned char* ws; size_t off_r, off_q, off_lora, off_vt;
    __device__ __forceinline__ void operator()(const f32x4 (&acc)[2][2][4][2], const Unit& u, int wr, int wc, int fr, int fq) const {
        bf16_t* base; int ldc, rowt, colt; float sc = 1.f;
        if (u.pn >= 64) { const int tile = u.pn - 64, grp = tile >> 2; rowt = u.pm * BM; colt = (tile & 3) * BM; ldc = 1024;
            size_t off;
            if (grp < 4) off = off_r + (size_t)grp * (32u << 20);
            else if (grp == 4) { off = off_q; sc = 0.125f; }
            else if (grp == 5) off = off_q + (32u << 20);
            else if (grp == 6) off = off_q + (96u << 20);
            else { off = off_lora; ldc = 256; colt = 0; }
            base = (bf16_t*)(ws + off);
        } else { base = (bf16_t*)(ws + off_vt); ldc = 16384; rowt = (u.pm - 93) * BM; colt = u.pn * BM; }
        const int row0 = rowt + wr * 64 + fr, col0 = colt + wc * 32 + 8 * fq;
#pragma unroll
        for (int ai = 0; ai < 2; ++ai)
#pragma unroll
            for (int m = 0; m < 4; ++m) { bf16_t* rowp = base + (size_t)(row0 + ai * HALF + m * 16) * ldc + col0;
#pragma unroll
                for (int bj = 0; bj < 2; ++bj) { f32x4 v0 = acc[ai][bj][m][0] * sc, v1 = acc[ai][bj][m][1] * sc;
                    u32x4 w; w.x = cvt_pk_bf16(v0[0], v0[1]); w.y = cvt_pk_bf16(v0[2], v0[3]); w.z = cvt_pk_bf16(v1[0], v1[1]); w.w = cvt_pk_bf16(v1[2], v1[3]);
                    *(u32x4*)(rowp + bj * HALF) = w; } }
    }
};
struct SchedIn {
    int G, c;
    __device__ __forceinline__ bool next(int i, Unit& u) const {
        const int L = i * G + c; if (L >= 2112) return false;
        if (L < 1856) { const int nwg = 1856, nM = 64, nN = 29; int wgid = L; { const int q = nwg / NXCD, r = nwg % NXCD, xcd = wgid % NXCD, off = wgid / NXCD; wgid = (xcd < r ? xcd * (q + 1) : r * (q + 1) + (xcd - r) * q) + off; }
            const int nig = WGM * nN, gid = wgid / nig, fm = gid * WGM, gsz = (nM - fm) < WGM ? (nM - fm) : WGM;
            u.pm = fm + ((wgid % nig) % gsz); u.pn = 64 + (wgid % nig) / gsz; }
        else { const int l2 = L - 1856; u.pm = 93 + (l2 & 3); u.pn = l2 >> 2; }
        return true;
    }
    __device__ __forceinline__ void a_ready(const Unit&) const {}
    __device__ __forceinline__ void done(const Unit&) const {}
};
struct EpiFinal {
    static constexpr bool PERM = false, AFTER_DRAIN = false;
    float* out; const bf16_t* ple; int ldc;
    __device__ __forceinline__ void operator()(const f32x4 (&acc)[2][2][4][2], const Unit& u, int wr, int wc, int fr, int fq) const {
        typedef unsigned u32x2v __attribute__((ext_vector_type(2)));
        const int row0 = u.pm * BM + wr * 64 + fr, col0 = u.pn * BM + wc * 32 + 4 * fq;
#pragma unroll
        for (int ai = 0; ai < 2; ++ai)
#pragma unroll
            for (int m = 0; m < 4; ++m) { const size_t ro = (size_t)(row0 + ai * HALF + m * 16) * ldc + col0;
#pragma unroll
                for (int bj = 0; bj < 2; ++bj)
#pragma unroll
                    for (int n = 0; n < 2; ++n) { const size_t o = ro + bj * HALF + n * 16; const f32x4 h = *(const f32x4*)(out + o); const u32x2v pw = *(const u32x2v*)(ple + o);
                        const f32x4 a = acc[ai][bj][m][n]; f32x4 pl; pl[0] = __uint_as_float(pw.x << 16); pl[1] = __uint_as_float(pw.x & 0xffff0000u); pl[2] = __uint_as_float(pw.y << 16); pl[3] = __uint_as_float(pw.y & 0xffff0000u);
                        f32x4 r;
#pragma unroll
                        for (int e = 0; e < 4; ++e) r[e] = h[e] + pl[e] * (1.0f / (1.0f + __expf(-a[e])));
                        *(f32x4*)(out + o) = r; } }
    }
};
template <class Epi, class Sched, bool ALIGN_EPI = false, bool SP2 = false>
__device__ __forceinline__ void gemm_phase(PG8_LAS unsigned char* lds, const Gemm g, const Sched& S, const Epi& E) {
    const int tid = threadIdx.x, wid = __builtin_amdgcn_readfirstlane(tid >> 6), lane = tid & 63, wr = wid >> 2, wc = wid & 3, fr = lane & 15, fq = lane >> 4;
    const int K = g.K, nt = K / BK;
    unsigned voffA[2], voffB[2];
#pragma unroll
    for (int i = 0; i < 2; ++i) { int R, C; stage_rc(tid * 16 + i * 8192, R, C); const int Rb = Epi::PERM ? ((R & ~31) + perm32(R & 31)) : R;
        voffA[i] = (unsigned)(R * K + C) * 2u; voffB[i] = (unsigned)(Rb * K + C) * 2u; }
    const size_t kstep = (size_t)(BK * 2);
    const size_t hstep = (size_t)HALF * K * 2;
    const size_t tstep = 2 * hstep;
    const unsigned ldsw = (unsigned)wid * 1024u;
    const int aoff = lds_byte(wr * 64 + fr, fq * 8), boff = lds_byte(wc * 32 + fr, fq * 8);
#define PG8_SA(b, h) (((b) * 2 + (h)) * HTB)
#define PG8_SB(b, h) ((4 + (b) * 2 + (h)) * HTB)
#define PG8_STAGE(bufoff, gbase, voff) do { _Pragma("unroll") for (int _i = 0; _i < 2; ++_i) \
        __builtin_amdgcn_global_load_lds((const unsigned*)((const char*)(gbase) + (voff)[_i]), (PG8_LAS unsigned*)(lds + (bufoff) + ldsw + _i * 8192), 16, 0, 0); } while (0)
#define PG8_LDA(dst, b, h) do { _Pragma("unroll") for (int m = 0; m < 4; ++m) _Pragma("unroll") for (int k = 0; k < 2; ++k) dst[m][k] = *(const PG8_LAS bf16x8*)(lds + PG8_SA(b, h) + aoff + m * 2048 + k * 1024); } while (0)
#define PG8_LDB(dst, b, h) do { _Pragma("unroll") for (int n = 0; n < 2; ++n) _Pragma("unroll") for (int k = 0; k < 2; ++k) dst[n][k] = *(const PG8_LAS bf16x8*)(lds + PG8_SB(b, h) + boff + n * 2048 + k * 1024); } while (0)
#define PG8_MMA(ai, bj, At, Bt) do { __builtin_amdgcn_s_setprio(1); _Pragma("unroll") for (int m = 0; m < 4; ++m) _Pragma("unroll") for (int n = 0; n < 2; ++n) _Pragma("unroll") for (int k = 0; k < 2; ++k) \
        acc[ai][bj][m][n] = __builtin_amdgcn_mfma_f32_16x16x32_bf16(Bt[n][k], At[m][k], acc[ai][bj][m][n], 0, 0, 0); __builtin_amdgcn_s_setprio(0); } while (0)
#define PG8_WAIT_V(n) asm volatile("s_waitcnt vmcnt(" #n ")" ::: "memory")
#define PG8_WAIT_L(n) asm volatile("s_waitcnt lgkmcnt(" #n ")" ::: "memory")
#define PG8_BAR __builtin_amdgcn_s_barrier()
#define PG8_SCHED __builtin_amdgcn_sched_barrier(0)
    Unit cur, nxt; int ui = 0;
    if (!S.next(0, cur)) return;
    f32x4 acc[2][2][4][2];
#pragma unroll
    for (int a = 0; a < 2; ++a)
#pragma unroll
        for (int b = 0; b < 2; ++b)
#pragma unroll
            for (int m = 0; m < 4; ++m)
#pragma unroll
                for (int n = 0; n < 2; ++n) acc[a][b][m][n] = (f32x4){0.f, 0.f, 0.f, 0.f};
    bf16x8 At[4][2], B0[2][2], B1[2][2];
    const char* cA = (const char*)g.A + (size_t)cur.pm * tstep; const char* cB = (const char*)g.Bt + (size_t)cur.pn * tstep;
    S.a_ready(cur);
    if constexpr (SP2) {
        PG8_STAGE(PG8_SB(0, 0), cB, voffB); PG8_STAGE(PG8_SB(0, 1), cB + hstep, voffB); PG8_STAGE(PG8_SA(0, 0), cA, voffA); PG8_STAGE(PG8_SA(0, 1), cA + hstep, voffA);
        if (wr == 1) PG8_BAR;
        PG8_WAIT_V(2); PG8_BAR;
        PG8_STAGE(PG8_SB(1, 0), cB + kstep, voffB); PG8_STAGE(PG8_SA(1, 0), cA + kstep, voffA); PG8_STAGE(PG8_SB(1, 1), cB + hstep + kstep, voffB);
        PG8_WAIT_V(6); PG8_BAR;
    } else {
        PG8_STAGE(PG8_SB(0, 0), cB, voffB); PG8_STAGE(PG8_SA(0, 0), cA, voffA); PG8_STAGE(PG8_SB(0, 1), cB + hstep, voffB); PG8_STAGE(PG8_SA(0, 1), cA + hstep, voffA);
        if (wr == 1) PG8_BAR;
        PG8_WAIT_V(4); PG8_BAR;
        PG8_STAGE(PG8_SB(1, 0), cB + kstep, voffB); PG8_STAGE(PG8_SA(1, 0), cA + kstep, voffA); PG8_STAGE(PG8_SB(1, 1), cB + hstep + kstep, voffB);
        PG8_WAIT_V(6); PG8_BAR;
    }
    for (;;) {
        const bool has_next = S.next(ui + 1, nxt);
        const char* nA = has_next ? (const char*)g.A + (size_t)nxt.pm * tstep : cA; const char* nB = has_next ? (const char*)g.Bt + (size_t)nxt.pn * tstep : cB;
        for (int t = 0; t < nt; t += 2) {
            const bool last = (t == nt - 2);
            const char* a1 = cA + (size_t)(t + 1) * kstep;
            const char* a2 = last ? nA : cA + (size_t)(t + 2) * kstep; const char* b2 = last ? nB : cB + (size_t)(t + 2) * kstep;
            const char* a3 = a2 + kstep; const char* b3 = b2 + kstep;
            if (last && has_next) S.a_ready(nxt);
            if constexpr (SP2) {
            PG8_LDB(B0, 0, 0); PG8_LDB(B1, 0, 1); PG8_SCHED; PG8_LDA(At, 0, 0); PG8_STAGE(PG8_SA(1, 1), a1 + hstep, voffA);
            PG8_WAIT_V(8); PG8_WAIT_L(0); PG8_BAR; PG8_MMA(0, 0, At, B0); PG8_MMA(0, 1, At, B1); PG8_BAR; PG8_SCHED;
            PG8_LDA(At, 0, 1); PG8_STAGE(PG8_SB(0, 0), b2, voffB); PG8_STAGE(PG8_SB(0, 1), b2 + hstep, voffB); PG8_STAGE(PG8_SA(0, 0), a2, voffA);
            PG8_WAIT_V(8); PG8_WAIT_L(0); PG8_BAR; PG8_MMA(1, 0, At, B0); PG8_MMA(1, 1, At, B1); PG8_BAR; PG8_SCHED;
            PG8_LDB(B0, 1, 0); PG8_LDB(B1, 1, 1); PG8_SCHED; PG8_LDA(At, 1, 0); PG8_STAGE(PG8_SA(0, 1), a2 + hstep, voffA);
            PG8_WAIT_V(8); PG8_WAIT_L(0); PG8_BAR; PG8_MMA(0, 0, At, B0); PG8_MMA(0, 1, At, B1); PG8_BAR; PG8_SCHED;
            PG8_LDA(At, 1, 1); PG8_STAGE(PG8_SB(1, 0), b3, voffB); PG8_STAGE(PG8_SB(1, 1), b3 + hstep, voffB); PG8_STAGE(PG8_SA(1, 0), a3, voffA);
            PG8_WAIT_V(8); PG8_WAIT_L(0); PG8_BAR; PG8_MMA(1, 0, At, B0); PG8_MMA(1, 1, At, B1); PG8_BAR; PG8_SCHED;
            } else {
            PG8_LDB(B0, 0, 0); PG8_SCHED; PG8_LDA(At, 0, 0); PG8_STAGE(PG8_SA(1, 1), a1 + hstep, voffA);
            PG8_WAIT_L(8); PG8_BAR; PG8_WAIT_L(0); PG8_MMA(0, 0, At, B0); PG8_BAR; PG8_SCHED;
            PG8_LDB(B1, 0, 1); PG8_STAGE(PG8_SB(0, 0), b2, voffB);
            PG8_BAR; PG8_WAIT_L(0); PG8_MMA(0, 1, At, B1); PG8_BAR;
            PG8_LDA(At, 0, 1); PG8_STAGE(PG8_SA(0, 0), a2, voffA);
            PG8_BAR; PG8_WAIT_L(0); PG8_MMA(1, 0, At, B0); PG8_BAR; PG8_SCHED;
            PG8_STAGE(PG8_SB(0, 1), b2 + hstep, voffB);
            PG8_WAIT_V(6); PG8_BAR; PG8_MMA(1, 1, At, B1); PG8_BAR;
            PG8_LDB(B0, 1, 0); PG8_SCHED; PG8_LDA(At, 1, 0); PG8_STAGE(PG8_SA(0, 1), a2 + hstep, voffA);
            PG8_WAIT_L(8); PG8_BAR; PG8_WAIT_L(0); PG8_MMA(0, 0, At, B0); PG8_BAR; PG8_SCHED;
            PG8_LDB(B1, 1, 1); PG8_STAGE(PG8_SB(1, 0), b3, voffB);
            PG8_BAR; PG8_WAIT_L(0); PG8_MMA(0, 1, At, B1); PG8_BAR;
            PG8_LDA(At, 1, 1); PG8_STAGE(PG8_SA(1, 0), a3, voffA);
            PG8_BAR; PG8_WAIT_L(0); PG8_MMA(1, 0, At, B0); PG8_BAR; PG8_SCHED;
            PG8_STAGE(PG8_SB(1, 1), b3 + hstep, voffB);
            PG8_WAIT_V(6); PG8_BAR; PG8_MMA(1, 1, At, B1); PG8_BAR;
            }
        }
        if constexpr (ALIGN_EPI) { if (wr == 0) PG8_BAR; }
        if constexpr (!Epi::AFTER_DRAIN) { E(acc, cur, wr, wc, fr, fq); S.done(cur); }
        if (!has_next) break;
#pragma unroll
        for (int a = 0; a < 2; ++a)
#pragma unroll
            for (int b = 0; b < 2; ++b)
#pragma unroll
                for (int m = 0; m < 4; ++m)
#pragma unroll
                    for (int n = 0; n < 2; ++n) acc[a][b][m][n] = (f32x4){0.f, 0.f, 0.f, 0.f};
        cur = nxt; cA = nA; cB = nB; ++ui;
        if constexpr (ALIGN_EPI) { if (wr == 1) PG8_BAR; }
    }
    PG8_WAIT_V(0);
    if constexpr (!ALIGN_EPI) { if (wr == 0) PG8_BAR; }
    PG8_BAR;
    if constexpr (Epi::AFTER_DRAIN) { E.fused(acc, cur, wr, wc, fr, fq, lds, wid, lane); S.done(cur); }
#undef PG8_SA
#undef PG8_SB
#undef PG8_STAGE
#undef PG8_LDA
#undef PG8_LDB
#undef PG8_MMA
#undef PG8_WAIT_V
#undef PG8_WAIT_L
#undef PG8_BAR
#undef PG8_SCHED
}
}

constexpr int NWAVES = 8;
constexpr int BATCH = 2, SEQ = 8192, DM = 2048, M = BATCH * SEQ, RW = 1024, NH = 16, HD = 64, PLE_DIM = 256, INW = 8320;
constexpr float RMS_EPS = 1e-6f, LNX_EPS = 64e-5f, L2_EPS = 1e-12f;
constexpr float SB_CUT = -104.0f;
#ifndef MK_N_LAUNCHES
#define MK_N_LAUNCHES 1
#endif
constexpr int N_PHASES = 8;
constexpr size_t MiB = 1u << 20;
constexpr size_t WS_CTL = 0, CTL_ZERO_BYTES = 64 * 1024;
constexpr size_t WS_Z = 1 * MiB;
constexpr size_t WS_WDEC = WS_Z, WS_ACO = WS_Z + 64 * MiB;
constexpr size_t WS_H1B = WS_Z;
constexpr size_t WS_W2T = 98 * MiB, WS_W3T = 106 * MiB, WS_WPT = 114 * MiB, WS_PB = 115 * MiB;
constexpr size_t WS_R = 123 * MiB, WS_K = 155 * MiB, WS_V = 187 * MiB, WS_G = 219 * MiB;
constexpr size_t WS_Q = 251 * MiB, WS_KS = 283 * MiB, WS_VT = 315 * MiB, WS_GS = 347 * MiB;
constexpr size_t WS_LORA = 379 * MiB;
constexpr size_t WS_MIX = 387 * MiB;
constexpr size_t WS_YRAW = WS_Q;
constexpr size_t WS_MIXOUT = WS_R;
constexpr size_t WS_PLERAW = WS_Q;
constexpr size_t WS_PLEN = WS_MIX;
constexpr size_t WS_END = 484 * MiB;
constexpr int CW_BAR = 1024;
constexpr int RING_OFF = 0, RING_BYTES = 131072;
constexpr int LDSCTL_OFF = RING_BYTES, MISC_OFF = LDSCTL_OFF + 320;
constexpr int LDS_BYTES = 147456;

#define GAS __attribute__((address_space(1)))
#define LAS __attribute__((address_space(3)))
typedef unsigned short bf16;
typedef unsigned v4u __attribute__((ext_vector_type(4)));
typedef float f32x4 __attribute__((ext_vector_type(4)));
typedef short bf16x8 __attribute__((ext_vector_type(8)));
typedef GAS unsigned gu32;
typedef GAS unsigned long long gu64;
#define RLX_AGENT __ATOMIC_RELAXED, __HIP_MEMORY_SCOPE_AGENT
#define LDS_WAIT() asm volatile("s_waitcnt lgkmcnt(0)" ::: "memory")
#define VM_WAIT() asm volatile("s_waitcnt vmcnt(0)" ::: "memory")
__device__ __forceinline__ unsigned long long rt() { return __builtin_amdgcn_s_memrealtime(); }
__device__ __forceinline__ unsigned f2bf(float f) { unsigned u = __builtin_bit_cast(unsigned, f); return (u + 0x7fffu + ((u >> 16) & 1u)) >> 16; }
__device__ __forceinline__ unsigned pk2(float lo, float hi) { return f2bf(lo) | (f2bf(hi) << 16); }

#define XB_TMO      128
#define XB_XCNT(j)  (256  + 64 * (j))
#define XB_XSUB(j)  (1280 + 64 * (j))
#define XB_XGEN(j)  (2304 + 64 * (j))
#define XB_TOP      3328
#define XB_TOPGEN   3392
#define XCD_BAR_WORDS 3456
#define XB_SPIN_CAP (1u << 18)

__device__ __forceinline__ unsigned xb_ld(unsigned* p)              { return __hip_atomic_load(p, __ATOMIC_RELAXED, __HIP_MEMORY_SCOPE_AGENT); }
__device__ __forceinline__ unsigned xb_add(unsigned* p, unsigned v) { return __hip_atomic_fetch_add(p, v, __ATOMIC_RELAXED, __HIP_MEMORY_SCOPE_AGENT); }
__device__ __forceinline__ unsigned xb_xcc_id() { return (unsigned)__builtin_amdgcn_s_getreg((3 << 11) | 20) & 0xFu; }
#define XB_SPIN(cond, bar) do { unsigned _sp = 0; while (cond) { __builtin_amdgcn_s_sleep(1); \
    if ((++_sp & 255u) == 0u) { if (xb_ld(&(bar)[XB_TMO])) break; if (_sp > XB_SPIN_CAP) { atomicAdd(&(bar)[XB_TMO], 1u); break; } } } } while (0)

struct XcdBarrier {
    unsigned* bar; unsigned x;
    volatile LAS unsigned* st;
};

__device__ __forceinline__ XcdBarrier xcd_barrier_post(unsigned* bar, volatile LAS unsigned* st) {
    XcdBarrier b; b.bar = bar; b.x = xb_xcc_id(); b.st = st;
    if (threadIdx.x == 0) (void)xb_add(&bar[XB_XCNT(b.x)], 1u);
    return b;
}
__device__ __forceinline__ void xcd_barrier_complete(unsigned* bar, unsigned x, unsigned& nloc, unsigned& nx) {
    const unsigned G = gridDim.x * gridDim.y * gridDim.z;
    unsigned sum, cnt, mine, sp = 0u;
    for (;;) {
        sum = 0u; cnt = 0u; mine = 0u;
#pragma unroll
        for (unsigned j = 0; j < 16; ++j) { const unsigned c = xb_ld(&bar[XB_XCNT(j)]); sum += c; cnt += (c > 0u) ? 1u : 0u; mine = (j == x) ? c : mine; }
        if (sum == G) break;
        __builtin_amdgcn_s_sleep(1);
        if ((++sp & 255u) == 0u) { if (xb_ld(&bar[XB_TMO])) break; if (sp > XB_SPIN_CAP) { atomicAdd(&bar[XB_TMO], 1u); break; } }
    }
    nloc = mine > 0u ? mine : 1u; nx = cnt > 0u ? cnt : 1u;
}

__device__ __forceinline__ void xcd_barrier(const XcdBarrier& b) {
    asm volatile("s_waitcnt vmcnt(0)" ::: "memory");
    __syncthreads();
    if (threadIdx.x == 0) {
        unsigned* bar = b.bar;
        __builtin_amdgcn_s_waitcnt(0);
        unsigned nloc = b.st[0], nx = b.st[1];
        if (nloc == 0u) { xcd_barrier_complete(bar, b.x, nloc, nx); b.st[0] = nloc; b.st[1] = nx; }
        const unsigned old = xb_add(&bar[XB_XSUB(b.x)], 1u);
        const unsigned gen = old / nloc;
        if (old + 1u == (gen + 1u) * nloc) {
            __builtin_amdgcn_fence(__ATOMIC_RELEASE, "agent");
            asm volatile("s_waitcnt vmcnt(0)" ::: "memory");
            const unsigned og = xb_add(&bar[XB_TOP], 1u);
            const unsigned tg = og / nx;
            if (og + 1u == (tg + 1u) * nx) xb_add(&bar[XB_TOPGEN], 1u);
            else XB_SPIN(xb_ld(&bar[XB_TOPGEN]) == tg, bar);
            __builtin_amdgcn_fence(__ATOMIC_ACQUIRE, "agent");
            xb_add(&bar[XB_XGEN(b.x)], 1u);
            asm volatile("s_waitcnt vmcnt(0)" ::: "memory");
        } else {
            XB_SPIN(xb_ld(&bar[XB_XGEN(b.x)]) == gen, bar);
            __builtin_amdgcn_fence(__ATOMIC_ACQUIRE, "agent");
            asm volatile("s_waitcnt vmcnt(0)" ::: "memory");
        }
    }
    __syncthreads();
}

typedef float f32x16 __attribute__((ext_vector_type(16)));
typedef unsigned u32x2 __attribute__((ext_vector_type(2)));
typedef unsigned u32x4 __attribute__((ext_vector_type(4)));
struct Frame {
    LAS unsigned char* lds; volatile LAS unsigned* MISC; gu32* ctl;
    int tid, lane, wave, vcu, G;
};
__device__ __forceinline__ float bf2f(bf16 b) { return __uint_as_float((unsigned)b << 16); }
__device__ __forceinline__ float bflo(unsigned w) { return __uint_as_float(w << 16); }
__device__ __forceinline__ float bfhi(unsigned w) { return __uint_as_float(w & 0xffff0000u); }
template <int CTRL, int RMASK> __device__ __forceinline__ float dppadd(float x) {
    const int m = __builtin_amdgcn_update_dpp(0, __builtin_bit_cast(int, x), CTRL, RMASK, 0xF, false);
    return x + __builtin_bit_cast(float, m);
}
__device__ __forceinline__ float dpp_sum63(float x) {
    x = dppadd<0xB1, 0xF>(x); x = dppadd<0x4E, 0xF>(x); x = dppadd<0x141, 0xF>(x); x = dppadd<0x140, 0xF>(x);
    x = dppadd<0x142, 0xA>(x); x = dppadd<0x143, 0xC>(x); return x;
}
__device__ __forceinline__ float rdlane(float x, int l) { return __builtin_bit_cast(float, __builtin_amdgcn_readlane(__builtin_bit_cast(int, x), l)); }
__device__ __forceinline__ float wave_allsum(float x) { return rdlane(dpp_sum63(x), 63); }
__device__ __forceinline__ float row16_allsum(float x) { x = dppadd<0xB1, 0xF>(x); x = dppadd<0x4E, 0xF>(x); x = dppadd<0x141, 0xF>(x); x = dppadd<0x140, 0xF>(x); return x; }

__device__ __forceinline__ void p0_transpose_tile(const float* W, int ldw, int k0, int sn0, bf16* WT, int K, int dn0, LAS float* scr, int lane) {
#pragma unroll 8
    for (int i = 0; i < 32; ++i) { const int kk = 2 * i + (lane >> 5); scr[kk * 33 + (lane & 31)] = sn0 >= 0 ? W[(size_t)(k0 + kk) * ldw + sn0 + (lane & 31)] : 0.f; }
    LDS_WAIT(); asm volatile("" ::: "memory");
    const int c = lane & 7;
#pragma unroll
    for (int j = 0; j < 4; ++j) { const int n = (lane >> 3) + 8 * j; const LAS float* s = scr + (8 * c) * 33 + n;
        v4u o; o.x = pk2(s[0 * 33], s[1 * 33]); o.y = pk2(s[2 * 33], s[3 * 33]); o.z = pk2(s[4 * 33], s[5 * 33]); o.w = pk2(s[6 * 33], s[7 * 33]);
        *(GAS v4u*)(WT + (size_t)(dn0 + n) * K + k0 + 8 * c) = o; }
    LDS_WAIT(); asm volatile("" ::: "memory");
}
__device__ __forceinline__ int w1_src_col(int n) {
    if (n < 3072) return n;
    if (n < 4096) return 3200 + (n - 3072);
    if (n < 5120) return 4224 + (n - 4096);
    if (n < 6144) return 5248 + (n - 5120);
    if (n < 7168) return 7296 + (n - 6144);
    if (n < 7296) return 3072 + (n - 7168);
    if (n < 7424) return -1;
    return 6272 + (n - 7424);
}
struct In { const float *x, *p, *g_pre, *w_in, *mu, *w0, *w_up, *a0, *a_up, *k_k, *k_a, *r_k, *lnx_w, *lnx_b, *w_out, *g_post, *w_ple, *w_plg, *g_ple; };

__device__ __forceinline__ void p0_prologue(Frame& F, const In& I, unsigned char* ws) {
    LAS float* scr = (LAS float*)(F.lds + RING_OFF + F.wave * 16384);
    const int gw = F.vcu * NWAVES + F.wave, NGW = F.G * NWAVES, lane = F.lane;
    bf16* Z = (bf16*)(ws + WS_Z); bf16* W1T = Z + (size_t)64 * 256 * DM;
    constexpr int I_1 = 264 * 32, I_2 = 64 * 32, I_3 = 64 * 32, I_P = 64 * 4;
    constexpr int NITEMS = I_1 + I_2 + I_3 + I_P;
    for (int it = gw; it < NITEMS; it += NGW) {
        int r = it;
        if (r < I_1) { const int nb = r % 264, kb = r / 264; p0_transpose_tile(I.w_in, INW, kb * 64, w1_src_col(nb * 32), W1T, DM, nb * 32, scr, lane); continue; } r -= I_1;
        if (r < I_2) { const int nb = r % 64, kb = r / 64; p0_transpose_tile(I.w_out, DM, kb * 64, nb * 32, (bf16*)(ws + WS_W2T), DM, nb * 32, scr, lane); continue; } r -= I_2;
        if (r < I_3) { const int nb = r % 64, kb = r / 64; p0_transpose_tile(I.w_plg, DM, kb * 64, nb * 32, (bf16*)(ws + WS_W3T), DM, nb * 32, scr, lane); continue; } r -= I_3;
        { const int nb = r % 64, kb = r / 64; p0_transpose_tile(I.w_ple, DM, kb * 64, nb * 32, (bf16*)(ws + WS_WPT), PLE_DIM, nb * 32, scr, lane); }
    }
    for (int m = gw; m < M; m += NGW) {
        const GAS f32x4* xr = (const GAS f32x4*)(I.x + (size_t)m * DM) + lane; const GAS f32x4* gr = (const GAS f32x4*)I.g_pre + lane;
        f32x4 v[8]; float s = 0.f;
#pragma unroll
        for (int j = 0; j < 8; ++j) { v[j] = xr[64 * j]; s += (v[j].x * v[j].x + v[j].y * v[j].y) + (v[j].z * v[j].z + v[j].w * v[j].w); }
        const float rinv = 1.0f / sqrtf(wave_allsum(s) * (1.0f / DM) + RMS_EPS);
        GAS u32x2* o8 = (GAS u32x2*)(Z + (size_t)m * DM) + lane;
#pragma unroll
        for (int j = 0; j < 8; ++j) { const f32x4 g = gr[64 * j]; u32x2 o; o.x = pk2(v[j].x * rinv * g.x, v[j].y * rinv * g.y); o.y = pk2(v[j].z * rinv * g.z, v[j].w * rinv * g.w); o8[64 * j] = o; }
    }
    { const GAS f32x4* pr = (const GAS f32x4*)I.p; GAS u32x2* po = (GAS u32x2*)(ws + WS_PB); const int n4 = M * PLE_DIM / 4;
      for (int i = gw * 64 + lane; i < n4; i += NGW * 64) { const f32x4 v = pr[i]; u32x2 o; o.x = pk2(v.x, v.y); o.y = pk2(v.z, v.w); po[i] = o; } }
}

__device__ __forceinline__ void p2_lora(Frame& F, const In& I, unsigned char* ws) {
    LAS float* th = (LAS float*)(F.lds + RING_OFF); LAS float* ad = th + 64 * 64;
    const bf16* LORA = (const bf16*)(ws + WS_LORA); float* WDEC = (float*)(ws + WS_WDEC); bf16* ACO = (bf16*)(ws + WS_ACO);
    const int tid = F.tid;
    for (int it = F.vcu; it < M / 64; it += F.G) {
        const int row0 = it * 64;
        __syncthreads();
        for (int e = tid; e < 64 * 128; e += NWAVES * 64) { const int tok = e >> 7, j = e & 127; const int row = row0 + tok;
            const float cur = bf2f(LORA[(size_t)row * 256 + j]); const float prev = (row % SEQ) ? bf2f(LORA[(size_t)(row - 1) * 256 + j]) : 0.f;
            const float sv = cur + (prev - cur) * I.mu[3072 + j];
            if (j < 64) { const float e2 = __expf(2.0f * sv); th[tok * 64 + j] = 1.0f - 2.0f / (e2 + 1.0f); } else ad[tok * 64 + (j - 64)] = sv; }
        __syncthreads();
#pragma unroll 1
        for (int cc = 0; cc < 2; ++cc) { const int c = tid + cc * 512;
            float wc[64];
#pragma unroll
            for (int j = 0; j < 64; ++j) wc[j] = I.w_up[j * RW + c];
            const float b0 = I.w0[c];
#pragma unroll 2
            for (int tok = 0; tok < 64; ++tok) { float acc0 = b0, acc1 = 0.f;
#pragma unroll
                for (int j = 0; j < 64; j += 8) { const f32x4 t0 = *(const LAS f32x4*)(th + tok * 64 + j), t1 = *(const LAS f32x4*)(th + tok * 64 + j + 4);
                    acc0 += t0.x * wc[j] + t0.y * wc[j + 1] + t0.z * wc[j + 2] + t0.w * wc[j + 3]; acc1 += t1.x * wc[j + 4] + t1.y * wc[j + 5] + t1.z * wc[j + 6] + t1.w * wc[j + 7]; }
                const float xw = acc0 + acc1; const float sg = 1.0f / (1.0f + __expf(-xw));
                WDEC[(size_t)(row0 + tok) * RW + c] = -0.60653065971263342f * sg;   }
#pragma unroll
            for (int j = 0; j < 64; ++j) wc[j] = I.a_up[j * RW + c];
            const float b1 = I.a0[c];
#pragma unroll 2
            for (int tok = 0; tok < 64; ++tok) { float acc0 = b1, acc1 = 0.f;
#pragma unroll
                for (int j = 0; j < 64; j += 8) { const f32x4 t0 = *(const LAS f32x4*)(ad + tok * 64 + j), t1 = *(const LAS f32x4*)(ad + tok * 64 + j + 4);
                    acc0 += t0.x * wc[j] + t0.y * wc[j + 1] + t0.z * wc[j + 2] + t0.w * wc[j + 3]; acc1 += t1.x * wc[j + 4] + t1.y * wc[j + 5] + t1.z * wc[j + 6] + t1.w * wc[j + 7]; }
                const float xa = acc0 + acc1;
                ACO[(size_t)(row0 + tok) * RW + c] = (bf16)f2bf(1.0f / (1.0f + __expf(-xa))); }
        }
    }
    __syncthreads();
}

__device__ __forceinline__ int crow(int r, int hi) { return (r & 3) + 8 * (r >> 2) + 4 * hi; }
__device__ __forceinline__ float softplusf(float z) { return fmaxf(z, 0.f) + __logf(1.0f + __expf(-fabsf(z))); }
__device__ __forceinline__ void attn_tile(const bf16* Q, const bf16* KS, const bf16* VT, const bf16* GS, bf16* MIX, int b, int h, int qt, int lane) {
    const int r32 = lane & 31, hi = lane >> 5, t0 = qt * 32; const size_t rowb = (size_t)b * SEQ;
    bf16x8 qf[4];
    { const bf16* qp = Q + (rowb + t0 + r32) * 1024 + h * 64 + hi * 8;
#pragma unroll
      for (int d0 = 0; d0 < 4; ++d0) qf[d0] = *(const GAS bf16x8*)(qp + d0 * 16); }
    f32x16 o0 = {}, o1 = {}; float R = 0.f;
    const bf16* vt0 = VT + (size_t)(h * 64 + r32) * M + rowb + 4 * hi;
    for (int kb = qt; kb >= 0; --kb) {
        const int s0 = kb * 32;
        bf16x8 kf[4];
        { const bf16* kp = KS + (rowb + s0 + r32) * 1024 + h * 64 + hi * 8;
#pragma unroll
          for (int d0 = 0; d0 < 4; ++d0) kf[d0] = *(const GAS bf16x8*)(kp + d0 * 16); }
        u32x2 va[2][2][2];
#pragma unroll
        for (int dt = 0; dt < 2; ++dt)
#pragma unroll
            for (int s = 0; s < 2; ++s)
#pragma unroll
                for (int hf = 0; hf < 2; ++hf) va[dt][s][hf] = *(const GAS u32x2*)(vt0 + (size_t)dt * 32 * M + s0 + 16 * s + 8 * hf);
        f32x16 p = {};
#pragma unroll
        for (int d0 = 0; d0 < 4; ++d0) p = __builtin_amdgcn_mfma_f32_32x32x16_bf16(kf[d0], qf[d0], p, 0, 0, 0);
        const bool diag = (kb == qt);
        float l1[16], lb[16];
#pragma unroll
        for (int r = 0; r < 16; ++r) { const float z = p[r]; const float sp = softplusf(z); const bool valid = !diag || (crow(r, hi) < r32); l1[r] = valid ? -sp : 0.f; lb[r] = valid ? (z - sp) : -INFINITY; }
        float mine[4], oth[4], tot[4];
#pragma unroll
        for (int g = 0; g < 4; ++g) { mine[g] = (l1[4 * g] + l1[4 * g + 1]) + (l1[4 * g + 2] + l1[4 * g + 3]);
            auto rr = __builtin_amdgcn_permlane32_swap(__float_as_uint(mine[g]), __float_as_uint(mine[g]), false, false);
            const float lo = __uint_as_float(rr[0]), up = __uint_as_float(rr[1]); oth[g] = hi ? lo : up; tot[g] = lo + up; }
        float T[4]; T[3] = 0.f; T[2] = tot[3]; T[1] = T[2] + tot[2]; T[0] = T[1] + tot[1];
        float w[16];
#pragma unroll
        for (int g = 0; g < 4; ++g) { float e = T[g] + (hi ? 0.f : oth[g]) + R;
            w[4 * g + 3] = __expf(lb[4 * g + 3] + e); e += l1[4 * g + 3];
            w[4 * g + 2] = __expf(lb[4 * g + 2] + e); e += l1[4 * g + 2];
            w[4 * g + 1] = __expf(lb[4 * g + 1] + e); e += l1[4 * g + 1];
            w[4 * g + 0] = __expf(lb[4 * g + 0] + e); }
        R += T[0] + tot[0];
        u32x4 pb0, pb1;
        pb0.x = pk2(w[0], w[1]); pb0.y = pk2(w[2], w[3]); pb0.z = pk2(w[4], w[5]); pb0.w = pk2(w[6], w[7]);
        pb1.x = pk2(w[8], w[9]); pb1.y = pk2(w[10], w[11]); pb1.z = pk2(w[12], w[13]); pb1.w = pk2(w[14], w[15]);
        const bf16x8 pB0 = __builtin_bit_cast(bf16x8, pb0), pB1 = __builtin_bit_cast(bf16x8, pb1);
#define VA(dt, s) __builtin_bit_cast(bf16x8, (u32x4){va[dt][s][0].x, va[dt][s][0].y, va[dt][s][1].x, va[dt][s][1].y})
        o0 = __builtin_amdgcn_mfma_f32_32x32x16_bf16(VA(0, 0), pB0, o0, 0, 0, 0); o0 = __builtin_amdgcn_mfma_f32_32x32x16_bf16(VA(0, 1), pB1, o0, 0, 0, 0);
        o1 = __builtin_amdgcn_mfma_f32_32x32x16_bf16(VA(1, 0), pB0, o1, 0, 0, 0); o1 = __builtin_amdgcn_mfma_f32_32x32x16_bf16(VA(1, 1), pB1, o1, 0, 0, 0);
#undef VA
        if (__all(R < SB_CUT)) break;
    }
    const size_t row = rowb + t0 + r32;
#pragma unroll
    for (int dt = 0; dt < 2; ++dt)
#pragma unroll
        for (int g = 0; g < 4; ++g) { const int d = dt * 32 + 8 * g + 4 * hi; const u32x2 gw = *(const GAS u32x2*)(GS + row * 1024 + h * 64 + d);
            float gv[4] = {bflo(gw.x), bfhi(gw.x), bflo(gw.y), bfhi(gw.y)}; float ov[4];
#pragma unroll
            for (int e = 0; e < 4; ++e) { const float o = dt ? o1[4 * g + e] : o0[4 * g + e]; ov[e] = o * gv[e] / (1.0f + __expf(-gv[e])); }
            u32x2 st; st.x = pk2(ov[0], ov[1]); st.y = pk2(ov[2], ov[3]); *(GAS u32x2*)(MIX + row * 2048 + 1024 + h * 64 + d) = st; }
}
__device__ __forceinline__ void p2_attention(Frame& F, unsigned char* ws) {
    const bf16 *Q = (const bf16*)(ws + WS_Q), *KS = (const bf16*)(ws + WS_KS), *VT = (const bf16*)(ws + WS_VT), *GS = (const bf16*)(ws + WS_GS); bf16* MIX = (bf16*)(ws + WS_MIX);
    const int gw = F.vcu * NWAVES + F.wave, NGW = F.G * NWAVES;
    for (int u = gw; u < BATCH * NH * (SEQ / 32); u += NGW) { const int qt = u & 255, bh = u >> 8; attn_tile(Q, KS, VT, GS, MIX, bh >> 4, bh & 15, qt, F.lane); }
}

constexpr int PT = 72, MATB = 64 * PT * 2;
constexpr int LB_KQ = 0, LB_RQ = 1, LB_BK = 2, LB_KK = 3, LB_BD = 4, LB_KD = 5, LB_V = 6, LB_LA = 7, LB_AUK = 8, LB_ARB = 9, LB_ARK = 10, LB_PA = 11;
constexpr int LB_LB = LB_BK, LB_PB = LB_KK;
constexpr int L_G = 12 * MATB, L_SEG = L_G + 64 * 64 * 4;
static_assert(L_SEG + 8 * 64 * 4 <= RING_BYTES, "chunk LDS map");
constexpr size_t WS_NCT = WS_Q, WS_MCT = WS_VT, WS_QC = WS_GS, WS_YLOC = 451 * MiB, WS_BON = 483 * MiB, WS_SC = WS_Z;
typedef short v4i16_t __attribute__((ext_vector_type(4)));
__device__ __forceinline__ bf16x8 ldA(const LAS unsigned char* X, int m0, int ks, int lane) { return *(const LAS bf16x8*)(X + ((m0 + (lane & 15)) * PT + 32 * ks + 8 * (lane >> 4)) * 2); }
__device__ __forceinline__ bf16x8 ldTr(const LAS unsigned char* X, int c0, int ks, int lane) {
    const int g = lane >> 4, i = lane & 15, q = i >> 2, p = i & 3;
    const LAS unsigned char* a = X + ((32 * ks + 8 * g + q) * PT + c0 + 4 * p) * 2;
    const v4i16_t lo = __builtin_amdgcn_ds_read_tr16_b64_v4i16((LAS v4i16_t*)a), hi = __builtin_amdgcn_ds_read_tr16_b64_v4i16((LAS v4i16_t*)(a + 4 * PT * 2));
    return (bf16x8){lo[0], lo[1], lo[2], lo[3], hi[0], hi[1], hi[2], hi[3]};
}
__device__ __forceinline__ void stRM(LAS unsigned char* X, int m0, int n0, const f32x4& acc, int lane) {
    const int n = lane & 15, q = lane >> 4;
#pragma unroll
    for (int r = 0; r < 4; ++r) *(LAS unsigned short*)(X + ((m0 + 4 * q + r) * PT + n0 + n) * 2) = (unsigned short)f2bf(acc[r]);
}
#define MMA16(a, b, c) __builtin_amdgcn_mfma_f32_16x16x32_bf16(a, b, c, 0, 0, 0)
struct PreRegs { v4u rc, rp, kc, kp, ac, vc, vp; f32x4 lw0, lw1; };

__device__ __forceinline__ void p3a_prepass(Frame& F, const In& I, unsigned char* ws) {
    const int tid = F.tid, lane = F.lane, wave = F.wave;
    LAS unsigned char* L = F.lds + RING_OFF;
#define LBUF(i) (L + (i) * MATB)
    const bf16 *Rb = (const bf16*)(ws + WS_R), *Kb = (const bf16*)(ws + WS_K), *Vb = (const bf16*)(ws + WS_V), *ACO = (const bf16*)(ws + WS_ACO); const float* LW = (const float*)(ws + WS_WDEC);
    float* NCT = (float*)(ws + WS_NCT); bf16* MCT = (bf16*)(ws + WS_MCT); bf16* QC = (bf16*)(ws + WS_QC); bf16* YLOC = (bf16*)(ws + WS_YLOC); float* BON = (float*)(ws + WS_BON);
    const int st = tid >> 3, k8 = (tid & 7) * 8;
    const int m0 = (wave & 3) * 16, nb = (wave >> 2) * 32;
    const int tn = lane & 15, tq = lane >> 4;
    auto LOAD = [&](int unit, PreRegs& g) {
        const int bh = unit >> 7, c = unit & 127, b = bh >> 4, h = bh & 15; const int t = c * 64 + st; const size_t row = (size_t)b * SEQ + t; const size_t o = row * 1024 + h * 64 + k8;
        g.rc = *(const GAS v4u*)(Rb + o); g.kc = *(const GAS v4u*)(Kb + o); g.vc = *(const GAS v4u*)(Vb + o); g.ac = *(const GAS v4u*)(ACO + o);
        g.lw0 = *(const GAS f32x4*)(LW + o); g.lw1 = *(const GAS f32x4*)(LW + o + 4);
        if (t > 0) { g.rp = *(const GAS v4u*)(Rb + o - 1024); g.kp = *(const GAS v4u*)(Kb + o - 1024); g.vp = *(const GAS v4u*)(Vb + o - 1024); } else { g.rp = (v4u){0u, 0u, 0u, 0u}; g.kp = g.rp; g.vp = g.rp; }
    };
    PreRegs g;
    int unit = F.vcu;
    if (unit < 4096) LOAD(unit, g);
    for (; unit < 4096; unit += F.G) {
        const int bh = unit >> 7, c = unit & 127, b = bh >> 4, h = bh & 15; const size_t row0 = (size_t)b * SEQ + c * 64; const int ch0 = h * 64;
        float rs[8], kt[8], kk[8], bb[8], vs[8], lw[8];
        { const unsigned rcw[4] = {g.rc.x, g.rc.y, g.rc.z, g.rc.w}, rpw[4] = {g.rp.x, g.rp.y, g.rp.z, g.rp.w}, kcw[4] = {g.kc.x, g.kc.y, g.kc.z, g.kc.w}, kpw[4] = {g.kp.x, g.kp.y, g.kp.z, g.kp.w};
          const unsigned vcw[4] = {g.vc.x, g.vc.y, g.vc.z, g.vc.w}, vpw[4] = {g.vp.x, g.vp.y, g.vp.z, g.vp.w}, acw[4] = {g.ac.x, g.ac.y, g.ac.z, g.ac.w};
          float ss = 0.f, bon = 0.f; float av[8], ks[8];
#pragma unroll
          for (int e = 0; e < 8; ++e) { const int cch = ch0 + k8 + e; const int w2 = e >> 1; const bool hi = e & 1;
              const float rc = hi ? bfhi(rcw[w2]) : bflo(rcw[w2]), rp = hi ? bfhi(rpw[w2]) : bflo(rpw[w2]), kc = hi ? bfhi(kcw[w2]) : bflo(kcw[w2]), kp = hi ? bfhi(kpw[w2]) : bflo(kpw[w2]);
              const float vc = hi ? bfhi(vcw[w2]) : bflo(vcw[w2]), vp = hi ? bfhi(vpw[w2]) : bflo(vpw[w2]); av[e] = hi ? bfhi(acw[w2]) : bflo(acw[w2]);
              rs[e] = rc + (rp - rc) * I.mu[cch]; ks[e] = kc + (kp - kc) * I.mu[1024 + cch]; vs[e] = vc + (vp - vc) * I.mu[2048 + cch];
              kk[e] = ks[e] * I.k_k[cch]; ss += kk[e] * kk[e]; kt[e] = ks[e] * (1.0f + (av[e] - 1.0f) * I.k_a[cch]); bon += rs[e] * kt[e] * I.r_k[cch]; }
          ss = dppadd<0xB1, 0xF>(ss); ss = dppadd<0x4E, 0xF>(ss); ss = dppadd<0x141, 0xF>(ss);
          bon = dppadd<0xB1, 0xF>(bon); bon = dppadd<0x4E, 0xF>(bon); bon = dppadd<0x141, 0xF>(bon);
          const float inv = 1.0f / sqrtf(ss + L2_EPS);
#pragma unroll
          for (int e = 0; e < 8; ++e) { kk[e] *= inv; bb[e] = av[e] * kk[e]; }
          lw[0] = g.lw0.x; lw[1] = g.lw0.y; lw[2] = g.lw0.z; lw[3] = g.lw0.w; lw[4] = g.lw1.x; lw[5] = g.lw1.y; lw[6] = g.lw1.z; lw[7] = g.lw1.w;
          if ((tid & 7) == 0) BON[(row0 + st) * 16 + h] = bon;
          *(LAS f32x4*)(L + L_G + (st * 64 + k8) * 4) = g.lw0; *(LAS f32x4*)(L + L_G + (st * 64 + k8 + 4) * 4) = g.lw1; }
        if (unit + F.G < 4096) LOAD(unit + F.G, g);
        __syncthreads();
        { const int k = tid & 63, sg = tid >> 6; LAS float* Gp = (LAS float*)(L + L_G); LAS float* Sg = (LAS float*)(L + L_SEG);
          float v8[8]; float run = 0.f;
#pragma unroll
          for (int i = 0; i < 8; ++i) { run += Gp[(sg * 8 + i) * 64 + k]; v8[i] = run; }
          Sg[sg * 64 + k] = run;
          __syncthreads();
          float pre = 0.f;
#pragma unroll
          for (int s2 = 0; s2 < 7; ++s2) pre += (s2 < sg) ? Sg[s2 * 64 + k] : 0.f;
#pragma unroll
          for (int i = 0; i < 8; ++i) Gp[(sg * 8 + i) * 64 + k] = v8[i] + pre; }
        __syncthreads();
        { const LAS float* Gp = (const LAS float*)(L + L_G); float gg[8], gc[8];
          { const f32x4 a0 = *(const LAS f32x4*)(Gp + st * 64 + k8), a1 = *(const LAS f32x4*)(Gp + st * 64 + k8 + 4), c0 = *(const LAS f32x4*)(Gp + 63 * 64 + k8), c1 = *(const LAS f32x4*)(Gp + 63 * 64 + k8 + 4);
            gg[0] = a0.x; gg[1] = a0.y; gg[2] = a0.z; gg[3] = a0.w; gg[4] = a1.x; gg[5] = a1.y; gg[6] = a1.z; gg[7] = a1.w; gc[0] = c0.x; gc[1] = c0.y; gc[2] = c0.z; gc[3] = c0.w; gc[4] = c1.x; gc[5] = c1.y; gc[6] = c1.z; gc[7] = c1.w; }
          float o[7][8];
#pragma unroll
          for (int e = 0; e < 8; ++e) { const float eg = __expf(gg[e]), egm = __expf(gg[e] - lw[e]), ei = __expf(-gg[e]), ed = __expf(gc[e] - gg[e]);
              o[LB_KQ][e] = kk[e] * egm; o[LB_RQ][e] = rs[e] * eg; o[LB_BK][e] = bb[e] * ei; o[LB_KK][e] = kt[e] * ei; o[LB_BD][e] = bb[e] * ed; o[LB_KD][e] = kt[e] * ed; o[LB_V][e] = vs[e]; }
#pragma unroll
          for (int mtx = 0; mtx < 7; ++mtx) { v4u w; w.x = pk2(o[mtx][0], o[mtx][1]); w.y = pk2(o[mtx][2], o[mtx][3]); w.z = pk2(o[mtx][4], o[mtx][5]); w.w = pk2(o[mtx][6], o[mtx][7]);
              *(LAS v4u*)(LBUF(mtx) + (st * PT + k8) * 2) = w; } }
        __syncthreads();
        f32x4 Pacc[2];
#pragma unroll
        for (int ti = 0; ti < 2; ++ti) { const int n0 = nb + 16 * ti; f32x4 ub = {0.f, 0.f, 0.f, 0.f}, uk = ub, rb = ub, rk = ub;
#pragma unroll
            for (int ks = 0; ks < 2; ++ks) { const bf16x8 aq = ldA(LBUF(LB_KQ), m0, ks, lane), ar = ldA(LBUF(LB_RQ), m0, ks, lane), b1 = ldA(LBUF(LB_BK), n0, ks, lane), b2 = ldA(LBUF(LB_KK), n0, ks, lane);
                ub = MMA16(aq, b1, ub); uk = MMA16(aq, b2, uk); rb = MMA16(ar, b1, rb); rk = MMA16(ar, b2, rk); }
#pragma unroll
            for (int r = 0; r < 4; ++r) { const int t = m0 + 4 * tq + r, j = n0 + tn; if (!(j < t)) { ub[r] = 0.f; uk[r] = 0.f; } if (!(j <= t)) { rb[r] = 0.f; rk[r] = 0.f; } Pacc[ti][r] = (t == j ? 1.0f : 0.0f) - ub[r]; }
            stRM(LBUF(LB_LA), m0, n0, ub, lane); stRM(LBUF(LB_AUK), m0, n0, uk, lane); stRM(LBUF(LB_ARB), m0, n0, rb, lane); stRM(LBUF(LB_ARK), m0, n0, rk, lane); stRM(LBUF(LB_PA), m0, n0, Pacc[ti], lane); }
        __syncthreads();
#define SQR(dst, src) do { _Pragma("unroll") for (int ti = 0; ti < 2; ++ti) { const int n0 = nb + 16 * ti; f32x4 a_ = {0.f, 0.f, 0.f, 0.f}; \
            _Pragma("unroll") for (int ks = 0; ks < 2; ++ks) a_ = MMA16(ldA(LBUF(src), m0, ks, lane), ldTr(LBUF(src), n0, ks, lane), a_); stRM(LBUF(dst), m0, n0, a_, lane); } } while (0)
#define PUPD(pdst, psrc, lsrc) do { _Pragma("unroll") for (int ti = 0; ti < 2; ++ti) { const int n0 = nb + 16 * ti; \
            _Pragma("unroll") for (int ks = 0; ks < 2; ++ks) Pacc[ti] = MMA16(ldA(LBUF(psrc), m0, ks, lane), ldTr(LBUF(lsrc), n0, ks, lane), Pacc[ti]); stRM(LBUF(pdst), m0, n0, Pacc[ti], lane); } } while (0)
        SQR(LB_LB, LB_LA); __syncthreads();
        PUPD(LB_PB, LB_PA, LB_LB); SQR(LB_LA, LB_LB); __syncthreads();
        PUPD(LB_PA, LB_PB, LB_LA); SQR(LB_LB, LB_LA); __syncthreads();
        PUPD(LB_PB, LB_PA, LB_LB); SQR(LB_LA, LB_LB); __syncthreads();
        PUPD(LB_PA, LB_PB, LB_LA); SQR(LB_LB, LB_LA); __syncthreads();
        PUPD(LB_PB, LB_PA, LB_LB); __syncthreads();
#undef SQR
#undef PUPD
#pragma unroll
        for (int ti = 0; ti < 2; ++ti) { const int n0 = nb + 16 * ti; f32x4 a_ = {0.f, 0.f, 0.f, 0.f};
#pragma unroll
            for (int ks = 0; ks < 2; ++ks) a_ = MMA16(ldA(LBUF(LB_AUK), m0, ks, lane), ldTr(LBUF(LB_V), n0, ks, lane), a_);
            stRM(LBUF(LB_LA), m0, n0, a_, lane); }
        __syncthreads();
#pragma unroll
        for (int ti = 0; ti < 2; ++ti) { const int n0 = nb + 16 * ti; f32x4 u_ = {0.f, 0.f, 0.f, 0.f}, w_ = u_;
#pragma unroll
            for (int ks = 0; ks < 2; ++ks) { const bf16x8 at = ldA(LBUF(LB_PB), m0, ks, lane); u_ = MMA16(at, ldTr(LBUF(LB_LA), n0, ks, lane), u_); w_ = MMA16(at, ldTr(LBUF(LB_KQ), n0, ks, lane), w_); }
            u_ = -u_; stRM(LBUF(LB_PA), m0, n0, u_, lane); stRM(LBUF(LB_LB), m0, n0, w_, lane); }
        __syncthreads();
        const size_t ub16 = (size_t)unit * 4096;
#pragma unroll
        for (int ti = 0; ti < 2; ++ti) { const int n0 = nb + 16 * ti;
            f32x4 qa = {0.f, 0.f, 0.f, 0.f}, ya = qa, ma = qa, na = qa;
#pragma unroll
            for (int ks = 0; ks < 2; ++ks) { const bf16x8 wq = ldTr(LBUF(LB_LB), m0, ks, lane), arb = ldA(LBUF(LB_ARB), n0, ks, lane), u0 = ldTr(LBUF(LB_PA), m0, ks, lane), vv = ldTr(LBUF(LB_V), m0, ks, lane), ark = ldA(LBUF(LB_ARK), n0, ks, lane);
                qa = MMA16(wq, arb, qa); ya = MMA16(u0, arb, ya); ya = MMA16(vv, ark, ya);
                const bf16x8 bdn = ldTr(LBUF(LB_BD), n0, ks, lane), bdm = ldTr(LBUF(LB_BD), m0, ks, lane), kdm = ldTr(LBUF(LB_KD), m0, ks, lane), u0n = ldTr(LBUF(LB_PA), n0, ks, lane), vn = ldTr(LBUF(LB_V), n0, ks, lane);
                ma = MMA16(wq, bdn, ma); na = MMA16(bdm, u0n, na); na = MMA16(kdm, vn, na); }
            { const u32x2 rq = *(const LAS u32x2*)(LBUF(LB_RQ) + ((n0 + tn) * PT + m0 + 4 * tq) * 2);
              u32x2 qo; qo.x = pk2(bflo(rq.x) - qa[0], bfhi(rq.x) - qa[1]); qo.y = pk2(bflo(rq.y) - qa[2], bfhi(rq.y) - qa[3]);
              const size_t o = (row0 + n0 + tn) * 1024 + ch0 + m0 + 4 * tq;
              *(GAS u32x2*)(QC + o) = qo; u32x2 yo; yo.x = pk2(ya[0], ya[1]); yo.y = pk2(ya[2], ya[3]); *(GAS u32x2*)(YLOC + o) = yo; }
            { const LAS float* Gp = (const LAS float*)(L + L_G); float mv[4];
#pragma unroll
              for (int r = 0; r < 4; ++r) { const int k = m0 + 4 * tq + r, kp = n0 + tn; mv[r] = (k == kp ? __expf(Gp[63 * 64 + k]) : 0.f) - ma[r]; }
              u32x2 mo; mo.x = pk2(mv[0], mv[1]); mo.y = pk2(mv[2], mv[3]);
              *(GAS u32x2*)(MCT + ub16 + (size_t)(n0 + tn) * 64 + m0 + 8 * (tq & 1) + 4 * (tq >> 1)) = mo; }
#pragma unroll
            for (int r = 0; r < 4; ++r) NCT[ub16 + (size_t)(m0 + 4 * tq + r) * 64 + n0 + tn] = na[r]; }
        __syncthreads();
    }
#undef LBUF
}

__device__ __forceinline__ void p3b_state(Frame& F, unsigned char* ws) {
    const int lane = F.lane;
    if (F.wave != 0 || blockIdx.x >= 64) return;
    const int bh = blockIdx.x >> 1, vh = blockIdx.x & 1, r32 = lane & 31, hi = lane >> 5;
    const float* NCT = (const float*)(ws + WS_NCT); const bf16* MCT = (const bf16*)(ws + WS_MCT); bf16* SC = (bf16*)(ws + WS_SC);
    f32x16 T0 = {}, T1 = {};
    bf16x8 mf[2][2][2]; f32x16 n0v, n1v;
    auto LOADC = [&](int c, bf16x8 (&m)[2][2][2], f32x16& a0, f32x16& a1) {
        const size_t ub = (size_t)(bh * 128 + c) * 4096;
#pragma unroll
        for (int i = 0; i < 2; ++i)
#pragma unroll
            for (int j = 0; j < 2; ++j)
#pragma unroll
                for (int s = 0; s < 2; ++s) m[i][j][s] = *(const GAS bf16x8*)(MCT + ub + (size_t)(32 * i + r32) * 64 + 16 * (2 * j + s) + 8 * hi);
#pragma unroll
        for (int r = 0; r < 16; ++r) { const int kr = (r & 3) + 8 * (r >> 2) + 4 * hi; a0[r] = NCT[ub + (size_t)kr * 64 + vh * 32 + r32]; a1[r] = NCT[ub + (size_t)(32 + kr) * 64 + vh * 32 + r32]; }
    };
    LOADC(0, mf, n0v, n1v);
    for (int c = 0; c < 128; ++c) {
        bf16x8 mg[2][2][2]; f32x16 g0, g1;
        if (c + 1 < 128) LOADC(c + 1, mg, g0, g1); else { g0 = n0v; g1 = n1v;
#pragma unroll
            for (int i = 0; i < 2; ++i)
#pragma unroll
                for (int j = 0; j < 2; ++j)
#pragma unroll
                    for (int s = 0; s < 2; ++s) mg[i][j][s] = mf[i][j][s]; }
        u32x4 tb[2][2];
#pragma unroll
        for (int s = 0; s < 2; ++s) { tb[0][s].x = pk2(T0[8 * s], T0[8 * s + 1]); tb[0][s].y = pk2(T0[8 * s + 2], T0[8 * s + 3]); tb[0][s].z = pk2(T0[8 * s + 4], T0[8 * s + 5]); tb[0][s].w = pk2(T0[8 * s + 6], T0[8 * s + 7]);
            tb[1][s].x = pk2(T1[8 * s], T1[8 * s + 1]); tb[1][s].y = pk2(T1[8 * s + 2], T1[8 * s + 3]); tb[1][s].z = pk2(T1[8 * s + 4], T1[8 * s + 5]); tb[1][s].w = pk2(T1[8 * s + 6], T1[8 * s + 7]); }
        { bf16* sp = SC + (size_t)(bh * 128 + c) * 4096 + (size_t)(vh * 32 + r32) * 64 + 4 * hi;
#pragma unroll
          for (int j = 0; j < 2; ++j)
#pragma unroll
              for (int s = 0; s < 2; ++s) { *(GAS u32x2*)(sp + 32 * j + 16 * s) = (u32x2){tb[j][s].x, tb[j][s].y}; *(GAS u32x2*)(sp + 32 * j + 16 * s + 8) = (u32x2){tb[j][s].z, tb[j][s].w}; } }
        f32x16 a0 = n0v, a1 = n1v;
#pragma unroll
        for (int j = 0; j < 2; ++j)
#pragma unroll
            for (int s = 0; s < 2; ++s) { const bf16x8 bfr = __builtin_bit_cast(bf16x8, tb[j][s]);
                a0 = __builtin_amdgcn_mfma_f32_32x32x16_bf16(mf[0][j][s], bfr, a0, 0, 0, 0); a1 = __builtin_amdgcn_mfma_f32_32x32x16_bf16(mf[1][j][s], bfr, a1, 0, 0, 0); }
        T0 = a0; T1 = a1; n0v = g0; n1v = g1;
#pragma unroll
        for (int i = 0; i < 2; ++i)
#pragma unroll
            for (int j = 0; j < 2; ++j)
#pragma unroll
                for (int s = 0; s < 2; ++s) mf[i][j][s] = mg[i][j][s];
    }
}

__device__ __forceinline__ void p4_post(Frame& F, const In& I, unsigned char* ws) {
    const int lane = F.lane, tn = lane & 15, tq = lane >> 4;
    const bf16 *SC = (const bf16*)(ws + WS_SC), *QC = (const bf16*)(ws + WS_QC), *YLOC = (const bf16*)(ws + WS_YLOC), *Vb = (const bf16*)(ws + WS_V), *Gb = (const bf16*)(ws + WS_G); const float* BON = (const float*)(ws + WS_BON);
    bf16* MIX = (bf16*)(ws + WS_MIX);
    const int gw = F.vcu * NWAVES + F.wave, NGW = F.G * NWAVES;
    for (int it = gw; it < 4096 * 4; it += NGW) {
        const int unit = it >> 2, n0 = (it & 3) * 16, bh = unit >> 7, c = unit & 127, b = bh >> 4, h = bh & 15; const size_t row = (size_t)b * SEQ + c * 64 + n0 + tn; const int ch0 = h * 64;
        const bf16* sc = SC + (size_t)unit * 4096;
        f32x4 acc[4] = {{0.f, 0.f, 0.f, 0.f}, {0.f, 0.f, 0.f, 0.f}, {0.f, 0.f, 0.f, 0.f}, {0.f, 0.f, 0.f, 0.f}};
#pragma unroll
        for (int ks = 0; ks < 2; ++ks) { const bf16x8 bq = *(const GAS bf16x8*)(QC + row * 1024 + ch0 + 32 * ks + 8 * tq);
#pragma unroll
            for (int mt = 0; mt < 4; ++mt) { const bf16x8 as = *(const GAS bf16x8*)(sc + (size_t)(16 * mt + tn) * 64 + 32 * ks + 8 * tq); acc[mt] = MMA16(as, bq, acc[mt]); } }
        float y[4][4]; float s = 0.f;
#pragma unroll
        for (int mt = 0; mt < 4; ++mt) { const u32x2 yl = *(const GAS u32x2*)(YLOC + row * 1024 + ch0 + 16 * mt + 4 * tq);
            y[mt][0] = acc[mt][0] + bflo(yl.x); y[mt][1] = acc[mt][1] + bfhi(yl.x); y[mt][2] = acc[mt][2] + bflo(yl.y); y[mt][3] = acc[mt][3] + bfhi(yl.y); s += (y[mt][0] + y[mt][1]) + (y[mt][2] + y[mt][3]); }
        s += __shfl_xor(s, 16); s += __shfl_xor(s, 32);
        const float mean = s * (1.0f / 64.0f); float q = 0.f;
#pragma unroll
        for (int mt = 0; mt < 4; ++mt)
#pragma unroll
            for (int r = 0; r < 4; ++r) { y[mt][r] -= mean; q += y[mt][r] * y[mt][r]; }
        q += __shfl_xor(q, 16); q += __shfl_xor(q, 32);
        const float rstd = 1.0f / sqrtf(q * (1.0f / 64.0f) + LNX_EPS);
        const float bon = BON[row * 16 + h]; const bool first = (c == 0) && (n0 + tn == 0);
#pragma unroll
        for (int mt = 0; mt < 4; ++mt) { const int cc = ch0 + 16 * mt + 4 * tq; const size_t o = row * 1024 + cc;
            const f32x4 lw = *(const GAS f32x4*)(I.lnx_w + cc), lb = *(const GAS f32x4*)(I.lnx_b + cc), mu = *(const GAS f32x4*)(I.mu + 2048 + cc);
            const u32x2 vc = *(const GAS u32x2*)(Vb + o), gg = *(const GAS u32x2*)(Gb + o); u32x2 vp = {0u, 0u}; if (!first) vp = *(const GAS u32x2*)(Vb + o - 1024);
            const float vcf[4] = {bflo(vc.x), bfhi(vc.x), bflo(vc.y), bfhi(vc.y)}, vpf[4] = {bflo(vp.x), bfhi(vp.x), bflo(vp.y), bfhi(vp.y)}, gf[4] = {bflo(gg.x), bfhi(gg.x), bflo(gg.y), bfhi(gg.y)};
            float ov[4];
#pragma unroll
            for (int r = 0; r < 4; ++r) { const float vsft = vcf[r] + (vpf[r] - vcf[r]) * mu[r]; ov[r] = (y[mt][r] * rstd * lw[r] + lb[r] + bon * vsft) * (gf[r] / (1.0f + __expf(-gf[r]))); }
            u32x2 st; st.x = pk2(ov[0], ov[1]); st.y = pk2(ov[2], ov[3]); *(GAS u32x2*)(MIX + row * 2048 + cc) = st; }
    }
}

__device__ __forceinline__ void p6_rows(Frame& F, const In& I, unsigned char* ws, float* out) {
    const float *MIXOUT = (const float*)(ws + WS_MIXOUT), *PLERAW = (const float*)(ws + WS_PLERAW); bf16 *H1B = (bf16*)(ws + WS_H1B), *PLEN = (bf16*)(ws + WS_PLEN);
    const int gw = F.vcu * NWAVES + F.wave, NGW = F.G * NWAVES, lane = F.lane;
    for (int m = gw; m < M; m += NGW) {
        { const GAS f32x4* mr = (const GAS f32x4*)(MIXOUT + (size_t)m * DM) + lane; const GAS f32x4* xr = (const GAS f32x4*)(I.x + (size_t)m * DM) + lane; const GAS f32x4* gr = (const GAS f32x4*)I.g_post + lane;
          f32x4 v[8]; float s = 0.f;
#pragma unroll
          for (int j = 0; j < 8; ++j) { v[j] = mr[64 * j]; s += (v[j].x * v[j].x + v[j].y * v[j].y) + (v[j].z * v[j].z + v[j].w * v[j].w); }
          const float rinv = 1.0f / sqrtf(wave_allsum(s) * (1.0f / DM) + RMS_EPS);
          GAS f32x4* orow = (GAS f32x4*)(out + (size_t)m * DM) + lane; GAS u32x2* hb = (GAS u32x2*)(H1B + (size_t)m * DM) + lane;
#pragma unroll
          for (int j = 0; j < 8; ++j) { const f32x4 g = gr[64 * j], x = xr[64 * j]; f32x4 hh; hh.x = x.x + v[j].x * rinv * g.x; hh.y = x.y + v[j].y * rinv * g.y; hh.z = x.z + v[j].z * rinv * g.z; hh.w = x.w + v[j].w * rinv * g.w;
              orow[64 * j] = hh; u32x2 o; o.x = pk2(hh.x, hh.y); o.y = pk2(hh.z, hh.w); hb[64 * j] = o; } }
        { const GAS f32x4* pr = (const GAS f32x4*)(PLERAW + (size_t)m * DM) + lane; const GAS f32x4* gr = (const GAS f32x4*)I.g_ple + lane;
          f32x4 v[8]; float s = 0.f;
#pragma unroll
          for (int j = 0; j < 8; ++j) { v[j] = pr[64 * j]; s += (v[j].x * v[j].x + v[j].y * v[j].y) + (v[j].z * v[j].z + v[j].w * v[j].w); }
          const float rinv = 1.0f / sqrtf(wave_allsum(s) * (1.0f / DM) + RMS_EPS);
          GAS u32x2* pn = (GAS u32x2*)(PLEN + (size_t)m * DM) + lane;
#pragma unroll
          for (int j = 0; j < 8; ++j) { const f32x4 g = gr[64 * j]; u32x2 o; o.x = pk2(v[j].x * rinv * g.x, v[j].y * rinv * g.y); o.y = pk2(v[j].z * rinv * g.z, v[j].w * rinv * g.w); pn[64 * j] = o; } }
    }
}

struct Args { const float* in[19]; float* out; unsigned char* ws; int ph_lo, ph_hi, li, pad; };
__global__ void __launch_bounds__(NWAVES * 64, 2) hymba_fwd(Args args) {
    extern __shared__ __attribute__((aligned(16))) unsigned char lds[];
    Frame F;
    F.lds = (LAS unsigned char*)lds; F.MISC = (volatile LAS unsigned*)(F.lds + MISC_OFF);
    F.tid = threadIdx.x; F.lane = F.tid & 63; F.wave = __builtin_amdgcn_readfirstlane(F.tid >> 6);
    F.G = gridDim.x; { const int bx = blockIdx.x; F.vcu = (F.G % 8 == 0) ? (bx % 8) * (F.G / 8) + bx / 8 : bx; }
    unsigned char* ws = args.ws; F.ctl = (gu32*)(ws + WS_CTL);
    In I; I.x = args.in[0]; I.p = args.in[1]; I.g_pre = args.in[2]; I.w_in = args.in[3]; I.mu = args.in[4]; I.w0 = args.in[5]; I.w_up = args.in[6]; I.a0 = args.in[7]; I.a_up = args.in[8];
    I.k_k = args.in[9]; I.k_a = args.in[10]; I.r_k = args.in[11]; I.lnx_w = args.in[12]; I.lnx_b = args.in[13]; I.w_out = args.in[14]; I.g_post = args.in[15]; I.w_ple = args.in[16]; I.w_plg = args.in[17]; I.g_ple = args.in[18];
    for (int u = F.tid; u < (LDS_BYTES - LDSCTL_OFF) / 4; u += NWAVES * 64) ((LAS unsigned*)(F.lds + LDSCTL_OFF))[u] = 0u;
    __syncthreads();
    const bool multi = (args.ph_hi - args.ph_lo) > 1;
    XcdBarrier bar; bar.bar = (unsigned*)(F.ctl + CW_BAR); bar.x = 0; bar.st = nullptr;
    if (multi) bar = xcd_barrier_post((unsigned*)(F.ctl + CW_BAR), F.MISC + 8);
    const int lo = args.ph_lo, hi = args.ph_hi;
#define IN(k) (lo <= (k) && (k) < hi)
#define BOTH(k) (IN(k) && IN((k) + 1))
    bf16* Z = (bf16*)(ws + WS_Z);
    if (IN(0)) { p0_prologue(F, I, ws); if (BOTH(0)) xcd_barrier(bar); }
    if (IN(1)) {
        pg8::Gemm g{Z, Z, M, 8448, DM}; pg8::SchedIn S{F.G, (int)blockIdx.x};
        pg8::EpiIn E{ws, WS_R, WS_Q, WS_LORA, WS_VT};
        pg8::gemm_phase<pg8::EpiIn, pg8::SchedIn, true, true>(F.lds + RING_OFF, g, S, E);
        if (BOTH(1)) xcd_barrier(bar);
    }
    if (IN(2)) { p2_lora(F, I, ws); p2_attention(F, ws); if (BOTH(2)) xcd_barrier(bar); }
    if (IN(3)) { p3a_prepass(F, I, ws); xcd_barrier(bar); p3b_state(F, ws); if (BOTH(3)) xcd_barrier(bar); }
    if (IN(4)) { p4_post(F, I, ws); if (BOTH(4)) xcd_barrier(bar); }
    if (IN(5)) {
        { pg8::Gemm g{(const bf16*)(ws + WS_MIX), (const bf16*)(ws + WS_W2T), M, DM, DM}; pg8::StaticOrder S; S.init(M, DM, F.G, (int)blockIdx.x);
          pg8::EpiF32 E{(float*)(ws + WS_MIXOUT), DM};
          pg8::gemm_phase<pg8::EpiF32, pg8::StaticOrder, true, true>(F.lds + RING_OFF, g, S, E); }
        __syncthreads();
        { pg8::Gemm g{(const bf16*)(ws + WS_PB), (const bf16*)(ws + WS_WPT), M, DM, PLE_DIM}; pg8::StaticOrder S; S.init(M, DM, F.G, (int)blockIdx.x);
          pg8::EpiF32 E{(float*)(ws + WS_PLERAW), DM};
          pg8::gemm_phase<pg8::EpiF32, pg8::StaticOrder, true, true>(F.lds + RING_OFF, g, S, E); }
        if (BOTH(5)) xcd_barrier(bar);
    }
    if (IN(6)) { p6_rows(F, I, ws, args.out); if (BOTH(6)) xcd_barrier(bar); }
    if (IN(7)) {
        pg8::Gemm g{(const bf16*)(ws + WS_H1B), (const bf16*)(ws + WS_W3T), M, DM, DM}; pg8::StaticOrder S; S.init(M, DM, F.G, (int)blockIdx.x);
        pg8::EpiFinal E{args.out, (const bf16*)(ws + WS_PLEN), DM};
        pg8::gemm_phase<pg8::EpiFinal, pg8::StaticOrder, true, true>(F.lds + RING_OFF, g, S, E);
    }
#undef IN
#undef BOTH
}

extern "C" void kernel_launch(void* const* d_in, const int* in_sizes, int n_in, void* d_out, int out_size, void* d_ws, size_t ws_size, hipStream_t stream) {
    static int grid = 0;
    if (grid == 0) {
        if (n_in != 19 || in_sizes[0] != M * DM || out_size != M * DM || ws_size < WS_END) { fprintf(stderr, "kernel_launch: unexpected shapes (n_in %d, in0 %d, out %d, ws %zu); nothing launched\n", n_in, n_in > 0 ? in_sizes[0] : -1, out_size, ws_size); grid = -1; return; }
        int dev = 0, cus = 0, per_cu = 0;
        if (hipGetDevice(&dev) != hipSuccess || hipDeviceGetAttribute(&cus, hipDeviceAttributeMultiprocessorCount, dev) != hipSuccess) { grid = -1; return; }
        if (hipFuncSetAttribute((const void*)hymba_fwd, hipFuncAttributeMaxDynamicSharedMemorySize, LDS_BYTES) != hipSuccess) { fprintf(stderr, "kernel_launch: hipFuncSetAttribute failed\n"); grid = -1; return; }
        if (hipOccupancyMaxActiveBlocksPerMultiprocessor(&per_cu, (const void*)hymba_fwd, NWAVES * 64, LDS_BYTES) != hipSuccess || per_cu < 1) { fprintf(stderr, "kernel_launch: occupancy query says %d\n", per_cu); }
        (void)hipGetLastError();
        grid = cus;
    }
    if (grid < 0) return;
    if (hipMemsetAsync((char*)d_ws + WS_CTL, 0, CTL_ZERO_BYTES, stream) != hipSuccess) return;
    Args a{};
    for (int i = 0; i < 19; ++i) a.in[i] = (const float*)d_in[i];
    a.out = (float*)d_out; a.ws = (unsigned char*)d_ws;
    constexpr int NL = MK_N_LAUNCHES;
    for (int li = 0; li < NL; ++li) {
        a.ph_lo = (NL == 1) ? 0 : li; a.ph_hi = (NL == 1) ? N_PHASES : li + 1; a.li = li;
        hipLaunchKernelGGL(hymba_fwd, dim3(grid), dim3(NWAVES * 64), LDS_BYTES, stream, a);
    }
}
```

```cpp
#include <hip/hip_runtime.h>
#include <cstdio>
#include <cstdint>
namespace pg8 {
#define PG8_LAS __attribute__((address_space(3)))
typedef unsigned short bf16_t;
typedef short bf16x8 __attribute__((ext_vector_type(8)));
typedef float f32x4 __attribute__((ext_vector_type(4)));
typedef unsigned u32x4 __attribute__((ext_vector_type(4)));
constexpr int BM = 256, BK = 64, HALF = 128, HTB = HALF * BK * 2  , STAGE_BYTES = 8 * HTB, NXCD = 8, WGM = 8;

__host__ __device__ __forceinline__ int lds_byte(int r, int c) { const int st = (r >> 4) * 2 + (c >> 5), rr = r & 15, cc = c & 31, ob = rr * 64 + cc * 2; return st * 1024 + (ob ^ (((ob >> 9) & 1) << 5)); }
__host__ __device__ __forceinline__ void stage_rc(int b, int& R, int& C) { const int st = b / 1024, sb = b % 1024, swz = sb ^ (((sb >> 9) & 1) << 5); R = (st >> 1) * 16 + swz / 64; C = (st & 1) * 32 + (swz % 64) / 2; }
__host__ __device__ __forceinline__ int perm32(int rho) { const int n = rho >> 4, i = rho & 15; return 8 * (i >> 2) + 4 * n + (i & 3); }

struct Unit { int pm, pn; };
struct Gemm { const bf16_t* A; const bf16_t* Bt; int M, N, K; };

struct StaticOrder {
    int nM, nN, nwg, G, c;
    __host__ __device__ void init(int M, int N, int G_, int c_) { nM = M / BM; nN = N / BM; nwg = nM * nN; G = G_; c = c_; }
    __host__ __device__ bool next(int i, Unit& u) const {
        const long L = (long)i * G + c; if (L >= nwg) return false;
        int wgid = (int)L; { const int q = nwg / NXCD, r = nwg % NXCD, xcd = wgid % NXCD, off = wgid / NXCD; wgid = (xcd < r ? xcd * (q + 1) : r * (q + 1) + (xcd - r) * q) + off; }
        const int nig = WGM * nN, gid = wgid / nig, fm = gid * WGM, gsz = (nM - fm) < WGM ? (nM - fm) : WGM;
        u.pm = fm + ((wgid % nig) % gsz); u.pn = (wgid % nig) / gsz; return true;
    }
    __device__ __forceinline__ void a_ready(const Unit&) const {}
    __device__ __forceinline__ void done(const Unit&) const {}
};

__device__ __forceinline__ unsigned cvt_pk_bf16(float lo, float hi) { unsigned r; asm volatile("v_cvt_pk_bf16_f32 %0, %1, %2" : "=v"(r) : "v"(lo), "v"(hi)); return r; }
typedef float f32x2 __attribute__((ext_vector_type(2)));
struct EpiF32 {
    static constexpr bool PERM = false, AFTER_DRAIN = false;
    float* C; int ldc;
    __device__ __forceinline__ void operator()(const f32x4 (&acc)[2][2][4][2], const Unit& u, int wr, int wc, int fr, int fq) const {
        const int row0 = u.pm * BM + wr * 64 + fr, col0 = u.pn * BM + wc * 32 + 4 * fq;
#pragma unroll
        for (int ai = 0; ai < 2; ++ai)
#pragma unroll
            for (int m = 0; m < 4; ++m) { float* rowp = C + (size_t)(row0 + ai * HALF + m * 16) * ldc + col0;
#pragma unroll
                for (int bj = 0; bj < 2; ++bj)
#pragma unroll
                    for (int n = 0; n < 2; ++n) *(f32x4*)(rowp + bj * HALF + n * 16) = acc[ai][bj][m][n]; }
    }
};
struct EpiIn {
    static constexpr bool PERM = true, AFTER_DRAIN = false;
    unsigned char* ws; size_t off_r, off_q, off_lora, off_vt;
    __device__ __forceinline__ void operator()(const f32x4 (&acc)[2][2][4][2], const Unit& u, int wr, int wc, int fr, int fq) const {
        bf16_t* base; int ldc, rowt, colt; float sc = 1.f;
        if (u.pn >= 64) { const int tile = u.pn - 64, grp = tile >> 2; rowt = u.pm * BM; colt = (tile & 3) * BM; ldc = 1024;
            size_t off;
            if (grp < 4) off = off_r + (size_t)grp * (32u << 20);
            else if (grp == 4) { off = off_q; sc = 0.125f; }
            else if (grp == 5) off = off_q + (32u << 20);
            else if (grp == 6) off = off_q + (96u << 20);
            else { off = off_lora; ldc = 256; colt = 0; }
            base = (bf16_t*)(ws + off);
        } else { base = (bf16_t*)(ws + off_vt); ldc = 16384; rowt = (u.pm - 93) * BM; colt = u.pn * BM; }
        const int row0 = rowt + wr * 64 + fr, col0 = colt + wc * 32 + 8 * fq;
#pragma unroll
        for (int ai = 0; ai < 2; ++ai)
#pragma unroll
            for (int m = 0; m < 4; ++m) { bf16_t* rowp = base + (size_t)(row0 + ai * HALF + m * 16) * ldc + col0;
#pragma unroll
                for (int bj = 0; bj < 2; ++bj) { f32x4 v0 = acc[ai][bj][m][0] * sc, v1 = acc[ai][bj][m][1] * sc;
                    u32x4 w; w.x = cvt_pk_bf16(v0[0], v0[1]); w.y = cvt_pk_bf16(v0[2], v0[3]); w.z = cvt_pk_bf16(v1[0], v1[1]); w.w = cvt_pk_bf16(v1[2], v1[3]);
                    *(u32x4*)(rowp + bj * HALF) = w; } }
    }
};
struct SchedIn {
    int G, c;
    __device__ __forceinline__ bool next(int i, Unit& u) const {
        const int L = i * G + c; if (L >= 2112) return false;
        if (L < 1856) { const int nwg = 1856, nM = 64, nN = 29; int wgid = L; { const int q = nwg / NXCD, r = nwg % NXCD, xcd = wgid % NXCD, off = wgid / NXCD; wgid = (xcd < r ? xcd * (q + 1) : r * (q + 1) + (xcd - r) * q) + off; }
            const int nig = WGM * nN, gid = wgid / nig, fm = gid * WGM, gsz = (nM - fm) < WGM ? (nM - fm) : WGM;
            u.pm = fm + ((wgid % nig) % gsz); u.pn = 64 + (wgid % nig) / gsz; }
        else { const int l2 = L - 1856; u.pm = 93 + (l2 & 3); u.pn = l2 >> 2; }
        return true;
    }
    __device__ __forceinline__ void a_ready(const Unit&) const {}
    __device__ __forceinline__ void done(const Unit&) const {}
};
struct EpiFinal {
    static constexpr bool PERM = false, AFTER_DRAIN = false;
    float* __restrict__ out; const float* __restrict__ h1; const bf16_t* __restrict__ ple; int ldc;
    __device__ __forceinline__ void operator()(const f32x4 (&acc)[2][2][4][2], const Unit& u, int wr, int wc, int fr, int fq) const {
        typedef unsigned u32x2v __attribute__((ext_vector_type(2)));
        const int row0 = u.pm * BM + wr * 64 + fr, col0 = u.pn * BM + wc * 32 + 4 * fq;
#pragma unroll
        for (int ai = 0; ai < 2; ++ai)
#pragma unroll
            for (int mp = 0; mp < 2; ++mp) { f32x4 hv[2][2][2]; u32x2v pv[2][2][2];
#pragma unroll
                for (int mm = 0; mm < 2; ++mm) { const size_t ro = (size_t)(row0 + ai * HALF + (2 * mp + mm) * 16) * ldc + col0;
#pragma unroll
                    for (int bj = 0; bj < 2; ++bj)
#pragma unroll
                        for (int n = 0; n < 2; ++n) { const size_t o = ro + bj * HALF + n * 16; hv[mm][bj][n] = __builtin_nontemporal_load((const f32x4*)(h1 + o)); pv[mm][bj][n] = __builtin_nontemporal_load((const u32x2v*)(ple + o)); } }
#pragma unroll
                for (int mm = 0; mm < 2; ++mm) { const int m = 2 * mp + mm; const size_t ro = (size_t)(row0 + ai * HALF + m * 16) * ldc + col0;
#pragma unroll
                    for (int bj = 0; bj < 2; ++bj)
#pragma unroll
                        for (int n = 0; n < 2; ++n) { const size_t o = ro + bj * HALF + n * 16; const f32x4 h = hv[mm][bj][n]; const u32x2v pw = pv[mm][bj][n];
                            const f32x4 a = acc[ai][bj][m][n]; f32x4 pl; pl[0] = __uint_as_float(pw.x << 16); pl[1] = __uint_as_float(pw.x & 0xffff0000u); pl[2] = __uint_as_float(pw.y << 16); pl[3] = __uint_as_float(pw.y & 0xffff0000u);
                            f32x4 r;
#pragma unroll
                            for (int e = 0; e < 4; ++e) r[e] = h[e] + pl[e] * __builtin_amdgcn_rcpf(1.0f + __expf(-a[e]));
                            *(f32x4*)(out + o) = r; } } }
    }
};
template <class Epi, class Sched, bool ALIGN_EPI = false, bool SP2 = false>
__device__ __forceinline__ void gemm_phase(PG8_LAS unsigned char* lds, const Gemm g, const Sched& S, const Epi& E) {
    const int tid = threadIdx.x, wid = __builtin_amdgcn_readfirstlane(tid >> 6), lane = tid & 63, wr = wid >> 2, wc = wid & 3, fr = lane & 15, fq = lane >> 4;
    const int K = g.K, nt = K / BK;
    unsigned voffA[2], voffB[2];
#pragma unroll
    for (int i = 0; i < 2; ++i) { int R, C; stage_rc(tid * 16 + i * 8192, R, C); const int Rb = Epi::PERM ? ((R & ~31) + perm32(R & 31)) : R;
        voffA[i] = (unsigned)(R * K + C) * 2u; voffB[i] = (unsigned)(Rb * K + C) * 2u; }
    const size_t kstep = (size_t)(BK * 2);
    const size_t hstep = (size_t)HALF * K * 2;
    const size_t tstep = 2 * hstep;
    const unsigned ldsw = (unsigned)wid * 1024u;
    const int aoff = lds_byte(wr * 64 + fr, fq * 8), boff = lds_byte(wc * 32 + fr, fq * 8);
#define PG8_SA(b, h) (((b) * 2 + (h)) * HTB)
#define PG8_SB(b, h) ((4 + (b) * 2 + (h)) * HTB)
#define PG8_STAGE(bufoff, gbase, voff) do { _Pragma("unroll") for (int _i = 0; _i < 2; ++_i) \
        __builtin_amdgcn_global_load_lds((const unsigned*)((const char*)(gbase) + (voff)[_i]), (PG8_LAS unsigned*)(lds + (bufoff) + ldsw + _i * 8192), 16, 0, 0); } while (0)
#define PG8_LDA(dst, b, h) do { _Pragma("unroll") for (int m = 0; m < 4; ++m) _Pragma("unroll") for (int k = 0; k < 2; ++k) dst[m][k] = *(const PG8_LAS bf16x8*)(lds + PG8_SA(b, h) + aoff + m * 2048 + k * 1024); } while (0)
#define PG8_LDB(dst, b, h) do { _Pragma("unroll") for (int n = 0; n < 2; ++n) _Pragma("unroll") for (int k = 0; k < 2; ++k) dst[n][k] = *(const PG8_LAS bf16x8*)(lds + PG8_SB(b, h) + boff + n * 2048 + k * 1024); } while (0)
#define PG8_MMA(ai, bj, At, Bt) do { __builtin_amdgcn_s_setprio(1); _Pragma("unroll") for (int m = 0; m < 4; ++m) _Pragma("unroll") for (int n = 0; n < 2; ++n) _Pragma("unroll") for (int k = 0; k < 2; ++k) \
        acc[ai][bj][m][n] = __builtin_amdgcn_mfma_f32_16x16x32_bf16(Bt[n][k], At[m][k], acc[ai][bj][m][n], 0, 0, 0); __builtin_amdgcn_s_setprio(0); } while (0)
#define PG8_WAIT_V(n) asm volatile("s_waitcnt vmcnt(" #n ")" ::: "memory")
#define PG8_WAIT_L(n) asm volatile("s_waitcnt lgkmcnt(" #n ")" ::: "memory")
#define PG8_BAR __builtin_amdgcn_s_barrier()
#define PG8_SCHED __builtin_amdgcn_sched_barrier(0)
    Unit cur, nxt; int ui = 0;
    if (!S.next(0, cur)) return;
    f32x4 acc[2][2][4][2];
#pragma unroll
    for (int a = 0; a < 2; ++a)
#pragma unroll
        for (int b = 0; b < 2; ++b)
#pragma unroll
            for (int m = 0; m < 4; ++m)
#pragma unroll
                for (int n = 0; n < 2; ++n) acc[a][b][m][n] = (f32x4){0.f, 0.f, 0.f, 0.f};
    bf16x8 At[4][2], B0[2][2], B1[2][2];
    const char* cA = (const char*)g.A + (size_t)cur.pm * tstep; const char* cB = (const char*)g.Bt + (size_t)cur.pn * tstep;
    S.a_ready(cur);
    if constexpr (SP2) {
        PG8_STAGE(PG8_SB(0, 0), cB, voffB); PG8_STAGE(PG8_SB(0, 1), cB + hstep, voffB); PG8_STAGE(PG8_SA(0, 0), cA, voffA); PG8_STAGE(PG8_SA(0, 1), cA + hstep, voffA);
        if (wr == 1) PG8_BAR;
        PG8_WAIT_V(2); PG8_BAR;
        PG8_STAGE(PG8_SB(1, 0), cB + kstep, voffB); PG8_STAGE(PG8_SA(1, 0), cA + kstep, voffA); PG8_STAGE(PG8_SB(1, 1), cB + hstep + kstep, voffB);
        PG8_WAIT_V(6); PG8_BAR;
    } else {
        PG8_STAGE(PG8_SB(0, 0), cB, voffB); PG8_STAGE(PG8_SA(0, 0), cA, voffA); PG8_STAGE(PG8_SB(0, 1), cB + hstep, voffB); PG8_STAGE(PG8_SA(0, 1), cA + hstep, voffA);
        if (wr == 1) PG8_BAR;
        PG8_WAIT_V(4); PG8_BAR;
        PG8_STAGE(PG8_SB(1, 0), cB + kstep, voffB); PG8_STAGE(PG8_SA(1, 0), cA + kstep, voffA); PG8_STAGE(PG8_SB(1, 1), cB + hstep + kstep, voffB);
        PG8_WAIT_V(6); PG8_BAR;
    }
    for (;;) {
        const bool has_next = S.next(ui + 1, nxt);
        const char* nA = has_next ? (const char*)g.A + (size_t)nxt.pm * tstep : cA; const char* nB = has_next ? (const char*)g.Bt + (size_t)nxt.pn * tstep : cB;
        for (int t = 0; t < nt; t += 2) {
            const bool last = (t == nt - 2);
            const char* a1 = cA + (size_t)(t + 1) * kstep;
            const char* a2 = last ? nA : cA + (size_t)(t + 2) * kstep; const char* b2 = last ? nB : cB + (size_t)(t + 2) * kstep;
            const char* a3 = a2 + kstep; const char* b3 = b2 + kstep;
            if (last && has_next) S.a_ready(nxt);
            if constexpr (SP2) {
            PG8_LDB(B0, 0, 0); PG8_LDB(B1, 0, 1); PG8_SCHED; PG8_LDA(At, 0, 0); PG8_STAGE(PG8_SA(1, 1), a1 + hstep, voffA);
            PG8_WAIT_V(8); PG8_WAIT_L(0); PG8_BAR; PG8_MMA(0, 0, At, B0); PG8_MMA(0, 1, At, B1); PG8_BAR; PG8_SCHED;
            PG8_LDA(At, 0, 1); PG8_STAGE(PG8_SB(0, 0), b2, voffB); PG8_STAGE(PG8_SB(0, 1), b2 + hstep, voffB); PG8_STAGE(PG8_SA(0, 0), a2, voffA);
            PG8_WAIT_V(8); PG8_WAIT_L(0); PG8_BAR; PG8_MMA(1, 0, At, B0); PG8_MMA(1, 1, At, B1); PG8_BAR; PG8_SCHED;
            PG8_LDB(B0, 1, 0); PG8_LDB(B1, 1, 1); PG8_SCHED; PG8_LDA(At, 1, 0); PG8_STAGE(PG8_SA(0, 1), a2 + hstep, voffA);
            PG8_WAIT_V(8); PG8_WAIT_L(0); PG8_BAR; PG8_MMA(0, 0, At, B0); PG8_MMA(0, 1, At, B1); PG8_BAR; PG8_SCHED;
            PG8_LDA(At, 1, 1); PG8_STAGE(PG8_SB(1, 0), b3, voffB); PG8_STAGE(PG8_SB(1, 1), b3 + hstep, voffB); PG8_STAGE(PG8_SA(1, 0), a3, voffA);
            PG8_WAIT_V(8); PG8_WAIT_L(0); PG8_BAR; PG8_MMA(1, 0, At, B0); PG8_MMA(1, 1, At, B1); PG8_BAR; PG8_SCHED;
            } else {
            PG8_LDB(B0, 0, 0); PG8_SCHED; PG8_LDA(At, 0, 0); PG8_STAGE(PG8_SA(1, 1), a1 + hstep, voffA);
            PG8_WAIT_L(8); PG8_BAR; PG8_WAIT_L(0); PG8_MMA(0, 0, At, B0); PG8_BAR; PG8_SCHED;
            PG8_LDB(B1, 0, 1); PG8_STAGE(PG8_SB(0, 0), b2, voffB);
            PG8_BAR; PG8_WAIT_L(0); PG8_MMA(0, 1, At, B1); PG8_BAR;
            PG8_LDA(At, 0, 1); PG8_STAGE(PG8_SA(0, 0), a2, voffA);
            PG8_BAR; PG8_WAIT_L(0); PG8_MMA(1, 0, At, B0); PG8_BAR; PG8_SCHED;
            PG8_STAGE(PG8_SB(0, 1), b2 + hstep, voffB);
            PG8_WAIT_V(6); PG8_BAR; PG8_MMA(1, 1, At, B1); PG8_BAR;
            PG8_LDB(B0, 1, 0); PG8_SCHED; PG8_LDA(At, 1, 0); PG8_STAGE(PG8_SA(0, 1), a2 + hstep, voffA);
            PG8_WAIT_L(8); PG8_BAR; PG8_WAIT_L(0); PG8_MMA(0, 0, At, B0); PG8_BAR; PG8_SCHED;
            PG8_LDB(B1, 1, 1); PG8_STAGE(PG8_SB(1, 0), b3, voffB);
            PG8_BAR; PG8_WAIT_L(0); PG8_MMA(0, 1, At, B1); PG8_BAR;
            PG8_LDA(At, 1, 1); PG8_STAGE(PG8_SA(1, 0), a3, voffA);
            PG8_BAR; PG8_WAIT_L(0); PG8_MMA(1, 0, At, B0); PG8_BAR; PG8_SCHED;
            PG8_STAGE(PG8_SB(1, 1), b3 + hstep, voffB);
            PG8_WAIT_V(6); PG8_BAR; PG8_MMA(1, 1, At, B1); PG8_BAR;
            }
        }
        if constexpr (ALIGN_EPI) { if (wr == 0) PG8_BAR; }
        if constexpr (!Epi::AFTER_DRAIN) { E(acc, cur, wr, wc, fr, fq); S.done(cur); }
        if (!has_next) break;
#pragma unroll
        for (int a = 0; a < 2; ++a)
#pragma unroll
            for (int b = 0; b < 2; ++b)
#pragma unroll
                for (int m = 0; m < 4; ++m)
#pragma unroll
                    for (int n = 0; n < 2; ++n) acc[a][b][m][n] = (f32x4){0.f, 0.f, 0.f, 0.f};
        cur = nxt; cA = nA; cB = nB; ++ui;
        if constexpr (ALIGN_EPI) { if (wr == 1) PG8_BAR; }
    }
    PG8_WAIT_V(0);
    if constexpr (!ALIGN_EPI) { if (wr == 0) PG8_BAR; }
    PG8_BAR;
    if constexpr (Epi::AFTER_DRAIN) { E.fused(acc, cur, wr, wc, fr, fq, lds, wid, lane); S.done(cur); }
#undef PG8_SA
#undef PG8_SB
#undef PG8_STAGE
#undef PG8_LDA
#undef PG8_LDB
#undef PG8_MMA
#undef PG8_WAIT_V
#undef PG8_WAIT_L
#undef PG8_BAR
#undef PG8_SCHED
}
}

constexpr int NWAVES = 8;
constexpr int BATCH = 2, SEQ = 8192, DM = 2048, M = BATCH * SEQ, RW = 1024, NH = 16, HD = 64, PLE_DIM = 256, INW = 8320;
constexpr float RMS_EPS = 1e-6f, LNX_EPS = 64e-5f, L2_EPS = 1e-12f;
constexpr float SB_CUT = -104.0f;
#ifndef MK_N_LAUNCHES
#define MK_N_LAUNCHES 1
#endif
constexpr int N_PHASES = 8;
constexpr size_t MiB = 1u << 20;
constexpr size_t WS_CTL = 0, CTL_ZERO_BYTES = 64 * 1024;
constexpr size_t WS_Z = 1 * MiB;
constexpr size_t WS_WDEC = WS_Z, WS_ACO = WS_Z + 64 * MiB;
constexpr size_t WS_H1B = WS_Z;
constexpr size_t WS_W2T = 98 * MiB, WS_W3T = 106 * MiB, WS_WPT = 114 * MiB, WS_PB = 115 * MiB;
constexpr size_t WS_R = 123 * MiB, WS_K = 155 * MiB, WS_V = 187 * MiB, WS_G = 219 * MiB;
constexpr size_t WS_Q = 251 * MiB, WS_KS = 283 * MiB, WS_VT = 315 * MiB, WS_GS = 347 * MiB;
constexpr size_t WS_LORA = 379 * MiB;
constexpr size_t WS_MIX = 387 * MiB;
constexpr size_t WS_YRAW = WS_Q;
constexpr size_t WS_MIXOUT = WS_R;
constexpr size_t WS_PLERAW = WS_Q;
constexpr size_t WS_PLEN = WS_MIX;
constexpr size_t WS_END = 484 * MiB;
constexpr int CW_BAR = 1024;
constexpr int RING_OFF = 0, RING_BYTES = 131072;
constexpr int LDSCTL_OFF = RING_BYTES, MISC_OFF = LDSCTL_OFF + 320;
constexpr int LDS_BYTES = 147456;

#define GAS __attribute__((address_space(1)))
#define LAS __attribute__((address_space(3)))
typedef unsigned short bf16;
typedef unsigned v4u __attribute__((ext_vector_type(4)));
typedef float f32x4 __attribute__((ext_vector_type(4)));
typedef short bf16x8 __attribute__((ext_vector_type(8)));
typedef GAS unsigned gu32;
typedef GAS unsigned long long gu64;
#define RLX_AGENT __ATOMIC_RELAXED, __HIP_MEMORY_SCOPE_AGENT
#define LDS_WAIT() asm volatile("s_waitcnt lgkmcnt(0)" ::: "memory")
#define VM_WAIT() asm volatile("s_waitcnt vmcnt(0)" ::: "memory")
__device__ __forceinline__ unsigned long long rt() { return __builtin_amdgcn_s_memrealtime(); }
__device__ __forceinline__ unsigned f2bf(float f) { unsigned u = __builtin_bit_cast(unsigned, f); return (u + 0x7fffu + ((u >> 16) & 1u)) >> 16; }
__device__ __forceinline__ unsigned pk2(float lo, float hi) { return f2bf(lo) | (f2bf(hi) << 16); }

#define XB_TMO      128
#define XB_XCNT(j)  (256  + 64 * (j))
#define XB_XSUB(j)  (1280 + 64 * (j))
#define XB_XGEN(j)  (2304 + 64 * (j))
#define XB_TOP      3328
#define XB_TOPGEN   3392
#define XCD_BAR_WORDS 3456
#define XB_SPIN_CAP (1u << 18)

__device__ __forceinline__ unsigned xb_ld(unsigned* p)              { return __hip_atomic_load(p, __ATOMIC_RELAXED, __HIP_MEMORY_SCOPE_AGENT); }
__device__ __forceinline__ unsigned xb_add(unsigned* p, unsigned v) { return __hip_atomic_fetch_add(p, v, __ATOMIC_RELAXED, __HIP_MEMORY_SCOPE_AGENT); }
__device__ __forceinline__ unsigned xb_xcc_id() { return (unsigned)__builtin_amdgcn_s_getreg((3 << 11) | 20) & 0xFu; }
#define XB_SPIN(cond, bar) do { unsigned _sp = 0; while (cond) { __builtin_amdgcn_s_sleep(1); \
    if ((++_sp & 255u) == 0u) { if (xb_ld(&(bar)[XB_TMO])) break; if (_sp > XB_SPIN_CAP) { atomicAdd(&(bar)[XB_TMO], 1u); break; } } } } while (0)

struct XcdBarrier {
    unsigned* bar; unsigned x;
    volatile LAS unsigned* st;
};

__device__ __forceinline__ XcdBarrier xcd_barrier_post(unsigned* bar, volatile LAS unsigned* st) {
    XcdBarrier b; b.bar = bar; b.x = xb_xcc_id(); b.st = st;
    if (threadIdx.x == 0) (void)xb_add(&bar[XB_XCNT(b.x)], 1u);
    return b;
}
__device__ __forceinline__ void xcd_barrier_complete(unsigned* bar, unsigned x, unsigned& nloc, unsigned& nx) {
    const unsigned G = gridDim.x * gridDim.y * gridDim.z;
    unsigned sum, cnt, mine, sp = 0u;
    for (;;) {
        sum = 0u; cnt = 0u; mine = 0u;
#pragma unroll
        for (unsigned j = 0; j < 16; ++j) { const unsigned c = xb_ld(&bar[XB_XCNT(j)]); sum += c; cnt += (c > 0u) ? 1u : 0u; mine = (j == x) ? c : mine; }
        if (sum == G) break;
        __builtin_amdgcn_s_sleep(1);
        if ((++sp & 255u) == 0u) { if (xb_ld(&bar[XB_TMO])) break; if (sp > XB_SPIN_CAP) { atomicAdd(&bar[XB_TMO], 1u); break; } }
    }
    nloc = mine > 0u ? mine : 1u; nx = cnt > 0u ? cnt : 1u;
}

__device__ __forceinline__ void xcd_barrier(const XcdBarrier& b) {
    asm volatile("s_waitcnt vmcnt(0)" ::: "memory");
    __syncthreads();
    if (threadIdx.x == 0) {
        unsigned* bar = b.bar;
        __builtin_amdgcn_s_waitcnt(0);
        unsigned nloc = b.st[0], nx = b.st[1];
        if (nloc == 0u) { xcd_barrier_complete(bar, b.x, nloc, nx); b.st[0] = nloc; b.st[1] = nx; }
        const unsigned old = xb_add(&bar[XB_XSUB(b.x)], 1u);
        const unsigned gen = old / nloc;
        if (old + 1u == (gen + 1u) * nloc) {
            __builtin_amdgcn_fence(__ATOMIC_RELEASE, "agent");
            asm volatile("s_waitcnt vmcnt(0)" ::: "memory");
            const unsigned og = xb_add(&bar[XB_TOP], 1u);
            const unsigned tg = og / nx;
            if (og + 1u == (tg + 1u) * nx) xb_add(&bar[XB_TOPGEN], 1u);
            else XB_SPIN(xb_ld(&bar[XB_TOPGEN]) == tg, bar);
            __builtin_amdgcn_fence(__ATOMIC_ACQUIRE, "agent");
            xb_add(&bar[XB_XGEN(b.x)], 1u);
            asm volatile("s_waitcnt vmcnt(0)" ::: "memory");
        } else {
            XB_SPIN(xb_ld(&bar[XB_XGEN(b.x)]) == gen, bar);
            __builtin_amdgcn_fence(__ATOMIC_ACQUIRE, "agent");
            asm volatile("s_waitcnt vmcnt(0)" ::: "memory");
        }
    }
    __syncthreads();
}

typedef float f32x16 __attribute__((ext_vector_type(16)));
typedef unsigned u32x2 __attribute__((ext_vector_type(2)));
typedef unsigned u32x4 __attribute__((ext_vector_type(4)));
struct Frame {
    LAS unsigned char* lds; volatile LAS unsigned* MISC; gu32* ctl;
    int tid, lane, wave, vcu, G;
};
__device__ __forceinline__ float bf2f(bf16 b) { return __uint_as_float((unsigned)b << 16); }
__device__ __forceinline__ float bflo(unsigned w) { return __uint_as_float(w << 16); }
__device__ __forceinline__ float bfhi(unsigned w) { return __uint_as_float(w & 0xffff0000u); }
template <int CTRL, int RMASK> __device__ __forceinline__ float dppadd(float x) {
    const int m = __builtin_amdgcn_update_dpp(0, __builtin_bit_cast(int, x), CTRL, RMASK, 0xF, false);
    return x + __builtin_bit_cast(float, m);
}
__device__ __forceinline__ float dpp_sum63(float x) {
    x = dppadd<0xB1, 0xF>(x); x = dppadd<0x4E, 0xF>(x); x = dppadd<0x141, 0xF>(x); x = dppadd<0x140, 0xF>(x);
    x = dppadd<0x142, 0xA>(x); x = dppadd<0x143, 0xC>(x); return x;
}
__device__ __forceinline__ float rdlane(float x, int l) { return __builtin_bit_cast(float, __builtin_amdgcn_readlane(__builtin_bit_cast(int, x), l)); }
__device__ __forceinline__ float wave_allsum(float x) { return rdlane(dpp_sum63(x), 63); }
__device__ __forceinline__ float row16_allsum(float x) { x = dppadd<0xB1, 0xF>(x); x = dppadd<0x4E, 0xF>(x); x = dppadd<0x141, 0xF>(x); x = dppadd<0x140, 0xF>(x); return x; }

__device__ __forceinline__ void p0_transpose_tile(const float* W, int ldw, int k0, int sn0, bf16* WT, int K, int dn0, LAS float* scr, int lane) {
#pragma unroll 8
    for (int i = 0; i < 32; ++i) { const int kk = 2 * i + (lane >> 5); scr[kk * 33 + (lane & 31)] = sn0 >= 0 ? W[(size_t)(k0 + kk) * ldw + sn0 + (lane & 31)] : 0.f; }
    LDS_WAIT(); asm volatile("" ::: "memory");
    const int c = lane & 7;
#pragma unroll
    for (int j = 0; j < 4; ++j) { const int n = (lane >> 3) + 8 * j; const LAS float* s = scr + (8 * c) * 33 + n;
        v4u o; o.x = pk2(s[0 * 33], s[1 * 33]); o.y = pk2(s[2 * 33], s[3 * 33]); o.z = pk2(s[4 * 33], s[5 * 33]); o.w = pk2(s[6 * 33], s[7 * 33]);
        *(GAS v4u*)(WT + (size_t)(dn0 + n) * K + k0 + 8 * c) = o; }
    LDS_WAIT(); asm volatile("" ::: "memory");
}
__device__ __forceinline__ int w1_src_col(int n) {
    if (n < 3072) return n;
    if (n < 4096) return 3200 + (n - 3072);
    if (n < 5120) return 4224 + (n - 4096);
    if (n < 6144) return 5248 + (n - 5120);
    if (n < 7168) return 7296 + (n - 6144);
    if (n < 7296) return 3072 + (n - 7168);
    if (n < 7424) return -1;
    return 6272 + (n - 7424);
}
struct In { const float *x, *p, *g_pre, *w_in, *mu, *w0, *w_up, *a0, *a_up, *k_k, *k_a, *r_k, *lnx_w, *lnx_b, *w_out, *g_post, *w_ple, *w_plg, *g_ple; };

__device__ __forceinline__ void p0_prologue(Frame& F, const In& I, unsigned char* ws) {
    LAS float* scr = (LAS float*)(F.lds + RING_OFF + F.wave * 16384);
    const int gw = F.vcu * NWAVES + F.wave, NGW = F.G * NWAVES, lane = F.lane;
    bf16* Z = (bf16*)(ws + WS_Z); bf16* W1T = Z + (size_t)64 * 256 * DM;
    constexpr int I_1 = 264 * 32, I_2 = 64 * 32, I_3 = 64 * 32, I_P = 64 * 4;
    constexpr int NITEMS = I_1 + I_2 + I_3 + I_P;
    for (int it = gw; it < NITEMS; it += NGW) {
        int r = it;
        if (r < I_1) { const int nb = r % 264, kb = r / 264; p0_transpose_tile(I.w_in, INW, kb * 64, w1_src_col(nb * 32), W1T, DM, nb * 32, scr, lane); continue; } r -= I_1;
        if (r < I_2) { const int nb = r % 64, kb = r / 64; p0_transpose_tile(I.w_out, DM, kb * 64, nb * 32, (bf16*)(ws + WS_W2T), DM, nb * 32, scr, lane); continue; } r -= I_2;
        if (r < I_3) { const int nb = r % 64, kb = r / 64; p0_transpose_tile(I.w_plg, DM, kb * 64, nb * 32, (bf16*)(ws + WS_W3T), DM, nb * 32, scr, lane); continue; } r -= I_3;
        { const int nb = r % 64, kb = r / 64; p0_transpose_tile(I.w_ple, DM, kb * 64, nb * 32, (bf16*)(ws + WS_WPT), PLE_DIM, nb * 32, scr, lane); }
    }
    for (int m = gw; m < M; m += NGW) {
        const GAS f32x4* xr = (const GAS f32x4*)(I.x + (size_t)m * DM) + lane; const GAS f32x4* gr = (const GAS f32x4*)I.g_pre + lane;
        f32x4 v[8]; float s = 0.f;
#pragma unroll
        for (int j = 0; j < 8; ++j) { v[j] = xr[64 * j]; s += (v[j].x * v[j].x + v[j].y * v[j].y) + (v[j].z * v[j].z + v[j].w * v[j].w); }
        const float rinv = 1.0f / sqrtf(wave_allsum(s) * (1.0f / DM) + RMS_EPS);
        GAS u32x2* o8 = (GAS u32x2*)(Z + (size_t)m * DM) + lane;
#pragma unroll
        for (int j = 0; j < 8; ++j) { const f32x4 g = gr[64 * j]; u32x2 o; o.x = pk2(v[j].x * rinv * g.x, v[j].y * rinv * g.y); o.y = pk2(v[j].z * rinv * g.z, v[j].w * rinv * g.w); o8[64 * j] = o; }
    }
    { const GAS f32x4* pr = (const GAS f32x4*)I.p; GAS u32x2* po = (GAS u32x2*)(ws + WS_PB); const int n4 = M * PLE_DIM / 4;
      for (int i = gw * 64 + lane; i < n4; i += NGW * 64) { const f32x4 v = pr[i]; u32x2 o; o.x = pk2(v.x, v.y); o.y = pk2(v.z, v.w); po[i] = o; } }
}

__device__ __forceinline__ int crow(int r, int hi) { return (r & 3) + 8 * (r >> 2) + 4 * hi; }
__device__ __forceinline__ float softplusf(float z) { return fmaxf(z, 0.f) + __logf(1.0f + __expf(-fabsf(z))); }
__device__ __forceinline__ void attn_tile(const bf16* Q, const bf16* KS, const bf16* VT, const bf16* GS, bf16* MIX, int b, int h, int qt, int lane) {
    const int r32 = lane & 31, hi = lane >> 5, t0 = qt * 32; const size_t rowb = (size_t)b * SEQ;
    bf16x8 qf[4];
    { const bf16* qp = Q + (rowb + t0 + r32) * 1024 + h * 64 + hi * 8;
#pragma unroll
      for (int d0 = 0; d0 < 4; ++d0) qf[d0] = *(const GAS bf16x8*)(qp + d0 * 16); }
    f32x16 o0 = {}, o1 = {}; float R = 0.f;
    const bf16* vt0 = VT + (size_t)(h * 64 + r32) * M + rowb + 4 * hi;
    for (int kb = qt; kb >= 0; --kb) {
        const int s0 = kb * 32;
        bf16x8 kf[4];
        { const bf16* kp = KS + (rowb + s0 + r32) * 1024 + h * 64 + hi * 8;
#pragma unroll
          for (int d0 = 0; d0 < 4; ++d0) kf[d0] = *(const GAS bf16x8*)(kp + d0 * 16); }
        u32x2 va[2][2][2];
#pragma unroll
        for (int dt = 0; dt < 2; ++dt)
#pragma unroll
            for (int s = 0; s < 2; ++s)
#pragma unroll
                for (int hf = 0; hf < 2; ++hf) va[dt][s][hf] = *(const GAS u32x2*)(vt0 + (size_t)dt * 32 * M + s0 + 16 * s + 8 * hf);
        f32x16 p = {};
#pragma unroll
        for (int d0 = 0; d0 < 4; ++d0) p = __builtin_amdgcn_mfma_f32_32x32x16_bf16(kf[d0], qf[d0], p, 0, 0, 0);
        const bool diag = (kb == qt);
        float l1[16], lb[16];
#pragma unroll
        for (int r = 0; r < 16; ++r) { const float z = p[r]; const float sp = softplusf(z); const bool valid = !diag || (crow(r, hi) < r32); l1[r] = valid ? -sp : 0.f; lb[r] = valid ? (z - sp) : -INFINITY; }
        float mine[4], oth[4], tot[4];
#pragma unroll
        for (int g = 0; g < 4; ++g) { mine[g] = (l1[4 * g] + l1[4 * g + 1]) + (l1[4 * g + 2] + l1[4 * g + 3]);
            auto rr = __builtin_amdgcn_permlane32_swap(__float_as_uint(mine[g]), __float_as_uint(mine[g]), false, false);
            const float lo = __uint_as_float(rr[0]), up = __uint_as_float(rr[1]); oth[g] = hi ? lo : up; tot[g] = lo + up; }
        float T[4]; T[3] = 0.f; T[2] = tot[3]; T[1] = T[2] + tot[2]; T[0] = T[1] + tot[1];
        float w[16];
#pragma unroll
        for (int g = 0; g < 4; ++g) { float e = T[g] + (hi ? 0.f : oth[g]) + R;
            w[4 * g + 3] = __expf(lb[4 * g + 3] + e); e += l1[4 * g + 3];
            w[4 * g + 2] = __expf(lb[4 * g + 2] + e); e += l1[4 * g + 2];
            w[4 * g + 1] = __expf(lb[4 * g + 1] + e); e += l1[4 * g + 1];
            w[4 * g + 0] = __expf(lb[4 * g + 0] + e); }
        R += T[0] + tot[0];
        u32x4 pb0, pb1;
        pb0.x = pk2(w[0], w[1]); pb0.y = pk2(w[2], w[3]); pb0.z = pk2(w[4], w[5]); pb0.w = pk2(w[6], w[7]);
        pb1.x = pk2(w[8], w[9]); pb1.y = pk2(w[10], w[11]); pb1.z = pk2(w[12], w[13]); pb1.w = pk2(w[14], w[15]);
        const bf16x8 pB0 = __builtin_bit_cast(bf16x8, pb0), pB1 = __builtin_bit_cast(bf16x8, pb1);
#define VA(dt, s) __builtin_bit_cast(bf16x8, (u32x4){va[dt][s][0].x, va[dt][s][0].y, va[dt][s][1].x, va[dt][s][1].y})
        o0 = __builtin_amdgcn_mfma_f32_32x32x16_bf16(VA(0, 0), pB0, o0, 0, 0, 0); o0 = __builtin_amdgcn_mfma_f32_32x32x16_bf16(VA(0, 1), pB1, o0, 0, 0, 0);
        o1 = __builtin_amdgcn_mfma_f32_32x32x16_bf16(VA(1, 0), pB0, o1, 0, 0, 0); o1 = __builtin_amdgcn_mfma_f32_32x32x16_bf16(VA(1, 1), pB1, o1, 0, 0, 0);
#undef VA
        if (__all(R < SB_CUT)) break;
    }
    const size_t row = rowb + t0 + r32;
#pragma unroll
    for (int dt = 0; dt < 2; ++dt)
#pragma unroll
        for (int g = 0; g < 4; ++g) { const int d = dt * 32 + 8 * g + 4 * hi; const u32x2 gw = *(const GAS u32x2*)(GS + row * 1024 + h * 64 + d);
            float gv[4] = {bflo(gw.x), bfhi(gw.x), bflo(gw.y), bfhi(gw.y)}; float ov[4];
#pragma unroll
            for (int e = 0; e < 4; ++e) { const float o = dt ? o1[4 * g + e] : o0[4 * g + e]; ov[e] = o * gv[e] / (1.0f + __expf(-gv[e])); }
            u32x2 st; st.x = pk2(ov[0], ov[1]); st.y = pk2(ov[2], ov[3]); *(GAS u32x2*)(MIX + row * 2048 + 1024 + h * 64 + d) = st; }
}
__device__ __forceinline__ void p2_attention(Frame& F, unsigned char* ws, int wg0) {
    const bf16 *Q = (const bf16*)(ws + WS_Q), *KS = (const bf16*)(ws + WS_KS), *VT = (const bf16*)(ws + WS_VT), *GS = (const bf16*)(ws + WS_GS); bf16* MIX = (bf16*)(ws + WS_MIX);
    if ((int)blockIdx.x < wg0) return;
    const int gw = ((int)blockIdx.x - wg0) * NWAVES + F.wave, NGW = (F.G - wg0) * NWAVES;
    for (int u = gw; u < BATCH * NH * (SEQ / 32); u += NGW) { const int qt = u & 255, bh = u >> 8; attn_tile(Q, KS, VT, GS, MIX, bh >> 4, bh & 15, qt, F.lane); }
}

constexpr int PT = 72, MATB = 64 * PT * 2;
constexpr int LB_KQ = 0, LB_RQ = 1, LB_BK = 2, LB_KK = 3, LB_BD = 4, LB_KD = 5, LB_V = 6, LB_LA = 7, LB_AUK = 8, LB_ARB = 9, LB_ARK = 10, LB_PA = 11;
constexpr int LB_LB = LB_BK, LB_PB = LB_KK;
constexpr int L_G = 12 * MATB, L_SEG = L_G + 64 * 64 * 4;
static_assert(L_SEG + 8 * 64 * 4 <= RING_BYTES, "chunk LDS map");
constexpr size_t WS_NCT = WS_Z, WS_MCT = WS_Z + 32 * MiB, WS_QC = WS_Z + 64 * MiB, WS_YLOC = 451 * MiB, WS_BON = 483 * MiB, WS_SC = WS_R;
typedef short v4i16_t __attribute__((ext_vector_type(4)));
__device__ __forceinline__ bf16x8 ldA(const LAS unsigned char* X, int m0, int ks, int lane) { return *(const LAS bf16x8*)(X + ((m0 + (lane & 15)) * PT + 32 * ks + 8 * (lane >> 4)) * 2); }
__device__ __forceinline__ bf16x8 ldTr(const LAS unsigned char* X, int c0, int ks, int lane) {
    const int g = lane >> 4, i = lane & 15, q = i >> 2, p = i & 3;
    const LAS unsigned char* a = X + ((32 * ks + 8 * g + q) * PT + c0 + 4 * p) * 2;
    const v4i16_t lo = __builtin_amdgcn_ds_read_tr16_b64_v4i16((LAS v4i16_t*)a), hi = __builtin_amdgcn_ds_read_tr16_b64_v4i16((LAS v4i16_t*)(a + 4 * PT * 2));
    return (bf16x8){lo[0], lo[1], lo[2], lo[3], hi[0], hi[1], hi[2], hi[3]};
}
__device__ __forceinline__ void stRM(LAS unsigned char* X, int m0, int n0, const f32x4& acc, int lane) {
    const int n = lane & 15, q = lane >> 4;
#pragma unroll
    for (int r = 0; r < 4; ++r) *(LAS unsigned short*)(X + ((m0 + 4 * q + r) * PT + n0 + n) * 2) = (unsigned short)f2bf(acc[r]);
}
#define MMA16(a, b, c) __builtin_amdgcn_mfma_f32_16x16x32_bf16(a, b, c, 0, 0, 0)
struct PreRegs { v4u rc, rp, kc, kp, vc, vp, lc0, lc1, lp0, lp1; f32x4 wu0, wu1, au0, au1; };

__device__ __forceinline__ void p3a_prepass(Frame& F, const In& I, unsigned char* ws) {
    const int tid = F.tid, lane = F.lane, wave = F.wave;
    LAS unsigned char* L = F.lds + RING_OFF;
#define LBUF(i) (L + (i) * MATB)
    const bf16 *Rb = (const bf16*)(ws + WS_R), *Kb = (const bf16*)(ws + WS_K), *Vb = (const bf16*)(ws + WS_V), *LORA = (const bf16*)(ws + WS_LORA);
    bf16* NCT = (bf16*)(ws + WS_NCT); bf16* MCT = (bf16*)(ws + WS_MCT); bf16* QC = (bf16*)(ws + WS_QC); bf16* YLOC = (bf16*)(ws + WS_YLOC); float* BON = (float*)(ws + WS_BON);
    const int st = tid >> 3, k8 = (tid & 7) * 8;
    const int m0 = (wave & 3) * 16, nb = (wave >> 2) * 32;
    const int tn = lane & 15, tq = lane >> 4;
    auto LOAD = [&](int unit, PreRegs& g) {
        const int bh = unit >> 7, c = unit & 127, b = bh >> 4, h = bh & 15; const int t = c * 64 + st; const size_t row = (size_t)b * SEQ + t; const size_t o = row * 1024 + h * 64 + k8;
        g.rc = *(const GAS v4u*)(Rb + o); g.kc = *(const GAS v4u*)(Kb + o); g.vc = *(const GAS v4u*)(Vb + o);
        const size_t lo = row * 256 + 2 * k8;
        g.lc0 = *(const GAS v4u*)(LORA + lo); g.lc1 = *(const GAS v4u*)(LORA + lo + 8);
        if (t > 0) { g.rp = *(const GAS v4u*)(Rb + o - 1024); g.kp = *(const GAS v4u*)(Kb + o - 1024); g.vp = *(const GAS v4u*)(Vb + o - 1024); g.lp0 = *(const GAS v4u*)(LORA + lo - 256); g.lp1 = *(const GAS v4u*)(LORA + lo - 256 + 8); }
        else { g.rp = (v4u){0u, 0u, 0u, 0u}; g.kp = g.rp; g.vp = g.rp; g.lp0 = g.rp; g.lp1 = g.rp; }
        const size_t wo = (size_t)st * 1024 + h * 64 + k8;
        g.wu0 = *(const GAS f32x4*)(I.w_up + wo); g.wu1 = *(const GAS f32x4*)(I.w_up + wo + 4); g.au0 = *(const GAS f32x4*)(I.a_up + wo); g.au1 = *(const GAS f32x4*)(I.a_up + wo + 4);
    };
    PreRegs g;
    int unit = F.vcu;
    if (unit < 4096) LOAD(unit, g);
    for (; unit < 4096; unit += F.G) {
        const int bh = unit >> 7, c = unit & 127, b = bh >> 4, h = bh & 15; const size_t row0 = (size_t)b * SEQ + c * 64; const int ch0 = h * 64;
        { const unsigned lcw[8] = {g.lc0.x, g.lc0.y, g.lc0.z, g.lc0.w, g.lc1.x, g.lc1.y, g.lc1.z, g.lc1.w}, lpw[8] = {g.lp0.x, g.lp0.y, g.lp0.z, g.lp0.w, g.lp1.x, g.lp1.y, g.lp1.z, g.lp1.w};
          const int j0 = 2 * k8; const bool isw = j0 < 64; float lv[16];
#pragma unroll
          for (int e = 0; e < 16; ++e) { const float cur = (e & 1) ? bfhi(lcw[e >> 1]) : bflo(lcw[e >> 1]), prev = (e & 1) ? bfhi(lpw[e >> 1]) : bflo(lpw[e >> 1]);
              const float sv = cur + (prev - cur) * I.mu[3072 + j0 + e]; const float e2 = __expf(2.0f * sv); lv[e] = isw ? (1.0f - 2.0f * __builtin_amdgcn_rcpf(e2 + 1.0f)) : sv; }
          v4u w0_, w1_; w0_.x = pk2(lv[0], lv[1]); w0_.y = pk2(lv[2], lv[3]); w0_.z = pk2(lv[4], lv[5]); w0_.w = pk2(lv[6], lv[7]); w1_.x = pk2(lv[8], lv[9]); w1_.y = pk2(lv[10], lv[11]); w1_.z = pk2(lv[12], lv[13]); w1_.w = pk2(lv[14], lv[15]);
          LAS unsigned char* dst = isw ? LBUF(LB_LA) : LBUF(LB_AUK); const int jc = isw ? j0 : j0 - 64;
          *(LAS v4u*)(dst + (st * PT + jc) * 2) = w0_; *(LAS v4u*)(dst + (st * PT + jc + 8) * 2) = w1_;
          v4u u_; u_.x = pk2(g.wu0.x, g.wu0.y); u_.y = pk2(g.wu0.z, g.wu0.w); u_.z = pk2(g.wu1.x, g.wu1.y); u_.w = pk2(g.wu1.z, g.wu1.w); *(LAS v4u*)(LBUF(LB_ARB) + (st * PT + k8) * 2) = u_;
          u_.x = pk2(g.au0.x, g.au0.y); u_.y = pk2(g.au0.z, g.au0.w); u_.z = pk2(g.au1.x, g.au1.y); u_.w = pk2(g.au1.z, g.au1.w); *(LAS v4u*)(LBUF(LB_ARK) + (st * PT + k8) * 2) = u_; }
        __syncthreads();
#pragma unroll
        for (int ti = 0; ti < 2; ++ti) { const int n0 = nb + 16 * ti; f32x4 xw = {0.f, 0.f, 0.f, 0.f}, xa = xw;
#pragma unroll
            for (int ks = 0; ks < 2; ++ks) { xw = MMA16(ldA(LBUF(LB_LA), m0, ks, lane), ldTr(LBUF(LB_ARB), n0, ks, lane), xw); xa = MMA16(ldA(LBUF(LB_AUK), m0, ks, lane), ldTr(LBUF(LB_ARK), n0, ks, lane), xa); }
            const float w0c = I.w0[ch0 + n0 + tn], a0c = I.a0[ch0 + n0 + tn]; f32x4 av;
#pragma unroll
            for (int r = 0; r < 4; ++r) { *(LAS float*)(L + L_G + ((m0 + 4 * tq + r) * 64 + n0 + tn) * 4) = -0.60653065971263342f * __builtin_amdgcn_rcpf(1.0f + __expf(-(xw[r] + w0c))); av[r] = __builtin_amdgcn_rcpf(1.0f + __expf(-(xa[r] + a0c))); }
            stRM(LBUF(LB_PA), m0, n0, av, lane); }
        __syncthreads();
        float rs[8], kt[8], kk[8], bb[8], vs[8], lw[8];
        { const unsigned rcw[4] = {g.rc.x, g.rc.y, g.rc.z, g.rc.w}, rpw[4] = {g.rp.x, g.rp.y, g.rp.z, g.rp.w}, kcw[4] = {g.kc.x, g.kc.y, g.kc.z, g.kc.w}, kpw[4] = {g.kp.x, g.kp.y, g.kp.z, g.kp.w};
          const unsigned vcw[4] = {g.vc.x, g.vc.y, g.vc.z, g.vc.w}, vpw[4] = {g.vp.x, g.vp.y, g.vp.z, g.vp.w};
          const v4u aw = *(const LAS v4u*)(LBUF(LB_PA) + (st * PT + k8) * 2); const unsigned acw[4] = {aw.x, aw.y, aw.z, aw.w};
          const f32x4 l0 = *(const LAS f32x4*)(L + L_G + (st * 64 + k8) * 4), l1 = *(const LAS f32x4*)(L + L_G + (st * 64 + k8 + 4) * 4);
          float ss = 0.f, bon = 0.f; float av[8], ks[8];
#pragma unroll
          for (int e = 0; e < 8; ++e) { const int cch = ch0 + k8 + e; const int w2 = e >> 1; const bool hi = e & 1;
              const float rc = hi ? bfhi(rcw[w2]) : bflo(rcw[w2]), rp = hi ? bfhi(rpw[w2]) : bflo(rpw[w2]), kc = hi ? bfhi(kcw[w2]) : bflo(kcw[w2]), kp = hi ? bfhi(kpw[w2]) : bflo(kpw[w2]);
              const float vc = hi ? bfhi(vcw[w2]) : bflo(vcw[w2]), vp = hi ? bfhi(vpw[w2]) : bflo(vpw[w2]); av[e] = hi ? bfhi(acw[w2]) : bflo(acw[w2]);
              rs[e] = rc + (rp - rc) * I.mu[cch]; ks[e] = kc + (kp - kc) * I.mu[1024 + cch]; vs[e] = vc + (vp - vc) * I.mu[2048 + cch];
              kk[e] = ks[e] * I.k_k[cch]; ss += kk[e] * kk[e]; kt[e] = ks[e] * (1.0f + (av[e] - 1.0f) * I.k_a[cch]); bon += rs[e] * kt[e] * I.r_k[cch]; }
          ss = dppadd<0xB1, 0xF>(ss); ss = dppadd<0x4E, 0xF>(ss); ss = dppadd<0x141, 0xF>(ss);
          bon = dppadd<0xB1, 0xF>(bon); bon = dppadd<0x4E, 0xF>(bon); bon = dppadd<0x141, 0xF>(bon);
          const float inv = 1.0f / sqrtf(ss + L2_EPS);
#pragma unroll
          for (int e = 0; e < 8; ++e) { kk[e] *= inv; bb[e] = av[e] * kk[e]; }
          lw[0] = l0.x; lw[1] = l0.y; lw[2] = l0.z; lw[3] = l0.w; lw[4] = l1.x; lw[5] = l1.y; lw[6] = l1.z; lw[7] = l1.w;
          if ((tid & 7) == 0) BON[(row0 + st) * 16 + h] = bon; }
        if (unit + F.G < 4096) LOAD(unit + F.G, g);
        __syncthreads();
        { const int k = tid & 63, sg = tid >> 6; LAS float* Gp = (LAS float*)(L + L_G); LAS float* Sg = (LAS float*)(L + L_SEG);
          float v8[8]; float run = 0.f;
#pragma unroll
          for (int i = 0; i < 8; ++i) { run += Gp[(sg * 8 + i) * 64 + k]; v8[i] = run; }
          Sg[sg * 64 + k] = run;
          __syncthreads();
          float pre = 0.f;
#pragma unroll
          for (int s2 = 0; s2 < 7; ++s2) pre += (s2 < sg) ? Sg[s2 * 64 + k] : 0.f;
#pragma unroll
          for (int i = 0; i < 8; ++i) Gp[(sg * 8 + i) * 64 + k] = v8[i] + pre; }
        __syncthreads();
        { const LAS float* Gp = (const LAS float*)(L + L_G); float gg[8], gc[8];
          { const f32x4 a0 = *(const LAS f32x4*)(Gp + st * 64 + k8), a1 = *(const LAS f32x4*)(Gp + st * 64 + k8 + 4), c0 = *(const LAS f32x4*)(Gp + 63 * 64 + k8), c1 = *(const LAS f32x4*)(Gp + 63 * 64 + k8 + 4);
            gg[0] = a0.x; gg[1] = a0.y; gg[2] = a0.z; gg[3] = a0.w; gg[4] = a1.x; gg[5] = a1.y; gg[6] = a1.z; gg[7] = a1.w; gc[0] = c0.x; gc[1] = c0.y; gc[2] = c0.z; gc[3] = c0.w; gc[4] = c1.x; gc[5] = c1.y; gc[6] = c1.z; gc[7] = c1.w; }
          float o[7][8];
#pragma unroll
          for (int e = 0; e < 8; ++e) { const float eg = __expf(gg[e]), egm = __expf(gg[e] - lw[e]), ei = __expf(-gg[e]), ed = __expf(gc[e] - gg[e]);
              o[LB_KQ][e] = kk[e] * egm; o[LB_RQ][e] = rs[e] * eg; o[LB_BK][e] = bb[e] * ei; o[LB_KK][e] = kt[e] * ei; o[LB_BD][e] = bb[e] * ed; o[LB_KD][e] = kt[e] * ed; o[LB_V][e] = vs[e]; }
#pragma unroll
          for (int mtx = 0; mtx < 7; ++mtx) { v4u w; w.x = pk2(o[mtx][0], o[mtx][1]); w.y = pk2(o[mtx][2], o[mtx][3]); w.z = pk2(o[mtx][4], o[mtx][5]); w.w = pk2(o[mtx][6], o[mtx][7]);
              *(LAS v4u*)(LBUF(mtx) + (st * PT + k8) * 2) = w; } }
        __syncthreads();
        f32x4 Pacc[2];
#pragma unroll
        for (int ti = 0; ti < 2; ++ti) { const int n0 = nb + 16 * ti; f32x4 ub = {0.f, 0.f, 0.f, 0.f}, uk = ub, rb = ub, rk = ub;
#pragma unroll
            for (int ks = 0; ks < 2; ++ks) { const bf16x8 aq = ldA(LBUF(LB_KQ), m0, ks, lane), ar = ldA(LBUF(LB_RQ), m0, ks, lane), b1 = ldA(LBUF(LB_BK), n0, ks, lane), b2 = ldA(LBUF(LB_KK), n0, ks, lane);
                ub = MMA16(aq, b1, ub); uk = MMA16(aq, b2, uk); rb = MMA16(ar, b1, rb); rk = MMA16(ar, b2, rk); }
#pragma unroll
            for (int r = 0; r < 4; ++r) { const int t = m0 + 4 * tq + r, j = n0 + tn; if (!(j < t)) { ub[r] = 0.f; uk[r] = 0.f; } if (!(j <= t)) { rb[r] = 0.f; rk[r] = 0.f; } Pacc[ti][r] = (t == j ? 1.0f : 0.0f) - ub[r]; }
            stRM(LBUF(LB_LA), m0, n0, ub, lane); stRM(LBUF(LB_AUK), m0, n0, uk, lane); stRM(LBUF(LB_ARB), m0, n0, rb, lane); stRM(LBUF(LB_ARK), m0, n0, rk, lane); stRM(LBUF(LB_PA), m0, n0, Pacc[ti], lane); }
        __syncthreads();
#define SQR(dst, src) do { _Pragma("unroll") for (int ti = 0; ti < 2; ++ti) { const int n0 = nb + 16 * ti; f32x4 a_ = {0.f, 0.f, 0.f, 0.f}; \
            _Pragma("unroll") for (int ks = 0; ks < 2; ++ks) a_ = MMA16(ldA(LBUF(src), m0, ks, lane), ldTr(LBUF(src), n0, ks, lane), a_); stRM(LBUF(dst), m0, n0, a_, lane); } } while (0)
#define PUPD(pdst, psrc, lsrc) do { _Pragma("unroll") for (int ti = 0; ti < 2; ++ti) { const int n0 = nb + 16 * ti; \
            _Pragma("unroll") for (int ks = 0; ks < 2; ++ks) Pacc[ti] = MMA16(ldA(LBUF(psrc), m0, ks, lane), ldTr(LBUF(lsrc), n0, ks, lane), Pacc[ti]); stRM(LBUF(pdst), m0, n0, Pacc[ti], lane); } } while (0)
        SQR(LB_LB, LB_LA); __syncthreads();
        PUPD(LB_PB, LB_PA, LB_LB); SQR(LB_LA, LB_LB); __syncthreads();
        PUPD(LB_PA, LB_PB, LB_LA); SQR(LB_LB, LB_LA); __syncthreads();
        PUPD(LB_PB, LB_PA, LB_LB); SQR(LB_LA, LB_LB); __syncthreads();
        PUPD(LB_PA, LB_PB, LB_LA); SQR(LB_LB, LB_LA); __syncthreads();
        PUPD(LB_PB, LB_PA, LB_LB); __syncthreads();
#undef SQR
#undef PUPD
#pragma unroll
        for (int ti = 0; ti < 2; ++ti) { const int n0 = nb + 16 * ti; f32x4 a_ = {0.f, 0.f, 0.f, 0.f};
#pragma unroll
            for (int ks = 0; ks < 2; ++ks) a_ = MMA16(ldA(LBUF(LB_AUK), m0, ks, lane), ldTr(LBUF(LB_V), n0, ks, lane), a_);
            stRM(LBUF(LB_LA), m0, n0, a_, lane); }
        __syncthreads();
#pragma unroll
        for (int ti = 0; ti < 2; ++ti) { const int n0 = nb + 16 * ti; f32x4 u_ = {0.f, 0.f, 0.f, 0.f}, w_ = u_;
#pragma unroll
            for (int ks = 0; ks < 2; ++ks) { const bf16x8 at = ldA(LBUF(LB_PB), m0, ks, lane); u_ = MMA16(at, ldTr(LBUF(LB_LA), n0, ks, lane), u_); w_ = MMA16(at, ldTr(LBUF(LB_KQ), n0, ks, lane), w_); }
            u_ = -u_; stRM(LBUF(LB_PA), m0, n0, u_, lane); stRM(LBUF(LB_LB), m0, n0, w_, lane); }
        __syncthreads();
        const size_t ub16 = (size_t)unit * 4096;
#pragma unroll
        for (int ti = 0; ti < 2; ++ti) { const int n0 = nb + 16 * ti;
            f32x4 qa = {0.f, 0.f, 0.f, 0.f}, ya = qa, ma = qa, na = qa;
#pragma unroll
            for (int ks = 0; ks < 2; ++ks) { const bf16x8 wq = ldTr(LBUF(LB_LB), m0, ks, lane), arb = ldA(LBUF(LB_ARB), n0, ks, lane), u0 = ldTr(LBUF(LB_PA), m0, ks, lane), vv = ldTr(LBUF(LB_V), m0, ks, lane), ark = ldA(LBUF(LB_ARK), n0, ks, lane);
                qa = MMA16(wq, arb, qa); ya = MMA16(u0, arb, ya); ya = MMA16(vv, ark, ya);
                const bf16x8 bdn = ldTr(LBUF(LB_BD), n0, ks, lane), bdm = ldTr(LBUF(LB_BD), m0, ks, lane), kdm = ldTr(LBUF(LB_KD), m0, ks, lane), u0n = ldTr(LBUF(LB_PA), n0, ks, lane), vn = ldTr(LBUF(LB_V), n0, ks, lane);
                ma = MMA16(wq, bdn, ma); na = MMA16(bdm, u0n, na); na = MMA16(kdm, vn, na); }
            { const u32x2 rq = *(const LAS u32x2*)(LBUF(LB_RQ) + ((n0 + tn) * PT + m0 + 4 * tq) * 2);
              u32x2 qo; qo.x = pk2(bflo(rq.x) - qa[0], bfhi(rq.x) - qa[1]); qo.y = pk2(bflo(rq.y) - qa[2], bfhi(rq.y) - qa[3]);
              const size_t o = (row0 + n0 + tn) * 1024 + ch0 + m0 + 4 * tq;
              *(GAS u32x2*)(QC + o) = qo; u32x2 yo; yo.x = pk2(ya[0], ya[1]); yo.y = pk2(ya[2], ya[3]); *(GAS u32x2*)(YLOC + o) = yo; }
            { const LAS float* Gp = (const LAS float*)(L + L_G); float mv[4];
#pragma unroll
              for (int r = 0; r < 4; ++r) { const int k = m0 + 4 * tq + r, kp = n0 + tn; mv[r] = (k == kp ? __expf(Gp[63 * 64 + k]) : 0.f) - ma[r]; }
              u32x2 mo; mo.x = pk2(mv[0], mv[1]); mo.y = pk2(mv[2], mv[3]);
              *(GAS u32x2*)(MCT + ub16 + (size_t)(n0 + tn) * 64 + m0 + 8 * (tq & 1) + 4 * (tq >> 1)) = mo; }
            { u32x2 no; no.x = pk2(na[0], na[1]); no.y = pk2(na[2], na[3]); *(GAS u32x2*)(NCT + ub16 + (size_t)(n0 + tn) * 64 + m0 + 4 * tq) = no; } }
        __syncthreads();
    }
#undef LBUF
}

__device__ __forceinline__ void p3b_state(Frame& F, unsigned char* ws) {
    const int lane = F.lane;
    if (F.wave != 0 || blockIdx.x >= 64) return;
    const int bh = blockIdx.x >> 1, vh = blockIdx.x & 1, r32 = lane & 31, hi = lane >> 5;
    const bf16* NCT = (const bf16*)(ws + WS_NCT); const bf16* MCT = (const bf16*)(ws + WS_MCT); bf16* SC = (bf16*)(ws + WS_SC);
    f32x16 T0 = {}, T1 = {};
    bf16x8 mf[2][2][2]; f32x16 n0v, n1v;
    auto LOADC = [&](int c, bf16x8 (&m)[2][2][2], f32x16& a0, f32x16& a1) {
        const size_t ub = (size_t)(bh * 128 + c) * 4096;
#pragma unroll
        for (int i = 0; i < 2; ++i)
#pragma unroll
            for (int j = 0; j < 2; ++j)
#pragma unroll
                for (int s = 0; s < 2; ++s) m[i][j][s] = *(const GAS bf16x8*)(MCT + ub + (size_t)(32 * i + r32) * 64 + 16 * (2 * j + s) + 8 * hi);
#pragma unroll
        for (int gq = 0; gq < 4; ++gq) { const bf16* np_ = NCT + ub + (size_t)(vh * 32 + r32) * 64 + 8 * gq + 4 * hi;
            const u32x2 x0 = *(const GAS u32x2*)np_, x1 = *(const GAS u32x2*)(np_ + 32);
            a0[4 * gq] = bflo(x0.x); a0[4 * gq + 1] = bfhi(x0.x); a0[4 * gq + 2] = bflo(x0.y); a0[4 * gq + 3] = bfhi(x0.y);
            a1[4 * gq] = bflo(x1.x); a1[4 * gq + 1] = bfhi(x1.x); a1[4 * gq + 2] = bflo(x1.y); a1[4 * gq + 3] = bfhi(x1.y); }
    };
    LOADC(0, mf, n0v, n1v);
    for (int c = 0; c < 128; ++c) {
        bf16x8 mg[2][2][2]; f32x16 g0, g1;
        if (c + 1 < 128) LOADC(c + 1, mg, g0, g1); else { g0 = n0v; g1 = n1v;
#pragma unroll
            for (int i = 0; i < 2; ++i)
#pragma unroll
                for (int j = 0; j < 2; ++j)
#pragma unroll
                    for (int s = 0; s < 2; ++s) mg[i][j][s] = mf[i][j][s]; }
        u32x4 tb[2][2];
#pragma unroll
        for (int s = 0; s < 2; ++s) { tb[0][s].x = pk2(T0[8 * s], T0[8 * s + 1]); tb[0][s].y = pk2(T0[8 * s + 2], T0[8 * s + 3]); tb[0][s].z = pk2(T0[8 * s + 4], T0[8 * s + 5]); tb[0][s].w = pk2(T0[8 * s + 6], T0[8 * s + 7]);
            tb[1][s].x = pk2(T1[8 * s], T1[8 * s + 1]); tb[1][s].y = pk2(T1[8 * s + 2], T1[8 * s + 3]); tb[1][s].z = pk2(T1[8 * s + 4], T1[8 * s + 5]); tb[1][s].w = pk2(T1[8 * s + 6], T1[8 * s + 7]); }
        { bf16* sp = SC + (size_t)(bh * 128 + c) * 4096 + (size_t)(vh * 32 + r32) * 64 + 4 * hi;
#pragma unroll
          for (int j = 0; j < 2; ++j)
#pragma unroll
              for (int s = 0; s < 2; ++s) { *(GAS u32x2*)(sp + 32 * j + 16 * s) = (u32x2){tb[j][s].x, tb[j][s].y}; *(GAS u32x2*)(sp + 32 * j + 16 * s + 8) = (u32x2){tb[j][s].z, tb[j][s].w}; } }
        f32x16 a0 = n0v, a1 = n1v;
#pragma unroll
        for (int j = 0; j < 2; ++j)
#pragma unroll
            for (int s = 0; s < 2; ++s) { const bf16x8 bfr = __builtin_bit_cast(bf16x8, tb[j][s]);
                a0 = __builtin_amdgcn_mfma_f32_32x32x16_bf16(mf[0][j][s], bfr, a0, 0, 0, 0); a1 = __builtin_amdgcn_mfma_f32_32x32x16_bf16(mf[1][j][s], bfr, a1, 0, 0, 0); }
        T0 = a0; T1 = a1; n0v = g0; n1v = g1;
#pragma unroll
        for (int i = 0; i < 2; ++i)
#pragma unroll
            for (int j = 0; j < 2; ++j)
#pragma unroll
                for (int s = 0; s < 2; ++s) mf[i][j][s] = mg[i][j][s];
    }
}

__device__ __forceinline__ void p4_post(Frame& F, const In& I, unsigned char* ws) {
    const int lane = F.lane, tn = lane & 15, tq = lane >> 4;
    const bf16 *SC = (const bf16*)(ws + WS_SC), *QC = (const bf16*)(ws + WS_QC), *YLOC = (const bf16*)(ws + WS_YLOC), *Vb = (const bf16*)(ws + WS_V), *Gb = (const bf16*)(ws + WS_G); const float* BON = (const float*)(ws + WS_BON);
    bf16* MIX = (bf16*)(ws + WS_MIX);
    const int gw = F.vcu * NWAVES + F.wave, NGW = F.G * NWAVES;
    for (int it = gw; it < 4096 * 4; it += NGW) {
        const int unit = it >> 2, n0 = (it & 3) * 16, bh = unit >> 7, c = unit & 127, b = bh >> 4, h = bh & 15; const size_t row = (size_t)b * SEQ + c * 64 + n0 + tn; const int ch0 = h * 64;
        const bf16* sc = SC + (size_t)unit * 4096;
        f32x4 acc[4] = {{0.f, 0.f, 0.f, 0.f}, {0.f, 0.f, 0.f, 0.f}, {0.f, 0.f, 0.f, 0.f}, {0.f, 0.f, 0.f, 0.f}};
#pragma unroll
        for (int ks = 0; ks < 2; ++ks) { const bf16x8 bq = *(const GAS bf16x8*)(QC + row * 1024 + ch0 + 32 * ks + 8 * tq);
#pragma unroll
            for (int mt = 0; mt < 4; ++mt) { const bf16x8 as = *(const GAS bf16x8*)(sc + (size_t)(16 * mt + tn) * 64 + 32 * ks + 8 * tq); acc[mt] = MMA16(as, bq, acc[mt]); } }
        float y[4][4]; float s = 0.f;
#pragma unroll
        for (int mt = 0; mt < 4; ++mt) { const u32x2 yl = *(const GAS u32x2*)(YLOC + row * 1024 + ch0 + 16 * mt + 4 * tq);
            y[mt][0] = acc[mt][0] + bflo(yl.x); y[mt][1] = acc[mt][1] + bfhi(yl.x); y[mt][2] = acc[mt][2] + bflo(yl.y); y[mt][3] = acc[mt][3] + bfhi(yl.y); s += (y[mt][0] + y[mt][1]) + (y[mt][2] + y[mt][3]); }
        s += __shfl_xor(s, 16); s += __shfl_xor(s, 32);
        const float mean = s * (1.0f / 64.0f); float q = 0.f;
#pragma unroll
        for (int mt = 0; mt < 4; ++mt)
#pragma unroll
            for (int r = 0; r < 4; ++r) { y[mt][r] -= mean; q += y[mt][r] * y[mt][r]; }
        q += __shfl_xor(q, 16); q += __shfl_xor(q, 32);
        const float rstd = 1.0f / sqrtf(q * (1.0f / 64.0f) + LNX_EPS);
        const float bon = BON[row * 16 + h]; const bool first = (c == 0) && (n0 + tn == 0);
#pragma unroll
        for (int mt = 0; mt < 4; ++mt) { const int cc = ch0 + 16 * mt + 4 * tq; const size_t o = row * 1024 + cc;
            const f32x4 lw = *(const GAS f32x4*)(I.lnx_w + cc), lb = *(const GAS f32x4*)(I.lnx_b + cc), mu = *(const GAS f32x4*)(I.mu + 2048 + cc);
            const u32x2 vc = *(const GAS u32x2*)(Vb + o), gg = *(const GAS u32x2*)(Gb + o); u32x2 vp = {0u, 0u}; if (!first) vp = *(const GAS u32x2*)(Vb + o - 1024);
            const float vcf[4] = {bflo(vc.x), bfhi(vc.x), bflo(vc.y), bfhi(vc.y)}, vpf[4] = {bflo(vp.x), bfhi(vp.x), bflo(vp.y), bfhi(vp.y)}, gf[4] = {bflo(gg.x), bfhi(gg.x), bflo(gg.y), bfhi(gg.y)};
            float ov[4];
#pragma unroll
            for (int r = 0; r < 4; ++r) { const float vsft = vcf[r] + (vpf[r] - vcf[r]) * mu[r]; ov[r] = (y[mt][r] * rstd * lw[r] + lb[r] + bon * vsft) * (gf[r] / (1.0f + __expf(-gf[r]))); }
            u32x2 st; st.x = pk2(ov[0], ov[1]); st.y = pk2(ov[2], ov[3]); *(GAS u32x2*)(MIX + row * 2048 + cc) = st; }
    }
}

__device__ __forceinline__ void p6_rows(Frame& F, const In& I, unsigned char* ws) {
    float* out = (float*)(ws + WS_MIXOUT);
    const float *MIXOUT = (const float*)(ws + WS_MIXOUT), *PLERAW = (const float*)(ws + WS_PLERAW); bf16 *H1B = (bf16*)(ws + WS_H1B), *PLEN = (bf16*)(ws + WS_PLEN);
    const int gw = F.vcu * NWAVES + F.wave, NGW = F.G * NWAVES, lane = F.lane;
    for (int m = gw; m < M; m += NGW) {
        { const GAS f32x4* mr = (const GAS f32x4*)(MIXOUT + (size_t)m * DM) + lane; const GAS f32x4* xr = (const GAS f32x4*)(I.x + (size_t)m * DM) + lane; const GAS f32x4* gr = (const GAS f32x4*)I.g_post + lane;
          f32x4 v[8]; float s = 0.f;
#pragma unroll
          for (int j = 0; j < 8; ++j) { v[j] = mr[64 * j]; s += (v[j].x * v[j].x + v[j].y * v[j].y) + (v[j].z * v[j].z + v[j].w * v[j].w); }
          const float rinv = 1.0f / sqrtf(wave_allsum(s) * (1.0f / DM) + RMS_EPS);
          GAS f32x4* orow = (GAS f32x4*)(out + (size_t)m * DM) + lane; GAS u32x2* hb = (GAS u32x2*)(H1B + (size_t)m * DM) + lane;
#pragma unroll
          for (int j = 0; j < 8; ++j) { const f32x4 g = gr[64 * j], x = xr[64 * j]; f32x4 hh; hh.x = x.x + v[j].x * rinv * g.x; hh.y = x.y + v[j].y * rinv * g.y; hh.z = x.z + v[j].z * rinv * g.z; hh.w = x.w + v[j].w * rinv * g.w;
              orow[64 * j] = hh; u32x2 o; o.x = pk2(hh.x, hh.y); o.y = pk2(hh.z, hh.w); hb[64 * j] = o; } }
        { const GAS f32x4* pr = (const GAS f32x4*)(PLERAW + (size_t)m * DM) + lane; const GAS f32x4* gr = (const GAS f32x4*)I.g_ple + lane;
          f32x4 v[8]; float s = 0.f;
#pragma unroll
          for (int j = 0; j < 8; ++j) { v[j] = pr[64 * j]; s += (v[j].x * v[j].x + v[j].y * v[j].y) + (v[j].z * v[j].z + v[j].w * v[j].w); }
          const float rinv = 1.0f / sqrtf(wave_allsum(s) * (1.0f / DM) + RMS_EPS);
          GAS u32x2* pn = (GAS u32x2*)(PLEN + (size_t)m * DM) + lane;
#pragma unroll
          for (int j = 0; j < 8; ++j) { const f32x4 g = gr[64 * j]; u32x2 o; o.x = pk2(v[j].x * rinv * g.x, v[j].y * rinv * g.y); o.y = pk2(v[j].z * rinv * g.z, v[j].w * rinv * g.w); pn[64 * j] = o; } }
    }
}

struct Args { const float* in[19]; float* out; unsigned char* ws; int ph_lo, ph_hi, li, pad; };
__global__ void __launch_bounds__(NWAVES * 64, 2) hymba_fwd(Args args) {
    extern __shared__ __attribute__((aligned(16))) unsigned char lds[];
    Frame F;
    F.lds = (LAS unsigned char*)lds; F.MISC = (volatile LAS unsigned*)(F.lds + MISC_OFF);
    F.tid = threadIdx.x; F.lane = F.tid & 63; F.wave = __builtin_amdgcn_readfirstlane(F.tid >> 6);
    F.G = gridDim.x; { const int bx = blockIdx.x; F.vcu = (F.G % 8 == 0) ? (bx % 8) * (F.G / 8) + bx / 8 : bx; }
    unsigned char* ws = args.ws; F.ctl = (gu32*)(ws + WS_CTL);
    In I; I.x = args.in[0]; I.p = args.in[1]; I.g_pre = args.in[2]; I.w_in = args.in[3]; I.mu = args.in[4]; I.w0 = args.in[5]; I.w_up = args.in[6]; I.a0 = args.in[7]; I.a_up = args.in[8];
    I.k_k = args.in[9]; I.k_a = args.in[10]; I.r_k = args.in[11]; I.lnx_w = args.in[12]; I.lnx_b = args.in[13]; I.w_out = args.in[14]; I.g_post = args.in[15]; I.w_ple = args.in[16]; I.w_plg = args.in[17]; I.g_ple = args.in[18];
    for (int u = F.tid; u < (LDS_BYTES - LDSCTL_OFF) / 4; u += NWAVES * 64) ((LAS unsigned*)(F.lds + LDSCTL_OFF))[u] = 0u;
    __syncthreads();
    const bool multi = (args.ph_hi - args.ph_lo) > 1;
    XcdBarrier bar; bar.bar = (unsigned*)(F.ctl + CW_BAR); bar.x = 0; bar.st = nullptr;
    if (multi) bar = xcd_barrier_post((unsigned*)(F.ctl + CW_BAR), F.MISC + 8);
    const int lo = args.ph_lo, hi = args.ph_hi;
#define IN(k) (lo <= (k) && (k) < hi)
#define BOTH(k) (IN(k) && IN((k) + 1))
    bf16* Z = (bf16*)(ws + WS_Z);
    if (IN(0)) { p0_prologue(F, I, ws); if (BOTH(0)) xcd_barrier(bar); }
    if (IN(1)) {
        pg8::Gemm g{Z, Z, M, 8448, DM}; pg8::SchedIn S{F.G, (int)blockIdx.x};
        pg8::EpiIn E{ws, WS_R, WS_Q, WS_LORA, WS_VT};
        pg8::gemm_phase<pg8::EpiIn, pg8::SchedIn, true, true>(F.lds + RING_OFF, g, S, E);
        if (BOTH(1)) xcd_barrier(bar);
    }
    if (IN(2)) { p3a_prepass(F, I, ws); if (BOTH(2)) xcd_barrier(bar); }
    if (IN(3)) { p3b_state(F, ws); p2_attention(F, ws, 64); if (BOTH(3)) xcd_barrier(bar); }
    if (IN(4)) { p4_post(F, I, ws); if (BOTH(4)) xcd_barrier(bar); }
    if (IN(5)) {
        { pg8::Gemm g{(const bf16*)(ws + WS_MIX), (const bf16*)(ws + WS_W2T), M, DM, DM}; pg8::StaticOrder S; S.init(M, DM, F.G, (int)blockIdx.x);
          pg8::EpiF32 E{(float*)(ws + WS_MIXOUT), DM};
          pg8::gemm_phase<pg8::EpiF32, pg8::StaticOrder, true, true>(F.lds + RING_OFF, g, S, E); }
        __syncthreads();
        { pg8::Gemm g{(const bf16*)(ws + WS_PB), (const bf16*)(ws + WS_WPT), M, DM, PLE_DIM}; pg8::StaticOrder S; S.init(M, DM, F.G, (int)blockIdx.x);
          pg8::EpiF32 E{(float*)(ws + WS_PLERAW), DM};
          pg8::gemm_phase<pg8::EpiF32, pg8::StaticOrder, true, true>(F.lds + RING_OFF, g, S, E); }
        if (BOTH(5)) xcd_barrier(bar);
    }
    if (IN(6)) { p6_rows(F, I, ws); if (BOTH(6)) xcd_barrier(bar); }
    if (IN(7)) {
        pg8::Gemm g{(const bf16*)(ws + WS_H1B), (const bf16*)(ws + WS_W3T), M, DM, DM}; pg8::StaticOrder S; S.init(M, DM, F.G, (int)blockIdx.x);
        pg8::EpiFinal E{args.out, (const float*)(ws + WS_MIXOUT), (const bf16*)(ws + WS_PLEN), DM};
        pg8::gemm_phase<pg8::EpiFinal, pg8::StaticOrder, true, true>(F.lds + RING_OFF, g, S, E);
    }
#undef IN
#undef BOTH
}

extern "C" void kernel_launch(void* const* d_in, const int* in_sizes, int n_in, void* d_out, int out_size, void* d_ws, size_t ws_size, hipStream_t stream) {
    static int grid = 0;
    if (grid == 0) {
        if (n_in != 19 || in_sizes[0] != M * DM || out_size != M * DM || ws_size < WS_END) { fprintf(stderr, "kernel_launch: unexpected shapes (n_in %d, in0 %d, out %d, ws %zu); nothing launched\n", n_in, n_in > 0 ? in_sizes[0] : -1, out_size, ws_size); grid = -1; return; }
        int dev = 0, cus = 0, per_cu = 0;
        if (hipGetDevice(&dev) != hipSuccess || hipDeviceGetAttribute(&cus, hipDeviceAttributeMultiprocessorCount, dev) != hipSuccess) { grid = -1; return; }
        if (hipFuncSetAttribute((const void*)hymba_fwd, hipFuncAttributeMaxDynamicSharedMemorySize, LDS_BYTES) != hipSuccess) { fprintf(stderr, "kernel_launch: hipFuncSetAttribute failed\n"); grid = -1; return; }
        if (hipOccupancyMaxActiveBlocksPerMultiprocessor(&per_cu, (const void*)hymba_fwd, NWAVES * 64, LDS_BYTES) != hipSuccess || per_cu < 1) { fprintf(stderr, "kernel_launch: occupancy query says %d\n", per_cu); }
        (void)hipGetLastError();
        grid = cus;
    }
    if (grid < 0) return;
    if (hipMemsetAsync((char*)d_ws + WS_CTL, 0, CTL_ZERO_BYTES, stream) != hipSuccess) return;
    Args a{};
    for (int i = 0; i < 19; ++i) a.in[i] = (const float*)d_in[i];
    a.out = (float*)d_out; a.ws = (unsigned char*)d_ws;
    constexpr int NL = MK_N_LAUNCHES;
    for (int li = 0; li < NL; ++li) {
        a.ph_lo = (NL == 1) ? 0 : li; a.ph_hi = (NL == 1) ? N_PHASES : li + 1; a.li = li;
        hipLaunchKernelGGL(hymba_fwd, dim3(grid), dim3(NWAVES * 64), LDS_BYTES, stream, a);
    }
}
```

```cpp
#include <hip/hip_runtime.h>
#include <cstdio>
#include <cstdint>
namespace pg8 {
#define PG8_LAS __attribute__((address_space(3)))
typedef unsigned short bf16_t;
typedef short bf16x8 __attribute__((ext_vector_type(8)));
typedef float f32x4 __attribute__((ext_vector_type(4)));
typedef unsigned u32x4 __attribute__((ext_vector_type(4)));
constexpr int BM = 256, BK = 64, HALF = 128, HTB = HALF * BK * 2  , STAGE_BYTES = 8 * HTB, NXCD = 8, WGM = 8;

__host__ __device__ __forceinline__ int lds_byte(int r, int c) { const int st = (r >> 4) * 2 + (c >> 5), rr = r & 15, cc = c & 31, ob = rr * 64 + cc * 2; return st * 1024 + (ob ^ (((ob >> 9) & 1) << 5)); }
__host__ __device__ __forceinline__ void stage_rc(int b, int& R, int& C) { const int st = b / 1024, sb = b % 1024, swz = sb ^ (((sb >> 9) & 1) << 5); R = (st >> 1) * 16 + swz / 64; C = (st & 1) * 32 + (swz % 64) / 2; }
__host__ __device__ __forceinline__ int perm32(int rho) { const int n = rho >> 4, i = rho & 15; return 8 * (i >> 2) + 4 * n + (i & 3); }

struct Unit { int pm, pn; };
struct Gemm { const bf16_t* A; const bf16_t* Bt; int M, N, K; };

struct StaticOrder {
    int nM, nN, nwg, G, c;
    __host__ __device__ void init(int M, int N, int G_, int c_) { nM = M / BM; nN = N / BM; nwg = nM * nN; G = G_; c = c_; }
    __host__ __device__ bool next(int i, Unit& u) const {
        const long L = (long)i * G + c; if (L >= nwg) return false;
        int wgid = (int)L; { const int q = nwg / NXCD, r = nwg % NXCD, xcd = wgid % NXCD, off = wgid / NXCD; wgid = (xcd < r ? xcd * (q + 1) : r * (q + 1) + (xcd - r) * q) + off; }
        const int nig = WGM * nN, gid = wgid / nig, fm = gid * WGM, gsz = (nM - fm) < WGM ? (nM - fm) : WGM;
        u.pm = fm + ((wgid % nig) % gsz); u.pn = (wgid % nig) / gsz; return true;
    }
    __device__ __forceinline__ void a_ready(const Unit&) const {}
    __device__ __forceinline__ void done(const Unit&) const {}
};

__device__ __forceinline__ unsigned cvt_pk_bf16(float lo, float hi) { unsigned r; asm volatile("v_cvt_pk_bf16_f32 %0, %1, %2" : "=v"(r) : "v"(lo), "v"(hi)); return r; }
typedef float f32x2 __attribute__((ext_vector_type(2)));
struct EpiF32 {
    static constexpr bool PERM = false, AFTER_DRAIN = false;
    float* C; int ldc;
    __device__ __forceinline__ void operator()(const f32x4 (&acc)[2][2][4][2], const Unit& u, int wr, int wc, int fr, int fq) const {
        const int row0 = u.pm * BM + wr * 64 + fr, col0 = u.pn * BM + wc * 32 + 4 * fq;
#pragma unroll
        for (int ai = 0; ai < 2; ++ai)
#pragma unroll
            for (int m = 0; m < 4; ++m) { float* rowp = C + (size_t)(row0 + ai * HALF + m * 16) * ldc + col0;
#pragma unroll
                for (int bj = 0; bj < 2; ++bj)
#pragma unroll
                    for (int n = 0; n < 2; ++n) *(f32x4*)(rowp + bj * HALF + n * 16) = acc[ai][bj][m][n]; }
    }
};
struct EpiIn {
    static constexpr bool PERM = true, AFTER_DRAIN = false;
    unsigned char* ws; size_t off_r, off_q, off_lora, off_vt;
    __device__ __forceinline__ void operator()(const f32x4 (&acc)[2][2][4][2], const Unit& u, int wr, int wc, int fr, int fq) const {
        bf16_t* base; int ldc = 1024, rowt, colt, mode = 0; float sc = 1.f;
        if (u.pn >= 64) { const int tile = u.pn - 64, grp = tile >> 2; rowt = u.pm * BM; colt = (tile & 3) * BM;
            size_t off;
            if (grp < 4) off = off_r + (size_t)grp * (32u << 20);
            else if (grp == 4) { off = off_q; sc = 0.18033688011112042f; mode = 1; }
            else if (grp == 5) { off = off_q + (32u << 20); mode = 1; }
            else if (grp == 6) { off = off_q + (96u << 20); mode = 1; }
            else { off = off_lora; ldc = 256; colt = 0; }
            base = (bf16_t*)(ws + off);
        } else { base = (bf16_t*)(ws + off_vt); rowt = (u.pm - 93) * BM; colt = u.pn * BM; mode = 2; }
        const int row0 = rowt + wr * 64 + fr, col0 = colt + wc * 32 + 8 * fq;
#pragma unroll
        for (int ai = 0; ai < 2; ++ai)
#pragma unroll
            for (int m = 0; m < 4; ++m) { const int r = row0 + ai * HALF + m * 16;
#pragma unroll
                for (int bj = 0; bj < 2; ++bj) { const int c = col0 + bj * HALF; f32x4 v0 = acc[ai][bj][m][0] * sc, v1 = acc[ai][bj][m][1] * sc;
                    u32x4 w; w.x = cvt_pk_bf16(v0[0], v0[1]); w.y = cvt_pk_bf16(v0[2], v0[3]); w.z = cvt_pk_bf16(v1[0], v1[1]); w.w = cvt_pk_bf16(v1[2], v1[3]);
                    size_t o;
                    if (mode == 0) o = (size_t)r * ldc + c;
                    else if (mode == 1) o = ((size_t)((r >> 13) * 16 + (c >> 6)) * 8192 + (r & 8191)) * 64 + (c & 63);
                    else o = ((size_t)(((c >> 13) * 16 + (r >> 6)) * 256 + ((c & 8191) >> 5)) * 64 + (r & 63)) * 32 + (c & 31);
                    *(u32x4*)(base + o) = w; } }
    }
};
struct SchedIn {
    int G, c;
    __device__ __forceinline__ bool next(int i, Unit& u) const {
        const int L = i * G + c; if (L >= 2112) return false;
        if (L < 1856) { const int nwg = 1856, nM = 64, nN = 29; int wgid = L; { const int q = nwg / NXCD, r = nwg % NXCD, xcd = wgid % NXCD, off = wgid / NXCD; wgid = (xcd < r ? xcd * (q + 1) : r * (q + 1) + (xcd - r) * q) + off; }
            const int nig = WGM * nN, gid = wgid / nig, fm = gid * WGM, gsz = (nM - fm) < WGM ? (nM - fm) : WGM;
            u.pm = fm + ((wgid % nig) % gsz); u.pn = 64 + (wgid % nig) / gsz; }
        else { const int l2 = L - 1856; u.pm = 93 + (l2 & 3); u.pn = l2 >> 2; }
        return true;
    }
    __device__ __forceinline__ void a_ready(const Unit&) const {}
    __device__ __forceinline__ void done(const Unit&) const {}
};
struct EpiFinal {
    static constexpr bool PERM = false, AFTER_DRAIN = false;
    float* __restrict__ out; const float* __restrict__ h1; const bf16_t* __restrict__ ple; int ldc;
    __device__ __forceinline__ void operator()(const f32x4 (&acc)[2][2][4][2], const Unit& u, int wr, int wc, int fr, int fq) const {
        typedef unsigned u32x2v __attribute__((ext_vector_type(2)));
        const int row0 = u.pm * BM + wr * 64 + fr, col0 = u.pn * BM + wc * 32 + 4 * fq;
#pragma unroll
        for (int ai = 0; ai < 2; ++ai)
#pragma unroll
            for (int mp = 0; mp < 2; ++mp) { f32x4 hv[2][2][2]; u32x2v pv[2][2][2];
#pragma unroll
                for (int mm = 0; mm < 2; ++mm) { const size_t ro = (size_t)(row0 + ai * HALF + (2 * mp + mm) * 16) * ldc + col0;
#pragma unroll
                    for (int bj = 0; bj < 2; ++bj)
#pragma unroll
                        for (int n = 0; n < 2; ++n) { const size_t o = ro + bj * HALF + n * 16; hv[mm][bj][n] = __builtin_nontemporal_load((const f32x4*)(h1 + o)); pv[mm][bj][n] = __builtin_nontemporal_load((const u32x2v*)(ple + o)); } }
#pragma unroll
                for (int mm = 0; mm < 2; ++mm) { const int m = 2 * mp + mm; const size_t ro = (size_t)(row0 + ai * HALF + m * 16) * ldc + col0;
#pragma unroll
                    for (int bj = 0; bj < 2; ++bj)
#pragma unroll
                        for (int n = 0; n < 2; ++n) { const size_t o = ro + bj * HALF + n * 16; const f32x4 h = hv[mm][bj][n]; const u32x2v pw = pv[mm][bj][n];
                            const f32x4 a = acc[ai][bj][m][n]; f32x4 pl; pl[0] = __uint_as_float(pw.x << 16); pl[1] = __uint_as_float(pw.x & 0xffff0000u); pl[2] = __uint_as_float(pw.y << 16); pl[3] = __uint_as_float(pw.y & 0xffff0000u);
                            f32x4 r;
#pragma unroll
                            for (int e = 0; e < 4; ++e) r[e] = h[e] + pl[e] * __builtin_amdgcn_rcpf(1.0f + __expf(-a[e]));
                            *(f32x4*)(out + o) = r; } } }
    }
};
template <class Epi, class Sched, bool ALIGN_EPI = false, bool SP2 = false>
__device__ __forceinline__ void gemm_phase(PG8_LAS unsigned char* lds, const Gemm g, const Sched& S, const Epi& E) {
    const int tid = threadIdx.x, wid = __builtin_amdgcn_readfirstlane(tid >> 6), lane = tid & 63, wr = wid >> 2, wc = wid & 3, fr = lane & 15, fq = lane >> 4;
    const int K = g.K, nt = K / BK;
    unsigned voffA[2], voffB[2];
#pragma unroll
    for (int i = 0; i < 2; ++i) { int R, C; stage_rc(tid * 16 + i * 8192, R, C); const int Rb = Epi::PERM ? ((R & ~31) + perm32(R & 31)) : R;
        voffA[i] = (unsigned)(R * K + C) * 2u; voffB[i] = (unsigned)(Rb * K + C) * 2u; }
    const size_t kstep = (size_t)(BK * 2);
    const size_t hstep = (size_t)HALF * K * 2;
    const size_t tstep = 2 * hstep;
    const unsigned ldsw = (unsigned)wid * 1024u;
    const int aoff = lds_byte(wr * 64 + fr, fq * 8), boff = lds_byte(wc * 32 + fr, fq * 8);
#define PG8_SA(b, h) (((b) * 2 + (h)) * HTB)
#define PG8_SB(b, h) ((4 + (b) * 2 + (h)) * HTB)
#define PG8_STAGE(bufoff, gbase, voff) do { _Pragma("unroll") for (int _i = 0; _i < 2; ++_i) \
        __builtin_amdgcn_global_load_lds((const unsigned*)((const char*)(gbase) + (voff)[_i]), (PG8_LAS unsigned*)(lds + (bufoff) + ldsw + _i * 8192), 16, 0, 0); } while (0)
#define PG8_LDA(dst, b, h) do { _Pragma("unroll") for (int m = 0; m < 4; ++m) _Pragma("unroll") for (int k = 0; k < 2; ++k) dst[m][k] = *(const PG8_LAS bf16x8*)(lds + PG8_SA(b, h) + aoff + m * 2048 + k * 1024); } while (0)
#define PG8_LDB(dst, b, h) do { _Pragma("unroll") for (int n = 0; n < 2; ++n) _Pragma("unroll") for (int k = 0; k < 2; ++k) dst[n][k] = *(const PG8_LAS bf16x8*)(lds + PG8_SB(b, h) + boff + n * 2048 + k * 1024); } while (0)
#define PG8_MMA(ai, bj, At, Bt) do { __builtin_amdgcn_s_setprio(1); _Pragma("unroll") for (int m = 0; m < 4; ++m) _Pragma("unroll") for (int n = 0; n < 2; ++n) _Pragma("unroll") for (int k = 0; k < 2; ++k) \
        acc[ai][bj][m][n] = __builtin_amdgcn_mfma_f32_16x16x32_bf16(Bt[n][k], At[m][k], acc[ai][bj][m][n], 0, 0, 0); __builtin_amdgcn_s_setprio(0); } while (0)
#define PG8_WAIT_V(n) asm volatile("s_waitcnt vmcnt(" #n ")" ::: "memory")
#define PG8_WAIT_L(n) asm volatile("s_waitcnt lgkmcnt(" #n ")" ::: "memory")
#define PG8_BAR __builtin_amdgcn_s_barrier()
#define PG8_SCHED __builtin_amdgcn_sched_barrier(0)
    Unit cur, nxt; int ui = 0;
    if (!S.next(0, cur)) return;
    f32x4 acc[2][2][4][2];
#pragma unroll
    for (int a = 0; a < 2; ++a)
#pragma unroll
        for (int b = 0; b < 2; ++b)
#pragma unroll
            for (int m = 0; m < 4; ++m)
#pragma unroll
                for (int n = 0; n < 2; ++n) acc[a][b][m][n] = (f32x4){0.f, 0.f, 0.f, 0.f};
    bf16x8 At[4][2], B0[2][2], B1[2][2];
    const char* cA = (const char*)g.A + (size_t)cur.pm * tstep; const char* cB = (const char*)g.Bt + (size_t)cur.pn * tstep;
    S.a_ready(cur);
    if constexpr (SP2) {
        PG8_STAGE(PG8_SB(0, 0), cB, voffB); PG8_STAGE(PG8_SB(0, 1), cB + hstep, voffB); PG8_STAGE(PG8_SA(0, 0), cA, voffA); PG8_STAGE(PG8_SA(0, 1), cA + hstep, voffA);
        if (wr == 1) PG8_BAR;
        PG8_WAIT_V(2); PG8_BAR;
        PG8_STAGE(PG8_SB(1, 0), cB + kstep, voffB); PG8_STAGE(PG8_SA(1, 0), cA + kstep, voffA); PG8_STAGE(PG8_SB(1, 1), cB + hstep + kstep, voffB);
        PG8_WAIT_V(6); PG8_BAR;
    } else {
        PG8_STAGE(PG8_SB(0, 0), cB, voffB); PG8_STAGE(PG8_SA(0, 0), cA, voffA); PG8_STAGE(PG8_SB(0, 1), cB + hstep, voffB); PG8_STAGE(PG8_SA(0, 1), cA + hstep, voffA);
        if (wr == 1) PG8_BAR;
        PG8_WAIT_V(4); PG8_BAR;
        PG8_STAGE(PG8_SB(1, 0), cB + kstep, voffB); PG8_STAGE(PG8_SA(1, 0), cA + kstep, voffA); PG8_STAGE(PG8_SB(1, 1), cB + hstep + kstep, voffB);
        PG8_WAIT_V(6); PG8_BAR;
    }
    for (;;) {
        const bool has_next = S.next(ui + 1, nxt);
        const char* nA = has_next ? (const char*)g.A + (size_t)nxt.pm * tstep : cA; const char* nB = has_next ? (const char*)g.Bt + (size_t)nxt.pn * tstep : cB;
        for (int t = 0; t < nt; t += 2) {
            const bool last = (t == nt - 2);
            const char* a1 = cA + (size_t)(t + 1) * kstep;
            const char* a2 = last ? nA : cA + (size_t)(t + 2) * kstep; const char* b2 = last ? nB : cB + (size_t)(t + 2) * kstep;
            const char* a3 = a2 + kstep; const char* b3 = b2 + kstep;
            if (last && has_next) S.a_ready(nxt);
            if constexpr (SP2) {
            PG8_LDB(B0, 0, 0); PG8_LDB(B1, 0, 1); PG8_SCHED; PG8_LDA(At, 0, 0); PG8_STAGE(PG8_SA(1, 1), a1 + hstep, voffA);
            PG8_WAIT_V(8); PG8_WAIT_L(0); PG8_BAR; PG8_MMA(0, 0, At, B0); PG8_MMA(0, 1, At, B1); PG8_BAR; PG8_SCHED;
            PG8_LDA(At, 0, 1); PG8_STAGE(PG8_SB(0, 0), b2, voffB); PG8_STAGE(PG8_SB(0, 1), b2 + hstep, voffB); PG8_STAGE(PG8_SA(0, 0), a2, voffA);
            PG8_WAIT_V(8); PG8_WAIT_L(0); PG8_BAR; PG8_MMA(1, 0, At, B0); PG8_MMA(1, 1, At, B1); PG8_BAR; PG8_SCHED;
            PG8_LDB(B0, 1, 0); PG8_LDB(B1, 1, 1); PG8_SCHED; PG8_LDA(At, 1, 0); PG8_STAGE(PG8_SA(0, 1), a2 + hstep, voffA);
            PG8_WAIT_V(8); PG8_WAIT_L(0); PG8_BAR; PG8_MMA(0, 0, At, B0); PG8_MMA(0, 1, At, B1); PG8_BAR; PG8_SCHED;
            PG8_LDA(At, 1, 1); PG8_STAGE(PG8_SB(1, 0), b3, voffB); PG8_STAGE(PG8_SB(1, 1), b3 + hstep, voffB); PG8_STAGE(PG8_SA(1, 0), a3, voffA);
            PG8_WAIT_V(8); PG8_WAIT_L(0); PG8_BAR; PG8_MMA(1, 0, At, B0); PG8_MMA(1, 1, At, B1); PG8_BAR; PG8_SCHED;
            } else {
            PG8_LDB(B0, 0, 0); PG8_SCHED; PG8_LDA(At, 0, 0); PG8_STAGE(PG8_SA(1, 1), a1 + hstep, voffA);
            PG8_WAIT_L(8); PG8_BAR; PG8_WAIT_L(0); PG8_MMA(0, 0, At, B0); PG8_BAR; PG8_SCHED;
            PG8_LDB(B1, 0, 1); PG8_STAGE(PG8_SB(0, 0), b2, voffB);
            PG8_BAR; PG8_WAIT_L(0); PG8_MMA(0, 1, At, B1); PG8_BAR;
            PG8_LDA(At, 0, 1); PG8_STAGE(PG8_SA(0, 0), a2, voffA);
            PG8_BAR; PG8_WAIT_L(0); PG8_MMA(1, 0, At, B0); PG8_BAR; PG8_SCHED;
            PG8_STAGE(PG8_SB(0, 1), b2 + hstep, voffB);
            PG8_WAIT_V(6); PG8_BAR; PG8_MMA(1, 1, At, B1); PG8_BAR;
            PG8_LDB(B0, 1, 0); PG8_SCHED; PG8_LDA(At, 1, 0); PG8_STAGE(PG8_SA(0, 1), a2 + hstep, voffA);
            PG8_WAIT_L(8); PG8_BAR; PG8_WAIT_L(0); PG8_MMA(0, 0, At, B0); PG8_BAR; PG8_SCHED;
            PG8_LDB(B1, 1, 1); PG8_STAGE(PG8_SB(1, 0), b3, voffB);
            PG8_BAR; PG8_WAIT_L(0); PG8_MMA(0, 1, At, B1); PG8_BAR;
            PG8_LDA(At, 1, 1); PG8_STAGE(PG8_SA(1, 0), a3, voffA);
            PG8_BAR; PG8_WAIT_L(0); PG8_MMA(1, 0, At, B0); PG8_BAR; PG8_SCHED;
            PG8_STAGE(PG8_SB(1, 1), b3 + hstep, voffB);
            PG8_WAIT_V(6); PG8_BAR; PG8_MMA(1, 1, At, B1); PG8_BAR;
            }
        }
        if constexpr (ALIGN_EPI) { if (wr == 0) PG8_BAR; }
        if constexpr (!Epi::AFTER_DRAIN) { E(acc, cur, wr, wc, fr, fq); S.done(cur); }
        if (!has_next) break;
#pragma unroll
        for (int a = 0; a < 2; ++a)
#pragma unroll
            for (int b = 0; b < 2; ++b)
#pragma unroll
                for (int m = 0; m < 4; ++m)
#pragma unroll
                    for (int n = 0; n < 2; ++n) acc[a][b][m][n] = (f32x4){0.f, 0.f, 0.f, 0.f};
        cur = nxt; cA = nA; cB = nB; ++ui;
        if constexpr (ALIGN_EPI) { if (wr == 1) PG8_BAR; }
    }
    PG8_WAIT_V(0);
    if constexpr (!ALIGN_EPI) { if (wr == 0) PG8_BAR; }
    PG8_BAR;
    if constexpr (Epi::AFTER_DRAIN) { E.fused(acc, cur, wr, wc, fr, fq, lds, wid, lane); S.done(cur); }
#undef PG8_SA
#undef PG8_SB
#undef PG8_STAGE
#undef PG8_LDA
#undef PG8_LDB
#undef PG8_MMA
#undef PG8_WAIT_V
#undef PG8_WAIT_L
#undef PG8_BAR
#undef PG8_SCHED
}
}

constexpr int NWAVES = 8;
constexpr int BATCH = 2, SEQ = 8192, DM = 2048, M = BATCH * SEQ, RW = 1024, NH = 16, HD = 64, PLE_DIM = 256, INW = 8320;
constexpr float RMS_EPS = 1e-6f, LNX_EPS = 64e-5f, L2_EPS = 1e-12f;
constexpr float SB_CUT = -150.1f;
#ifndef MK_N_LAUNCHES
#define MK_N_LAUNCHES 1
#endif
constexpr int N_PHASES = 8;
constexpr size_t MiB = 1u << 20;
constexpr size_t WS_CTL = 0, CTL_ZERO_BYTES = 64 * 1024;
constexpr size_t WS_Z = 1 * MiB;
constexpr size_t WS_WDEC = WS_Z, WS_ACO = WS_Z + 64 * MiB;
constexpr size_t WS_H1B = WS_Z;
constexpr size_t WS_W2T = 98 * MiB, WS_W3T = 106 * MiB, WS_WPT = 114 * MiB, WS_PB = 115 * MiB;
constexpr size_t WS_R = 123 * MiB, WS_K = 155 * MiB, WS_V = 187 * MiB, WS_G = 219 * MiB;
constexpr size_t WS_Q = 251 * MiB, WS_KS = 283 * MiB, WS_VT = 315 * MiB, WS_GS = 347 * MiB;
constexpr size_t WS_LORA = 379 * MiB;
constexpr size_t WS_MIX = 387 * MiB;
constexpr size_t WS_YRAW = WS_Q;
constexpr size_t WS_MIXOUT = WS_R;
constexpr size_t WS_PLERAW = WS_Q;
constexpr size_t WS_PLEN = WS_MIX;
constexpr size_t WS_END = 484 * MiB;
constexpr int CW_BAR = 1024;
constexpr int RING_OFF = 0, RING_BYTES = 131072;
constexpr int LDSCTL_OFF = 147456 - 512, MISC_OFF = LDSCTL_OFF + 320;
constexpr int LDS_BYTES = 147456;

#define GAS __attribute__((address_space(1)))
#define LAS __attribute__((address_space(3)))
typedef unsigned short bf16;
typedef unsigned v4u __attribute__((ext_vector_type(4)));
typedef float f32x4 __attribute__((ext_vector_type(4)));
typedef short bf16x8 __attribute__((ext_vector_type(8)));
typedef GAS unsigned gu32;
typedef GAS unsigned long long gu64;
#define RLX_AGENT __ATOMIC_RELAXED, __HIP_MEMORY_SCOPE_AGENT
#define LDS_WAIT() asm volatile("s_waitcnt lgkmcnt(0)" ::: "memory")
#define VM_WAIT() asm volatile("s_waitcnt vmcnt(0)" ::: "memory")
__device__ __forceinline__ unsigned long long rt() { return __builtin_amdgcn_s_memrealtime(); }
typedef float f32x2_t __attribute__((ext_vector_type(2))); typedef __bf16 bf16x2_t __attribute__((ext_vector_type(2)));
__device__ __forceinline__ unsigned pk2(float lo, float hi) { const f32x2_t v = {lo, hi}; const bf16x2_t b = __builtin_convertvector(v, bf16x2_t); return __builtin_bit_cast(unsigned, b); }
__device__ __forceinline__ unsigned f2bf(float f) { return pk2(f, 0.f) & 0xffffu; }

#define XB_TMO      128
#define XB_XCNT(j)  (256  + 64 * (j))
#define XB_XSUB(j)  (1280 + 64 * (j))
#define XB_XGEN(j)  (2304 + 64 * (j))
#define XB_TOP      3328
#define XB_TOPGEN   3392
#define XCD_BAR_WORDS 3456
#define XB_SPIN_CAP (1u << 18)

__device__ __forceinline__ unsigned xb_ld(unsigned* p)              { return __hip_atomic_load(p, __ATOMIC_RELAXED, __HIP_MEMORY_SCOPE_AGENT); }
__device__ __forceinline__ unsigned xb_add(unsigned* p, unsigned v) { return __hip_atomic_fetch_add(p, v, __ATOMIC_RELAXED, __HIP_MEMORY_SCOPE_AGENT); }
__device__ __forceinline__ unsigned xb_xcc_id() { return (unsigned)__builtin_amdgcn_s_getreg((3 << 11) | 20) & 0xFu; }
#define XB_SPIN(cond, bar) do { unsigned _sp = 0; while (cond) { __builtin_amdgcn_s_sleep(1); \
    if ((++_sp & 255u) == 0u) { if (xb_ld(&(bar)[XB_TMO])) break; if (_sp > XB_SPIN_CAP) { atomicAdd(&(bar)[XB_TMO], 1u); break; } } } } while (0)

struct XcdBarrier {
    unsigned* bar; unsigned x;
    volatile LAS unsigned* st;
};

__device__ __forceinline__ XcdBarrier xcd_barrier_post(unsigned* bar, volatile LAS unsigned* st) {
    XcdBarrier b; b.bar = bar; b.x = xb_xcc_id(); b.st = st;
    if (threadIdx.x == 0) (void)xb_add(&bar[XB_XCNT(b.x)], 1u);
    return b;
}
__device__ __forceinline__ void xcd_barrier_complete(unsigned* bar, unsigned x, unsigned& nloc, unsigned& nx) {
    const unsigned G = gridDim.x * gridDim.y * gridDim.z;
    unsigned sum, cnt, mine, sp = 0u;
    for (;;) {
        sum = 0u; cnt = 0u; mine = 0u;
#pragma unroll
        for (unsigned j = 0; j < 16; ++j) { const unsigned c = xb_ld(&bar[XB_XCNT(j)]); sum += c; cnt += (c > 0u) ? 1u : 0u; mine = (j == x) ? c : mine; }
        if (sum == G) break;
        __builtin_amdgcn_s_sleep(1);
        if ((++sp & 255u) == 0u) { if (xb_ld(&bar[XB_TMO])) break; if (sp > XB_SPIN_CAP) { atomicAdd(&bar[XB_TMO], 1u); break; } }
    }
    nloc = mine > 0u ? mine : 1u; nx = cnt > 0u ? cnt : 1u;
}

__device__ __forceinline__ void xcd_barrier(const XcdBarrier& b) {
    asm volatile("s_waitcnt vmcnt(0)" ::: "memory");
    __syncthreads();
    if (threadIdx.x == 0) {
        unsigned* bar = b.bar;
        __builtin_amdgcn_s_waitcnt(0);
        unsigned nloc = b.st[0], nx = b.st[1];
        if (nloc == 0u) { xcd_barrier_complete(bar, b.x, nloc, nx); b.st[0] = nloc; b.st[1] = nx; }
        const unsigned old = xb_add(&bar[XB_XSUB(b.x)], 1u);
        const unsigned gen = old / nloc;
        if (old + 1u == (gen + 1u) * nloc) {
            __builtin_amdgcn_fence(__ATOMIC_RELEASE, "agent");
            asm volatile("s_waitcnt vmcnt(0)" ::: "memory");
            const unsigned og = xb_add(&bar[XB_TOP], 1u);
            const unsigned tg = og / nx;
            if (og + 1u == (tg + 1u) * nx) xb_add(&bar[XB_TOPGEN], 1u);
            else XB_SPIN(xb_ld(&bar[XB_TOPGEN]) == tg, bar);
            __builtin_amdgcn_fence(__ATOMIC_ACQUIRE, "agent");
            xb_add(&bar[XB_XGEN(b.x)], 1u);
            asm volatile("s_waitcnt vmcnt(0)" ::: "memory");
        } else {
            XB_SPIN(xb_ld(&bar[XB_XGEN(b.x)]) == gen, bar);
            __builtin_amdgcn_fence(__ATOMIC_ACQUIRE, "agent");
            asm volatile("s_waitcnt vmcnt(0)" ::: "memory");
        }
    }
    __syncthreads();
}

typedef float f32x16 __attribute__((ext_vector_type(16)));
typedef unsigned u32x2 __attribute__((ext_vector_type(2)));
typedef unsigned u32x4 __attribute__((ext_vector_type(4)));
struct Frame {
    LAS unsigned char* lds; volatile LAS unsigned* MISC; gu32* ctl;
    int tid, lane, wave, vcu, G;
};
__device__ __forceinline__ float bf2f(bf16 b) { return __uint_as_float((unsigned)b << 16); }
__device__ __forceinline__ float bflo(unsigned w) { return __uint_as_float(w << 16); }
__device__ __forceinline__ float bfhi(unsigned w) { return __uint_as_float(w & 0xffff0000u); }
template <int CTRL, int RMASK> __device__ __forceinline__ float dppadd(float x) {
    const int m = __builtin_amdgcn_update_dpp(0, __builtin_bit_cast(int, x), CTRL, RMASK, 0xF, false);
    return x + __builtin_bit_cast(float, m);
}
__device__ __forceinline__ float dpp_sum63(float x) {
    x = dppadd<0xB1, 0xF>(x); x = dppadd<0x4E, 0xF>(x); x = dppadd<0x141, 0xF>(x); x = dppadd<0x140, 0xF>(x);
    x = dppadd<0x142, 0xA>(x); x = dppadd<0x143, 0xC>(x); return x;
}
__device__ __forceinline__ float rdlane(float x, int l) { return __builtin_bit_cast(float, __builtin_amdgcn_readlane(__builtin_bit_cast(int, x), l)); }
__device__ __forceinline__ float wave_allsum(float x) { return rdlane(dpp_sum63(x), 63); }
__device__ __forceinline__ float row16_allsum(float x) { x = dppadd<0xB1, 0xF>(x); x = dppadd<0x4E, 0xF>(x); x = dppadd<0x141, 0xF>(x); x = dppadd<0x140, 0xF>(x); return x; }

__device__ __forceinline__ void p0_transpose_tile(const float* W, int ldw, int k0, int sn0, bf16* WT, int K, int dn0, LAS float* scr, int lane) {
#pragma unroll 8
    for (int i = 0; i < 32; ++i) { const int kk = 2 * i + (lane >> 5); scr[kk * 33 + (lane & 31)] = sn0 >= 0 ? W[(size_t)(k0 + kk) * ldw + sn0 + (lane & 31)] : 0.f; }
    LDS_WAIT(); asm volatile("" ::: "memory");
    const int c = lane & 7;
#pragma unroll
    for (int j = 0; j < 4; ++j) { const int n = (lane >> 3) + 8 * j; const LAS float* s = scr + (8 * c) * 33 + n;
        v4u o; o.x = pk2(s[0 * 33], s[1 * 33]); o.y = pk2(s[2 * 33], s[3 * 33]); o.z = pk2(s[4 * 33], s[5 * 33]); o.w = pk2(s[6 * 33], s[7 * 33]);
        *(GAS v4u*)(WT + (size_t)(dn0 + n) * K + k0 + 8 * c) = o; }
    LDS_WAIT(); asm volatile("" ::: "memory");
}
__device__ __forceinline__ int w1_src_col(int n) {
    if (n < 3072) return n;
    if (n < 4096) return 3200 + (n - 3072);
    if (n < 5120) return 4224 + (n - 4096);
    if (n < 6144) return 5248 + (n - 5120);
    if (n < 7168) return 7296 + (n - 6144);
    if (n < 7296) return 3072 + (n - 7168);
    if (n < 7424) return -1;
    return 6272 + (n - 7424);
}
struct In { const float *x, *p, *g_pre, *w_in, *mu, *w0, *w_up, *a0, *a_up, *k_k, *k_a, *r_k, *lnx_w, *lnx_b, *w_out, *g_post, *w_ple, *w_plg, *g_ple; };

__device__ __forceinline__ void p0_prologue(Frame& F, const In& I, unsigned char* ws) {
    LAS float* scr = (LAS float*)(F.lds + RING_OFF + F.wave * 16384);
    const int gw = F.vcu * NWAVES + F.wave, NGW = F.G * NWAVES, lane = F.lane;
    bf16* Z = (bf16*)(ws + WS_Z); bf16* W1T = Z + (size_t)64 * 256 * DM;
    constexpr int I_1 = 264 * 32, I_2 = 64 * 32, I_3 = 64 * 32, I_P = 64 * 4;
    constexpr int NITEMS = I_1 + I_2 + I_3 + I_P;
    for (int it = gw; it < NITEMS; it += NGW) {
        int r = it;
        if (r < I_1) { const int nb = r % 264, kb = r / 264; p0_transpose_tile(I.w_in, INW, kb * 64, w1_src_col(nb * 32), W1T, DM, nb * 32, scr, lane); continue; } r -= I_1;
        if (r < I_2) { const int nb = r % 64, kb = r / 64; p0_transpose_tile(I.w_out, DM, kb * 64, nb * 32, (bf16*)(ws + WS_W2T), DM, nb * 32, scr, lane); continue; } r -= I_2;
        if (r < I_3) { const int nb = r % 64, kb = r / 64; p0_transpose_tile(I.w_plg, DM, kb * 64, nb * 32, (bf16*)(ws + WS_W3T), DM, nb * 32, scr, lane); continue; } r -= I_3;
        { const int nb = r % 64, kb = r / 64; p0_transpose_tile(I.w_ple, DM, kb * 64, nb * 32, (bf16*)(ws + WS_WPT), PLE_DIM, nb * 32, scr, lane); }
    }
    for (int m = gw; m < M; m += NGW) {
        const GAS f32x4* xr = (const GAS f32x4*)(I.x + (size_t)m * DM) + lane; const GAS f32x4* gr = (const GAS f32x4*)I.g_pre + lane;
        f32x4 v[8]; float s = 0.f;
#pragma unroll
        for (int j = 0; j < 8; ++j) { v[j] = xr[64 * j]; s += (v[j].x * v[j].x + v[j].y * v[j].y) + (v[j].z * v[j].z + v[j].w * v[j].w); }
        const float rinv = 1.0f / sqrtf(wave_allsum(s) * (1.0f / DM) + RMS_EPS);
        GAS u32x2* o8 = (GAS u32x2*)(Z + (size_t)m * DM) + lane;
#pragma unroll
        for (int j = 0; j < 8; ++j) { const f32x4 g = gr[64 * j]; u32x2 o; o.x = pk2(v[j].x * rinv * g.x, v[j].y * rinv * g.y); o.y = pk2(v[j].z * rinv * g.z, v[j].w * rinv * g.w); o8[64 * j] = o; }
    }
    { const GAS f32x4* pr = (const GAS f32x4*)I.p; GAS u32x2* po = (GAS u32x2*)(ws + WS_PB); const int n4 = M * PLE_DIM / 4;
      for (int i = gw * 64 + lane; i < n4; i += NGW * 64) { const f32x4 v = pr[i]; u32x2 o; o.x = pk2(v.x, v.y); o.y = pk2(v.z, v.w); po[i] = o; } }
}

__device__ __forceinline__ int crow(int r, int hi) { return (r & 3) + 8 * (r >> 2) + 4 * hi; }
template <bool DIAG> __device__ __forceinline__ void attn_block(const bf16x8 (&kf)[4], const u32x2 (&va)[2][2][2], const bf16x8 (&qf)[4], f32x16& o0, f32x16& o1, float& R, int r32, int hi) {
    f32x16 p = {};
#pragma unroll
    for (int d0 = 0; d0 < 4; ++d0) p = __builtin_amdgcn_mfma_f32_32x32x16_bf16(kf[d0], qf[d0], p, 0, 0, 0);
    float l1[16], lb[16];
#pragma unroll
    for (int r = 0; r < 16; ++r) { const float z = p[r]; const float sp = fmaxf(z, 0.f) + __builtin_amdgcn_logf(1.0f + __builtin_amdgcn_exp2f(-fabsf(z)));
        if (DIAG) { const bool valid = crow(r, hi) < r32; l1[r] = valid ? -sp : 0.f; lb[r] = valid ? (z - sp) : -INFINITY; } else { l1[r] = -sp; lb[r] = z - sp; } }
    float oth[4], tot[4];
#pragma unroll
    for (int g = 0; g < 4; ++g) { const float mine = (l1[4 * g] + l1[4 * g + 1]) + (l1[4 * g + 2] + l1[4 * g + 3]);
        auto rr = __builtin_amdgcn_permlane32_swap(__float_as_uint(mine), __float_as_uint(mine), false, false);
        const float lo = __uint_as_float(rr[0]), up = __uint_as_float(rr[1]); oth[g] = hi ? lo : up; tot[g] = lo + up; }
    float T[4]; T[3] = 0.f; T[2] = tot[3]; T[1] = T[2] + tot[2]; T[0] = T[1] + tot[1];
    float w[16];
#pragma unroll
    for (int g = 0; g < 4; ++g) { float e = T[g] + (hi ? 0.f : oth[g]) + R;
        w[4 * g + 3] = __builtin_amdgcn_exp2f(lb[4 * g + 3] + e); e += l1[4 * g + 3];
        w[4 * g + 2] = __builtin_amdgcn_exp2f(lb[4 * g + 2] + e); e += l1[4 * g + 2];
        w[4 * g + 1] = __builtin_amdgcn_exp2f(lb[4 * g + 1] + e); e += l1[4 * g + 1];
        w[4 * g + 0] = __builtin_amdgcn_exp2f(lb[4 * g + 0] + e); }
    R += T[0] + tot[0];
    u32x4 pb0, pb1;
    pb0.x = pk2(w[0], w[1]); pb0.y = pk2(w[2], w[3]); pb0.z = pk2(w[4], w[5]); pb0.w = pk2(w[6], w[7]);
    pb1.x = pk2(w[8], w[9]); pb1.y = pk2(w[10], w[11]); pb1.z = pk2(w[12], w[13]); pb1.w = pk2(w[14], w[15]);
    const bf16x8 pB0 = __builtin_bit_cast(bf16x8, pb0), pB1 = __builtin_bit_cast(bf16x8, pb1);
#define VA(dt, s) __builtin_bit_cast(bf16x8, (u32x4){va[dt][s][0].x, va[dt][s][0].y, va[dt][s][1].x, va[dt][s][1].y})
    o0 = __builtin_amdgcn_mfma_f32_32x32x16_bf16(VA(0, 0), pB0, o0, 0, 0, 0); o0 = __builtin_amdgcn_mfma_f32_32x32x16_bf16(VA(0, 1), pB1, o0, 0, 0, 0);
    o1 = __builtin_amdgcn_mfma_f32_32x32x16_bf16(VA(1, 0), pB0, o1, 0, 0, 0); o1 = __builtin_amdgcn_mfma_f32_32x32x16_bf16(VA(1, 1), pB1, o1, 0, 0, 0);
#undef VA
}
__device__ __forceinline__ void attn_tile(const bf16* Q, const bf16* KS, const bf16* VT, const bf16* GS, bf16* MIX, int b, int h, int qt, int lane) {
    const int r32 = lane & 31, hi = lane >> 5, t0 = qt * 32; const size_t rowb = (size_t)b * SEQ;
    bf16x8 qf[4];
    const size_t bh = (size_t)b * 16 + h;
    { const bf16* qp = Q + (bh * 8192 + t0 + r32) * 64 + hi * 8;
#pragma unroll
      for (int d0 = 0; d0 < 4; ++d0) qf[d0] = *(const GAS bf16x8*)(qp + d0 * 16); }
    f32x16 o0 = {}, o1 = {}; float R = 0.f;
    const bf16* vt0 = VT + (bh * 256 * 64 + r32) * 32 + 4 * hi;
    const bf16* kp0 = KS + (bh * 8192 + r32) * 64 + hi * 8;
    bf16x8 kf[4], kfn[4]; u32x2 va[2][2][2], van[2][2][2];
#define ATT_LOAD(KF, VA_, s0_) do { _Pragma("unroll") for (int d0 = 0; d0 < 4; ++d0) KF[d0] = *(const GAS bf16x8*)(kp0 + (size_t)(s0_) * 64 + d0 * 16); \
        _Pragma("unroll") for (int dt = 0; dt < 2; ++dt) _Pragma("unroll") for (int s = 0; s < 2; ++s) _Pragma("unroll") for (int hf = 0; hf < 2; ++hf) VA_[dt][s][hf] = *(const GAS u32x2*)(vt0 + (size_t)(s0_) * 64 + dt * 1024 + 16 * s + 8 * hf); } while (0)
#define ATT_ROT() do { _Pragma("unroll") for (int d0 = 0; d0 < 4; ++d0) kf[d0] = kfn[d0]; _Pragma("unroll") for (int dt = 0; dt < 2; ++dt) _Pragma("unroll") for (int s = 0; s < 2; ++s) _Pragma("unroll") for (int hf = 0; hf < 2; ++hf) va[dt][s][hf] = van[dt][s][hf]; } while (0)
    ATT_LOAD(kf, va, qt * 32);
    if (qt > 0) ATT_LOAD(kfn, van, (qt - 1) * 32);
    attn_block<true>(kf, va, qf, o0, o1, R, r32, hi);
    for (int kb = qt - 1; kb >= 0; --kb) {
        ATT_ROT();
        if (kb > 0) ATT_LOAD(kfn, van, (kb - 1) * 32);
        attn_block<false>(kf, va, qf, o0, o1, R, r32, hi);
        if (__all(R < SB_CUT)) break;
    }
#undef ATT_LOAD
#undef ATT_ROT
    const size_t row = rowb + t0 + r32;
#pragma unroll
    for (int dt = 0; dt < 2; ++dt)
#pragma unroll
        for (int g = 0; g < 4; ++g) { const int d = dt * 32 + 8 * g + 4 * hi; const u32x2 gw = *(const GAS u32x2*)(GS + (bh * 8192 + t0 + r32) * 64 + d);
            float gv[4] = {bflo(gw.x), bfhi(gw.x), bflo(gw.y), bfhi(gw.y)}; float ov[4];
#pragma unroll
            for (int e = 0; e < 4; ++e) { const float o = dt ? o1[4 * g + e] : o0[4 * g + e]; ov[e] = o * gv[e] * __builtin_amdgcn_rcpf(1.0f + __builtin_amdgcn_exp2f(-1.4426950408889634f * gv[e])); }
            u32x2 st; st.x = pk2(ov[0], ov[1]); st.y = pk2(ov[2], ov[3]); *(GAS u32x2*)(MIX + row * 2048 + 1024 + h * 64 + d) = st; }
}
__device__ __forceinline__ void p2_attention(Frame& F, unsigned char* ws, int wg0) {
    const bf16 *Q = (const bf16*)(ws + WS_Q), *KS = (const bf16*)(ws + WS_KS), *VT = (const bf16*)(ws + WS_VT), *GS = (const bf16*)(ws + WS_GS); bf16* MIX = (bf16*)(ws + WS_MIX);
    if ((int)blockIdx.x < wg0) return;
    const int gw = ((int)blockIdx.x - wg0) * NWAVES + F.wave, NGW = (F.G - wg0) * NWAVES;
    for (int u = gw; u < BATCH * NH * (SEQ / 32); u += NGW) { const int qt = u & 255, bh = u >> 8; attn_tile(Q, KS, VT, GS, MIX, bh >> 4, bh & 15, qt, F.lane); }
}

constexpr int PT = 72, MATB = 64 * PT * 2;
constexpr int LB_KQ = 0, LB_RQ = 1, LB_BK = 2, LB_KK = 3, LB_BD = 4, LB_KD = 5, LB_V = 6, LB_LA = 7, LB_AUK = 8, LB_ARB = 9, LB_ARK = 10, LB_PA = 11;
constexpr int LB_LB = LB_BK, LB_PB = LB_KK;
constexpr int LB_X1 = 12;
constexpr int L_G = 13 * MATB, L_SEG = L_G + 64 * 64 * 4, L_CT = L_SEG + 8 * 64 * 4;
static_assert(L_CT + 640 * 4 <= LDSCTL_OFF, "chunk LDS map");
#define PBAR() do { asm volatile("s_waitcnt lgkmcnt(0)" ::: "memory"); __builtin_amdgcn_s_barrier(); asm volatile("" ::: "memory"); } while (0)
constexpr size_t WS_NCT = WS_Z, WS_MCT = WS_Z + 32 * MiB, WS_QC = WS_Z + 64 * MiB, WS_YLOC = 451 * MiB, WS_BON = 483 * MiB, WS_SC = WS_R;
typedef short v4i16_t __attribute__((ext_vector_type(4)));
__device__ __forceinline__ bf16x8 ldA(const LAS unsigned char* X, int m0, int ks, int lane) { return *(const LAS bf16x8*)(X + ((m0 + (lane & 15)) * PT + 32 * ks + 8 * (lane >> 4)) * 2); }
__device__ __forceinline__ bf16x8 ldTr(const LAS unsigned char* X, int c0, int ks, int lane) {
    const int g = lane >> 4, i = lane & 15, q = i >> 2, p = i & 3;
    const LAS unsigned char* a = X + ((32 * ks + 8 * g + q) * PT + c0 + 4 * p) * 2;
    const v4i16_t lo = __builtin_amdgcn_ds_read_tr16_b64_v4i16((LAS v4i16_t*)a), hi = __builtin_amdgcn_ds_read_tr16_b64_v4i16((LAS v4i16_t*)(a + 4 * PT * 2));
    return (bf16x8){lo[0], lo[1], lo[2], lo[3], hi[0], hi[1], hi[2], hi[3]};
}
__device__ __forceinline__ void stRM(LAS unsigned char* X, int m0, int n0, const f32x4& acc, int lane) {
    const int n = lane & 15, q = lane >> 4;
    const unsigned w01 = pk2(acc[0], acc[1]), w23 = pk2(acc[2], acc[3]); LAS unsigned char* p = X + ((m0 + 4 * q) * PT + n0 + n) * 2;
    *(LAS unsigned short*)(p) = (unsigned short)w01; *(LAS unsigned short*)(p + PT * 2) = (unsigned short)(w01 >> 16); *(LAS unsigned short*)(p + 2 * PT * 2) = (unsigned short)w23; *(LAS unsigned short*)(p + 3 * PT * 2) = (unsigned short)(w23 >> 16);
}
#define MMA16(a, b, c) __builtin_amdgcn_mfma_f32_16x16x32_bf16(a, b, c, 0, 0, 0)
struct PreRegs { v4u rc, rp, kc, kp, vc, vp, lc0, lc1, lp0, lp1; f32x4 wu0, wu1, au0, au1; };

__device__ __forceinline__ void p3a_prepass(Frame& F, const In& I, unsigned char* ws) {
    const int tid = F.tid, lane = F.lane, wave = F.wave;
    LAS unsigned char* L = F.lds + RING_OFF;
#define LBUF(i) (L + (i) * MATB)
    const bf16 *Rb = (const bf16*)(ws + WS_R), *Kb = (const bf16*)(ws + WS_K), *Vb = (const bf16*)(ws + WS_V), *LORA = (const bf16*)(ws + WS_LORA);
    bf16* NCT = (bf16*)(ws + WS_NCT); bf16* MCT = (bf16*)(ws + WS_MCT); bf16* QC = (bf16*)(ws + WS_QC); bf16* YLOC = (bf16*)(ws + WS_YLOC); float* BON = (float*)(ws + WS_BON);
    const int st = tid >> 3, k8 = (tid & 7) * 8;
    const int m0 = (wave & 3) * 16, nb = (wave >> 2) * 32;
    const int tn = lane & 15, tq = lane >> 4;
    auto LOAD = [&](int unit, PreRegs& g) {
        const int bh = unit >> 7, c = unit & 127, b = bh >> 4, h = bh & 15; const int t = c * 64 + st; const size_t row = (size_t)b * SEQ + t; const size_t o = row * 1024 + h * 64 + k8;
        g.rc = *(const GAS v4u*)(Rb + o); g.kc = *(const GAS v4u*)(Kb + o); g.vc = *(const GAS v4u*)(Vb + o);
        const size_t lo = row * 256 + 2 * k8;
        g.lc0 = *(const GAS v4u*)(LORA + lo); g.lc1 = *(const GAS v4u*)(LORA + lo + 8);
        if (t > 0) { g.rp = *(const GAS v4u*)(Rb + o - 1024); g.kp = *(const GAS v4u*)(Kb + o - 1024); g.vp = *(const GAS v4u*)(Vb + o - 1024); g.lp0 = *(const GAS v4u*)(LORA + lo - 256); g.lp1 = *(const GAS v4u*)(LORA + lo - 256 + 8); }
        else { g.rp = (v4u){0u, 0u, 0u, 0u}; g.kp = g.rp; g.vp = g.rp; g.lp0 = g.rp; g.lp1 = g.rp; }
        const size_t wo = (size_t)st * 1024 + h * 64 + k8;
        g.wu0 = *(const GAS f32x4*)(I.w_up + wo); g.wu1 = *(const GAS f32x4*)(I.w_up + wo + 4); g.au0 = *(const GAS f32x4*)(I.a_up + wo); g.au1 = *(const GAS f32x4*)(I.a_up + wo + 4);
    };
    PreRegs g;
    const int per = 4096 / F.G;
    const int nmine = per + ((4096 - per * F.G) > F.vcu ? 1 : 0);
    auto UNIT = [&](int ui) { return ui < per ? F.vcu * per + ui : per * F.G + F.vcu; };
    if (nmine > 0) LOAD(UNIT(0), g);
    const LAS float* CT = (const LAS float*)(L + L_CT); int cur_h = -1;
    for (int ui = 0; ui < nmine; ++ui) {
        const int unit = UNIT(ui);
        const int bh = unit >> 7, c = unit & 127, b = bh >> 4, h = bh & 15; const size_t row0 = (size_t)b * SEQ + c * 64; const int ch0 = h * 64;
        if (h != cur_h) { cur_h = h; LAS float* ctw = (LAS float*)(L + L_CT);
            for (int e = tid; e < 640; e += NWAVES * 64) { float v;
                if (e < 384) { const int a_ = e >> 6, cc = ch0 + (e & 63); v = a_ == 0 ? I.mu[cc] : a_ == 1 ? I.mu[1024 + cc] : a_ == 2 ? I.mu[2048 + cc] : a_ == 3 ? I.k_k[cc] : a_ == 4 ? I.k_a[cc] : I.r_k[cc]; }
                else if (e < 512) v = I.mu[3072 + (e - 384)]; else if (e < 576) v = I.w0[ch0 + (e - 512)]; else v = I.a0[ch0 + (e - 576)];
                ctw[e] = v; }
            PBAR(); }
        { const unsigned lcw[8] = {g.lc0.x, g.lc0.y, g.lc0.z, g.lc0.w, g.lc1.x, g.lc1.y, g.lc1.z, g.lc1.w}, lpw[8] = {g.lp0.x, g.lp0.y, g.lp0.z, g.lp0.w, g.lp1.x, g.lp1.y, g.lp1.z, g.lp1.w};
          const int j0 = 2 * k8; const bool isw = j0 < 64; float lv[16];
#pragma unroll
          for (int e = 0; e < 16; ++e) { const float cur = (e & 1) ? bfhi(lcw[e >> 1]) : bflo(lcw[e >> 1]), prev = (e & 1) ? bfhi(lpw[e >> 1]) : bflo(lpw[e >> 1]);
              const float sv = cur + (prev - cur) * CT[384 + j0 + e]; const float e2 = __expf(2.0f * sv); lv[e] = isw ? (1.0f - 2.0f * __builtin_amdgcn_rcpf(e2 + 1.0f)) : sv; }
          v4u w0_, w1_; w0_.x = pk2(lv[0], lv[1]); w0_.y = pk2(lv[2], lv[3]); w0_.z = pk2(lv[4], lv[5]); w0_.w = pk2(lv[6], lv[7]); w1_.x = pk2(lv[8], lv[9]); w1_.y = pk2(lv[10], lv[11]); w1_.z = pk2(lv[12], lv[13]); w1_.w = pk2(lv[14], lv[15]);
          LAS unsigned char* dst = isw ? LBUF(LB_LA) : LBUF(LB_AUK); const int jc = isw ? j0 : j0 - 64;
          *(LAS v4u*)(dst + (st * PT + jc) * 2) = w0_; *(LAS v4u*)(dst + (st * PT + jc + 8) * 2) = w1_;
          v4u u_; u_.x = pk2(g.wu0.x, g.wu0.y); u_.y = pk2(g.wu0.z, g.wu0.w); u_.z = pk2(g.wu1.x, g.wu1.y); u_.w = pk2(g.wu1.z, g.wu1.w); *(LAS v4u*)(LBUF(LB_ARB) + (st * PT + k8) * 2) = u_;
          u_.x = pk2(g.au0.x, g.au0.y); u_.y = pk2(g.au0.z, g.au0.w); u_.z = pk2(g.au1.x, g.au1.y); u_.w = pk2(g.au1.z, g.au1.w); *(LAS v4u*)(LBUF(LB_ARK) + (st * PT + k8) * 2) = u_; }
        PBAR();
#pragma unroll
        for (int ti = 0; ti < 2; ++ti) { const int n0 = nb + 16 * ti; f32x4 xw = {0.f, 0.f, 0.f, 0.f}, xa = xw;
#pragma unroll
            for (int ks = 0; ks < 2; ++ks) { xw = MMA16(ldA(LBUF(LB_LA), m0, ks, lane), ldTr(LBUF(LB_ARB), n0, ks, lane), xw); xa = MMA16(ldA(LBUF(LB_AUK), m0, ks, lane), ldTr(LBUF(LB_ARK), n0, ks, lane), xa); }
            const float w0c = CT[512 + n0 + tn], a0c = CT[576 + n0 + tn]; f32x4 av;
#pragma unroll
            for (int r = 0; r < 4; ++r) { *(LAS float*)(L + L_G + ((m0 + 4 * tq + r) * 64 + n0 + tn) * 4) = -0.60653065971263342f * __builtin_amdgcn_rcpf(1.0f + __expf(-(xw[r] + w0c))); av[r] = __builtin_amdgcn_rcpf(1.0f + __expf(-(xa[r] + a0c))); }
            stRM(LBUF(LB_PA), m0, n0, av, lane); }
        PBAR();
        float rs[8], kt[8], kk[8], bb[8], vs[8], lw[8];
        { const unsigned rcw[4] = {g.rc.x, g.rc.y, g.rc.z, g.rc.w}, rpw[4] = {g.rp.x, g.rp.y, g.rp.z, g.rp.w}, kcw[4] = {g.kc.x, g.kc.y, g.kc.z, g.kc.w}, kpw[4] = {g.kp.x, g.kp.y, g.kp.z, g.kp.w};
          const unsigned vcw[4] = {g.vc.x, g.vc.y, g.vc.z, g.vc.w}, vpw[4] = {g.vp.x, g.vp.y, g.vp.z, g.vp.w};
          const v4u aw = *(const LAS v4u*)(LBUF(LB_PA) + (st * PT + k8) * 2); const unsigned acw[4] = {aw.x, aw.y, aw.z, aw.w};
          const f32x4 l0 = *(const LAS f32x4*)(L + L_G + (st * 64 + k8) * 4), l1 = *(const LAS f32x4*)(L + L_G + (st * 64 + k8 + 4) * 4);
          float ss = 0.f, bon = 0.f; float av[8], ks[8];
#pragma unroll
          for (int e = 0; e < 8; ++e) { const int cch = k8 + e; const int w2 = e >> 1; const bool hi = e & 1;
              const float rc = hi ? bfhi(rcw[w2]) : bflo(rcw[w2]), rp = hi ? bfhi(rpw[w2]) : bflo(rpw[w2]), kc = hi ? bfhi(kcw[w2]) : bflo(kcw[w2]), kp = hi ? bfhi(kpw[w2]) : bflo(kpw[w2]);
              const float vc = hi ? bfhi(vcw[w2]) : bflo(vcw[w2]), vp = hi ? bfhi(vpw[w2]) : bflo(vpw[w2]); av[e] = hi ? bfhi(acw[w2]) : bflo(acw[w2]);
              rs[e] = rc + (rp - rc) * CT[cch]; ks[e] = kc + (kp - kc) * CT[64 + cch]; vs[e] = vc + (vp - vc) * CT[128 + cch];
              kk[e] = ks[e] * CT[192 + cch]; ss += kk[e] * kk[e]; kt[e] = ks[e] * (1.0f + (av[e] - 1.0f) * CT[256 + cch]); bon += rs[e] * kt[e] * CT[320 + cch]; }
          ss = dppadd<0xB1, 0xF>(ss); ss = dppadd<0x4E, 0xF>(ss); ss = dppadd<0x141, 0xF>(ss);
          bon = dppadd<0xB1, 0xF>(bon); bon = dppadd<0x4E, 0xF>(bon); bon = dppadd<0x141, 0xF>(bon);
          const float inv = 1.0f / sqrtf(ss + L2_EPS);
#pragma unroll
          for (int e = 0; e < 8; ++e) { kk[e] *= inv; bb[e] = av[e] * kk[e]; }
          lw[0] = l0.x; lw[1] = l0.y; lw[2] = l0.z; lw[3] = l0.w; lw[4] = l1.x; lw[5] = l1.y; lw[6] = l1.z; lw[7] = l1.w;
          if ((tid & 7) == 0) BON[(row0 + st) * 16 + h] = bon; }
        if (ui + 1 < nmine) LOAD(UNIT(ui + 1), g);
        PBAR();
        { const int k = tid & 63, sg = tid >> 6; LAS float* Gp = (LAS float*)(L + L_G); LAS float* Sg = (LAS float*)(L + L_SEG);
          float v8[8]; float run = 0.f;
#pragma unroll
          for (int i = 0; i < 8; ++i) { run += Gp[(sg * 8 + i) * 64 + k]; v8[i] = run; }
          Sg[sg * 64 + k] = run;
          PBAR();
          float pre = 0.f;
#pragma unroll
          for (int s2 = 0; s2 < 7; ++s2) pre += (s2 < sg) ? Sg[s2 * 64 + k] : 0.f;
#pragma unroll
          for (int i = 0; i < 8; ++i) Gp[(sg * 8 + i) * 64 + k] = v8[i] + pre; }
        PBAR();
        { const LAS float* Gp = (const LAS float*)(L + L_G); float gg[8], gc[8];
          { const f32x4 a0 = *(const LAS f32x4*)(Gp + st * 64 + k8), a1 = *(const LAS f32x4*)(Gp + st * 64 + k8 + 4), c0 = *(const LAS f32x4*)(Gp + 63 * 64 + k8), c1 = *(const LAS f32x4*)(Gp + 63 * 64 + k8 + 4);
            gg[0] = a0.x; gg[1] = a0.y; gg[2] = a0.z; gg[3] = a0.w; gg[4] = a1.x; gg[5] = a1.y; gg[6] = a1.z; gg[7] = a1.w; gc[0] = c0.x; gc[1] = c0.y; gc[2] = c0.z; gc[3] = c0.w; gc[4] = c1.x; gc[5] = c1.y; gc[6] = c1.z; gc[7] = c1.w; }
          float o[7][8];
#pragma unroll
          for (int e = 0; e < 8; ++e) { const float eg = __expf(gg[e]), egm = __expf(gg[e] - lw[e]), ei = __expf(-gg[e]), ed = __expf(gc[e] - gg[e]);
              o[LB_KQ][e] = kk[e] * egm; o[LB_RQ][e] = rs[e] * eg; o[LB_BK][e] = bb[e] * ei; o[LB_KK][e] = kt[e] * ei; o[LB_BD][e] = bb[e] * ed; o[LB_KD][e] = kt[e] * ed; o[LB_V][e] = vs[e]; }
#pragma unroll
          for (int mtx = 0; mtx < 7; ++mtx) { v4u w; w.x = pk2(o[mtx][0], o[mtx][1]); w.y = pk2(o[mtx][2], o[mtx][3]); w.z = pk2(o[mtx][4], o[mtx][5]); w.w = pk2(o[mtx][6], o[mtx][7]);
              *(LAS v4u*)(LBUF(mtx) + (st * PT + k8) * 2) = w; } }
        PBAR();
        f32x4 Pacc[2];
#pragma unroll
        for (int ti = 0; ti < 2; ++ti) { const int n0 = nb + 16 * ti; f32x4 ub = {0.f, 0.f, 0.f, 0.f}, uk = ub, rb = ub, rk = ub;
#pragma unroll
            for (int ks = 0; ks < 2; ++ks) { const bf16x8 aq = ldA(LBUF(LB_KQ), m0, ks, lane), ar = ldA(LBUF(LB_RQ), m0, ks, lane), b1 = ldA(LBUF(LB_BK), n0, ks, lane), b2 = ldA(LBUF(LB_KK), n0, ks, lane);
                ub = MMA16(aq, b1, ub); uk = MMA16(aq, b2, uk); rb = MMA16(ar, b1, rb); rk = MMA16(ar, b2, rk); }
#pragma unroll
            for (int r = 0; r < 4; ++r) { const int t = m0 + 4 * tq + r, j = n0 + tn; if (!(j < t)) { ub[r] = 0.f; uk[r] = 0.f; } if (!(j <= t)) { rb[r] = 0.f; rk[r] = 0.f; } Pacc[ti][r] = (t == j ? 1.0f : 0.0f) - ub[r]; }
            stRM(LBUF(LB_LA), m0, n0, ub, lane); stRM(LBUF(LB_AUK), m0, n0, uk, lane); stRM(LBUF(LB_ARB), m0, n0, rb, lane); stRM(LBUF(LB_ARK), m0, n0, rk, lane); stRM(LBUF(LB_PA), m0, n0, Pacc[ti], lane); }
        PBAR();
#define SQR(dst, src) do { _Pragma("unroll") for (int ti = 0; ti < 2; ++ti) { const int n0 = nb + 16 * ti; f32x4 a_ = {0.f, 0.f, 0.f, 0.f}; \
            _Pragma("unroll") for (int ks = 0; ks < 2; ++ks) a_ = MMA16(ldA(LBUF(src), m0, ks, lane), ldTr(LBUF(src), n0, ks, lane), a_); stRM(LBUF(dst), m0, n0, a_, lane); } } while (0)
#define PUPD(pdst, psrc, lsrc) do { _Pragma("unroll") for (int ti = 0; ti < 2; ++ti) { const int n0 = nb + 16 * ti; \
            _Pragma("unroll") for (int ks = 0; ks < 2; ++ks) Pacc[ti] = MMA16(ldA(LBUF(psrc), m0, ks, lane), ldTr(LBUF(lsrc), n0, ks, lane), Pacc[ti]); stRM(LBUF(pdst), m0, n0, Pacc[ti], lane); } } while (0)
        SQR(LB_LB, LB_LA);
#pragma unroll
        for (int ti = 0; ti < 2; ++ti) { const int n0 = nb + 16 * ti; f32x4 a_ = {0.f, 0.f, 0.f, 0.f};
#pragma unroll
            for (int ks = 0; ks < 2; ++ks) a_ = MMA16(ldA(LBUF(LB_AUK), m0, ks, lane), ldTr(LBUF(LB_V), n0, ks, lane), a_);
            stRM(LBUF(LB_X1), m0, n0, a_, lane); }
        PBAR();
        PUPD(LB_PB, LB_PA, LB_LB); SQR(LB_LA, LB_LB); PBAR();
        PUPD(LB_PA, LB_PB, LB_LA); SQR(LB_LB, LB_LA); PBAR();
        PUPD(LB_PB, LB_PA, LB_LB); SQR(LB_LA, LB_LB); PBAR();
        PUPD(LB_PA, LB_PB, LB_LA); SQR(LB_LB, LB_LA); PBAR();
        PUPD(LB_PB, LB_PA, LB_LB); PBAR();
#undef SQR
#undef PUPD
#pragma unroll
        for (int ti = 0; ti < 2; ++ti) { const int n0 = nb + 16 * ti; f32x4 u_ = {0.f, 0.f, 0.f, 0.f}, w_ = u_;
#pragma unroll
            for (int ks = 0; ks < 2; ++ks) { const bf16x8 at = ldA(LBUF(LB_PB), m0, ks, lane); u_ = MMA16(at, ldTr(LBUF(LB_X1), n0, ks, lane), u_); w_ = MMA16(at, ldTr(LBUF(LB_KQ), n0, ks, lane), w_); }
            u_ = -u_; stRM(LBUF(LB_PA), m0, n0, u_, lane); stRM(LBUF(LB_LB), m0, n0, w_, lane); }
        PBAR();
        const size_t ub16 = (size_t)unit * 4096;
#pragma unroll
        for (int ti = 0; ti < 2; ++ti) { const int n0 = nb + 16 * ti;
            f32x4 qa = {0.f, 0.f, 0.f, 0.f}, ya = qa, ma = qa, na = qa;
#pragma unroll
            for (int ks = 0; ks < 2; ++ks) { const bf16x8 wq = ldTr(LBUF(LB_LB), m0, ks, lane), arb = ldA(LBUF(LB_ARB), n0, ks, lane), u0 = ldTr(LBUF(LB_PA), m0, ks, lane), vv = ldTr(LBUF(LB_V), m0, ks, lane), ark = ldA(LBUF(LB_ARK), n0, ks, lane);
                qa = MMA16(wq, arb, qa); ya = MMA16(u0, arb, ya); ya = MMA16(vv, ark, ya);
                const bf16x8 bdn = ldTr(LBUF(LB_BD), n0, ks, lane), bdm = ldTr(LBUF(LB_BD), m0, ks, lane), kdm = ldTr(LBUF(LB_KD), m0, ks, lane), u0n = ldTr(LBUF(LB_PA), n0, ks, lane), vn = ldTr(LBUF(LB_V), n0, ks, lane);
                ma = MMA16(wq, bdn, ma); na = MMA16(bdm, u0n, na); na = MMA16(kdm, vn, na); }
            { const u32x2 rq = *(const LAS u32x2*)(LBUF(LB_RQ) + ((n0 + tn) * PT + m0 + 4 * tq) * 2);
              u32x2 qo; qo.x = pk2(bflo(rq.x) - qa[0], bfhi(rq.x) - qa[1]); qo.y = pk2(bflo(rq.y) - qa[2], bfhi(rq.y) - qa[3]);
              const size_t o = (row0 + n0 + tn) * 1024 + ch0 + m0 + 4 * tq;
              *(GAS u32x2*)(QC + o) = qo; u32x2 yo; yo.x = pk2(ya[0], ya[1]); yo.y = pk2(ya[2], ya[3]); *(GAS u32x2*)(YLOC + o) = yo; }
            { const LAS float* Gp = (const LAS float*)(L + L_G); float mv[4];
#pragma unroll
              for (int r = 0; r < 4; ++r) { const int k = m0 + 4 * tq + r, kp = n0 + tn; mv[r] = (k == kp ? __expf(Gp[63 * 64 + k]) : 0.f) - ma[r]; }
              u32x2 mo; mo.x = pk2(mv[0], mv[1]); mo.y = pk2(mv[2], mv[3]);
              *(GAS u32x2*)(MCT + ub16 + (size_t)(n0 + tn) * 64 + m0 + 8 * (tq & 1) + 4 * (tq >> 1)) = mo; }
            { u32x2 no; no.x = pk2(na[0], na[1]); no.y = pk2(na[2], na[3]); *(GAS u32x2*)(NCT + ub16 + (size_t)(n0 + tn) * 64 + m0 + 4 * tq) = no; } }
        PBAR();
    }
#undef LBUF
}

constexpr int ST_MROW = 144, ST_NROW = 136, ST_SLOT = 64 * ST_MROW + 32 * ST_NROW;
static_assert(7 * ST_SLOT <= LDSCTL_OFF, "state ring");
__device__ __forceinline__ void p3b_state(Frame& F, unsigned char* ws) {
    const int lane = F.lane, wave = F.wave;
    if (blockIdx.x >= 64) return;
    const int bh = blockIdx.x >> 1, vh = blockIdx.x & 1, r32 = lane & 31, hi = lane >> 5;
    const bf16* NCT = (const bf16*)(ws + WS_NCT); const bf16* MCT = (const bf16*)(ws + WS_MCT); bf16* SC = (bf16*)(ws + WS_SC);
    LAS unsigned char* L = F.lds + RING_OFF;
    v4u ld[12];
    auto GLOAD = [&](int c) {
        const size_t ub = (size_t)(bh * 128 + c) * 4096;
#pragma unroll
        for (int i = 0; i < 8; ++i) ld[i] = *(const GAS v4u*)(MCT + ub + (size_t)(i * 64 + lane) * 8);
#pragma unroll
        for (int i = 0; i < 4; ++i) ld[8 + i] = *(const GAS v4u*)(NCT + ub + (size_t)vh * 2048 + (size_t)(i * 64 + lane) * 8);
    };
    auto LWRITE = [&](int slot) {
        LAS unsigned char* sb = L + slot * ST_SLOT;
#pragma unroll
        for (int i = 0; i < 8; ++i) { const int p = i * 64 + lane; *(LAS v4u*)(sb + (p >> 3) * ST_MROW + (p & 7) * 16) = ld[i]; }
#pragma unroll
        for (int i = 0; i < 4; ++i) { const int p = i * 64 + lane; *(LAS v4u*)(sb + 64 * ST_MROW + (p >> 3) * ST_NROW + (p & 7) * 16) = ld[8 + i]; }
    };
    __syncthreads();
    if (wave > 0) {
        const int k = wave - 1;
        GLOAD(k); LWRITE(k);
        PBAR();
        for (int c = 0; c < 128; ++c) {
            const int ph = c % 7;
            if (ph == k && c + 7 < 128) GLOAD(c + 7);
            if (ph == (k + 4) % 7 && c >= 4 && c + 3 < 128) { asm volatile("s_waitcnt vmcnt(0)" ::: "memory"); LWRITE(k); }
            PBAR();
        }
        return;
    }
    f32x16 T0 = {}, T1 = {};
    PBAR();
    for (int c = 0; c < 128; ++c) {
        const LAS unsigned char* sb = L + (c % 7) * ST_SLOT;
        bf16x8 mf[2][2][2]; f32x16 a0, a1;
#pragma unroll
        for (int i = 0; i < 2; ++i)
#pragma unroll
            for (int j = 0; j < 2; ++j)
#pragma unroll
                for (int s2 = 0; s2 < 2; ++s2) mf[i][j][s2] = *(const LAS bf16x8*)(sb + (32 * i + r32) * ST_MROW + (16 * (2 * j + s2) + 8 * hi) * 2);
#pragma unroll
        for (int gq = 0; gq < 4; ++gq) { const LAS unsigned char* np_ = sb + 64 * ST_MROW + r32 * ST_NROW + (8 * gq + 4 * hi) * 2;
            const u32x2 x0 = *(const LAS u32x2*)np_, x1 = *(const LAS u32x2*)(np_ + 64);
            a0[4 * gq] = bflo(x0.x); a0[4 * gq + 1] = bfhi(x0.x); a0[4 * gq + 2] = bflo(x0.y); a0[4 * gq + 3] = bfhi(x0.y);
            a1[4 * gq] = bflo(x1.x); a1[4 * gq + 1] = bfhi(x1.x); a1[4 * gq + 2] = bflo(x1.y); a1[4 * gq + 3] = bfhi(x1.y); }
        u32x4 tb[2][2];
#pragma unroll
        for (int s2 = 0; s2 < 2; ++s2) { tb[0][s2].x = pk2(T0[8 * s2], T0[8 * s2 + 1]); tb[0][s2].y = pk2(T0[8 * s2 + 2], T0[8 * s2 + 3]); tb[0][s2].z = pk2(T0[8 * s2 + 4], T0[8 * s2 + 5]); tb[0][s2].w = pk2(T0[8 * s2 + 6], T0[8 * s2 + 7]);
            tb[1][s2].x = pk2(T1[8 * s2], T1[8 * s2 + 1]); tb[1][s2].y = pk2(T1[8 * s2 + 2], T1[8 * s2 + 3]); tb[1][s2].z = pk2(T1[8 * s2 + 4], T1[8 * s2 + 5]); tb[1][s2].w = pk2(T1[8 * s2 + 6], T1[8 * s2 + 7]); }
        { bf16* sp = SC + (size_t)(bh * 128 + c) * 4096 + (size_t)(vh * 32 + r32) * 64 + 4 * hi;
#pragma unroll
          for (int j = 0; j < 2; ++j)
#pragma unroll
              for (int s2 = 0; s2 < 2; ++s2) { *(GAS u32x2*)(sp + 32 * j + 16 * s2) = (u32x2){tb[j][s2].x, tb[j][s2].y}; *(GAS u32x2*)(sp + 32 * j + 16 * s2 + 8) = (u32x2){tb[j][s2].z, tb[j][s2].w}; } }
#pragma unroll
        for (int j = 0; j < 2; ++j)
#pragma unroll
            for (int s2 = 0; s2 < 2; ++s2) { const bf16x8 bfr = __builtin_bit_cast(bf16x8, tb[j][s2]);
                a0 = __builtin_amdgcn_mfma_f32_32x32x16_bf16(mf[0][j][s2], bfr, a0, 0, 0, 0); a1 = __builtin_amdgcn_mfma_f32_32x32x16_bf16(mf[1][j][s2], bfr, a1, 0, 0, 0); }
        T0 = a0; T1 = a1;
        PBAR();
    }
}

__device__ __forceinline__ void p4_post(Frame& F, const In& I, unsigned char* ws) {
    const int lane = F.lane, tn = lane & 15, tq = lane >> 4;
    const bf16 *SC = (const bf16*)(ws + WS_SC), *QC = (const bf16*)(ws + WS_QC), *YLOC = (const bf16*)(ws + WS_YLOC), *Vb = (const bf16*)(ws + WS_V), *Gb = (const bf16*)(ws + WS_G); const float* BON = (const float*)(ws + WS_BON);
    bf16* MIX = (bf16*)(ws + WS_MIX);
    const int gw = F.vcu * NWAVES + F.wave, NGW = F.G * NWAVES;
    for (int it = gw; it < 4096 * 4; it += NGW) {
        const int unit = it >> 2, n0 = (it & 3) * 16, bh = unit >> 7, c = unit & 127, b = bh >> 4, h = bh & 15; const size_t row = (size_t)b * SEQ + c * 64 + n0 + tn; const int ch0 = h * 64;
        const bf16* sc = SC + (size_t)unit * 4096;
        f32x4 acc[4] = {{0.f, 0.f, 0.f, 0.f}, {0.f, 0.f, 0.f, 0.f}, {0.f, 0.f, 0.f, 0.f}, {0.f, 0.f, 0.f, 0.f}};
#pragma unroll
        for (int ks = 0; ks < 2; ++ks) { const bf16x8 bq = *(const GAS bf16x8*)(QC + row * 1024 + ch0 + 32 * ks + 8 * tq);
#pragma unroll
            for (int mt = 0; mt < 4; ++mt) { const bf16x8 as = *(const GAS bf16x8*)(sc + (size_t)(16 * mt + tn) * 64 + 32 * ks + 8 * tq); acc[mt] = MMA16(as, bq, acc[mt]); } }
        float y[4][4]; float s = 0.f;
#pragma unroll
        for (int mt = 0; mt < 4; ++mt) { const u32x2 yl = *(const GAS u32x2*)(YLOC + row * 1024 + ch0 + 16 * mt + 4 * tq);
            y[mt][0] = acc[mt][0] + bflo(yl.x); y[mt][1] = acc[mt][1] + bfhi(yl.x); y[mt][2] = acc[mt][2] + bflo(yl.y); y[mt][3] = acc[mt][3] + bfhi(yl.y); s += (y[mt][0] + y[mt][1]) + (y[mt][2] + y[mt][3]); }
        s += __shfl_xor(s, 16); s += __shfl_xor(s, 32);
        const float mean = s * (1.0f / 64.0f); float q = 0.f;
#pragma unroll
        for (int mt = 0; mt < 4; ++mt)
#pragma unroll
            for (int r = 0; r < 4; ++r) { y[mt][r] -= mean; q += y[mt][r] * y[mt][r]; }
        q += __shfl_xor(q, 16); q += __shfl_xor(q, 32);
        const float rstd = 1.0f / sqrtf(q * (1.0f / 64.0f) + LNX_EPS);
        const float bon = BON[row * 16 + h]; const bool first = (c == 0) && (n0 + tn == 0);
#pragma unroll
        for (int mt = 0; mt < 4; ++mt) { const int cc = ch0 + 16 * mt + 4 * tq; const size_t o = row * 1024 + cc;
            const f32x4 lw = *(const GAS f32x4*)(I.lnx_w + cc), lb = *(const GAS f32x4*)(I.lnx_b + cc), mu = *(const GAS f32x4*)(I.mu + 2048 + cc);
            const u32x2 vc = *(const GAS u32x2*)(Vb + o), gg = *(const GAS u32x2*)(Gb + o); u32x2 vp = {0u, 0u}; if (!first) vp = *(const GAS u32x2*)(Vb + o - 1024);
            const float vcf[4] = {bflo(vc.x), bfhi(vc.x), bflo(vc.y), bfhi(vc.y)}, vpf[4] = {bflo(vp.x), bfhi(vp.x), bflo(vp.y), bfhi(vp.y)}, gf[4] = {bflo(gg.x), bfhi(gg.x), bflo(gg.y), bfhi(gg.y)};
            float ov[4];
#pragma unroll
            for (int r = 0; r < 4; ++r) { const float vsft = vcf[r] + (vpf[r] - vcf[r]) * mu[r]; ov[r] = (y[mt][r] * rstd * lw[r] + lb[r] + bon * vsft) * (gf[r] / (1.0f + __expf(-gf[r]))); }
            u32x2 st; st.x = pk2(ov[0], ov[1]); st.y = pk2(ov[2], ov[3]); *(GAS u32x2*)(MIX + row * 2048 + cc) = st; }
    }
}

__device__ __forceinline__ void p6_rows(Frame& F, const In& I, unsigned char* ws) {
    float* out = (float*)(ws + WS_MIXOUT);
    const float *MIXOUT = (const float*)(ws + WS_MIXOUT), *PLERAW = (const float*)(ws + WS_PLERAW); bf16 *H1B = (bf16*)(ws + WS_H1B), *PLEN = (bf16*)(ws + WS_PLEN);
    const int gw = F.vcu * NWAVES + F.wave, NGW = F.G * NWAVES, lane = F.lane;
    for (int m = gw; m < M; m += NGW) {
        { const GAS f32x4* mr = (const GAS f32x4*)(MIXOUT + (size_t)m * DM) + lane; const GAS f32x4* xr = (const GAS f32x4*)(I.x + (size_t)m * DM) + lane; const GAS f32x4* gr = (const GAS f32x4*)I.g_post + lane;
          f32x4 v[8]; float s = 0.f;
#pragma unroll
          for (int j = 0; j < 8; ++j) { v[j] = mr[64 * j]; s += (v[j].x * v[j].x + v[j].y * v[j].y) + (v[j].z * v[j].z + v[j].w * v[j].w); }
          const float rinv = 1.0f / sqrtf(wave_allsum(s) * (1.0f / DM) + RMS_EPS);
          GAS f32x4* orow = (GAS f32x4*)(out + (size_t)m * DM) + lane; GAS u32x2* hb = (GAS u32x2*)(H1B + (size_t)m * DM) + lane;
#pragma unroll
          for (int j = 0; j < 8; ++j) { const f32x4 g = gr[64 * j], x = xr[64 * j]; f32x4 hh; hh.x = x.x + v[j].x * rinv * g.x; hh.y = x.y + v[j].y * rinv * g.y; hh.z = x.z + v[j].z * rinv * g.z; hh.w = x.w + v[j].w * rinv * g.w;
              orow[64 * j] = hh; u32x2 o; o.x = pk2(hh.x, hh.y); o.y = pk2(hh.z, hh.w); hb[64 * j] = o; } }
        { const GAS f32x4* pr = (const GAS f32x4*)(PLERAW + (size_t)m * DM) + lane; const GAS f32x4* gr = (const GAS f32x4*)I.g_ple + lane;
          f32x4 v[8]; float s = 0.f;
#pragma unroll
          for (int j = 0; j < 8; ++j) { v[j] = pr[64 * j]; s += (v[j].x * v[j].x + v[j].y * v[j].y) + (v[j].z * v[j].z + v[j].w * v[j].w); }
          const float rinv = 1.0f / sqrtf(wave_allsum(s) * (1.0f / DM) + RMS_EPS);
          GAS u32x2* pn = (GAS u32x2*)(PLEN + (size_t)m * DM) + lane;
#pragma unroll
          for (int j = 0; j < 8; ++j) { const f32x4 g = gr[64 * j]; u32x2 o; o.x = pk2(v[j].x * rinv * g.x, v[j].y * rinv * g.y); o.y = pk2(v[j].z * rinv * g.z, v[j].w * rinv * g.w); pn[64 * j] = o; } }
    }
}

struct Args { const float* in[19]; float* out; unsigned char* ws; int ph_lo, ph_hi, li, pad; };
__global__ void __launch_bounds__(NWAVES * 64, 2) hymba_fwd(Args args) {
    extern __shared__ __attribute__((aligned(16))) unsigned char lds[];
    Frame F;
    F.lds = (LAS unsigned char*)lds; F.MISC = (volatile LAS unsigned*)(F.lds + MISC_OFF);
    F.tid = threadIdx.x; F.lane = F.tid & 63; F.wave = __builtin_amdgcn_readfirstlane(F.tid >> 6);
    F.G = gridDim.x; { const int bx = blockIdx.x; F.vcu = (F.G % 8 == 0) ? (bx % 8) * (F.G / 8) + bx / 8 : bx; }
    unsigned char* ws = args.ws; F.ctl = (gu32*)(ws + WS_CTL);
    In I; I.x = args.in[0]; I.p = args.in[1]; I.g_pre = args.in[2]; I.w_in = args.in[3]; I.mu = args.in[4]; I.w0 = args.in[5]; I.w_up = args.in[6]; I.a0 = args.in[7]; I.a_up = args.in[8];
    I.k_k = args.in[9]; I.k_a = args.in[10]; I.r_k = args.in[11]; I.lnx_w = args.in[12]; I.lnx_b = args.in[13]; I.w_out = args.in[14]; I.g_post = args.in[15]; I.w_ple = args.in[16]; I.w_plg = args.in[17]; I.g_ple = args.in[18];
    for (int u = F.tid; u < (LDS_BYTES - LDSCTL_OFF) / 4; u += NWAVES * 64) ((LAS unsigned*)(F.lds + LDSCTL_OFF))[u] = 0u;
    __syncthreads();
    const bool multi = (args.ph_hi - args.ph_lo) > 1;
    XcdBarrier bar; bar.bar = (unsigned*)(F.ctl + CW_BAR); bar.x = 0; bar.st = nullptr;
    if (multi) bar = xcd_barrier_post((unsigned*)(F.ctl + CW_BAR), F.MISC + 8);
    const int lo = args.ph_lo, hi = args.ph_hi;
#define IN(k) (lo <= (k) && (k) < hi)
#define BOTH(k) (IN(k) && IN((k) + 1))
    bf16* Z = (bf16*)(ws + WS_Z);
    if (IN(0)) { p0_prologue(F, I, ws); if (BOTH(0)) xcd_barrier(bar); }
    if (IN(1)) {
        pg8::Gemm g{Z, Z, M, 8448, DM}; pg8::SchedIn S{F.G, (int)blockIdx.x};
        pg8::EpiIn E{ws, WS_R, WS_Q, WS_LORA, WS_VT};
        pg8::gemm_phase<pg8::EpiIn, pg8::SchedIn, true, true>(F.lds + RING_OFF, g, S, E);
        if (BOTH(1)) xcd_barrier(bar);
    }
    if (IN(2)) { p3a_prepass(F, I, ws); if (BOTH(2)) xcd_barrier(bar); }
    if (IN(3)) { p3b_state(F, ws); p2_attention(F, ws, 64); if (BOTH(3)) xcd_barrier(bar); }
    if (IN(4)) { p4_post(F, I, ws); if (BOTH(4)) xcd_barrier(bar); }
    if (IN(5)) {
        { pg8::Gemm g{(const bf16*)(ws + WS_MIX), (const bf16*)(ws + WS_W2T), M, DM, DM}; pg8::StaticOrder S; S.init(M, DM, F.G, (int)blockIdx.x);
          pg8::EpiF32 E{(float*)(ws + WS_MIXOUT), DM};
          pg8::gemm_phase<pg8::EpiF32, pg8::StaticOrder, true, true>(F.lds + RING_OFF, g, S, E); }
        __syncthreads();
        { pg8::Gemm g{(const bf16*)(ws + WS_PB), (const bf16*)(ws + WS_WPT), M, DM, PLE_DIM}; pg8::StaticOrder S; S.init(M, DM, F.G, (int)blockIdx.x);
          pg8::EpiF32 E{(float*)(ws + WS_PLERAW), DM};
          pg8::gemm_phase<pg8::EpiF32, pg8::StaticOrder, true, true>(F.lds + RING_OFF, g, S, E); }
        if (BOTH(5)) xcd_barrier(bar);
    }
    if (IN(6)) { p6_rows(F, I, ws); if (BOTH(6)) xcd_barrier(bar); }
    if (IN(7)) {
        pg8::Gemm g{(const bf16*)(ws + WS_H1B), (const bf16*)(ws + WS_W3T), M, DM, DM}; pg8::StaticOrder S; S.init(M, DM, F.G, (int)blockIdx.x);
        pg8::EpiFinal E{args.out, (const float*)(ws + WS_MIXOUT), (const bf16*)(ws + WS_PLEN), DM};
        pg8::gemm_phase<pg8::EpiFinal, pg8::StaticOrder, true, true>(F.lds + RING_OFF, g, S, E);
    }
#undef IN
#undef BOTH
}

extern "C" void kernel_launch(void* const* d_in, const int* in_sizes, int n_in, void* d_out, int out_size, void* d_ws, size_t ws_size, hipStream_t stream) {
    static int grid = 0;
    if (grid == 0) {
        if (n_in != 19 || in_sizes[0] != M * DM || out_size != M * DM || ws_size < WS_END) { fprintf(stderr, "kernel_launch: unexpected shapes (n_in %d, in0 %d, out %d, ws %zu); nothing launched\n", n_in, n_in > 0 ? in_sizes[0] : -1, out_size, ws_size); grid = -1; return; }
        int dev = 0, cus = 0, per_cu = 0;
        if (hipGetDevice(&dev) != hipSuccess || hipDeviceGetAttribute(&cus, hipDeviceAttributeMultiprocessorCount, dev) != hipSuccess) { grid = -1; return; }
        if (hipFuncSetAttribute((const void*)hymba_fwd, hipFuncAttributeMaxDynamicSharedMemorySize, LDS_BYTES) != hipSuccess) { fprintf(stderr, "kernel_launch: hipFuncSetAttribute failed\n"); grid = -1; return; }
        if (hipOccupancyMaxActiveBlocksPerMultiprocessor(&per_cu, (const void*)hymba_fwd, NWAVES * 64, LDS_BYTES) != hipSuccess || per_cu < 1) { fprintf(stderr, "kernel_launch: occupancy query says %d\n", per_cu); }
        (void)hipGetLastError();
        grid = cus;
    }
    if (grid < 0) return;
    if (hipMemsetAsync((char*)d_ws + WS_CTL, 0, CTL_ZERO_BYTES, stream) != hipSuccess) return;
    Args a{};
    for (int i = 0; i < 19; ++i) a.in[i] = (const float*)d_in[i];
    a.out = (float*)d_out; a.ws = (unsigned char*)d_ws;
    constexpr int NL = MK_N_LAUNCHES;
    for (int li = 0; li < NL; ++li) {
        a.ph_lo = (NL == 1) ? 0 : li; a.ph_hi = (NL == 1) ? N_PHASES : li + 1; a.li = li;
        hipLaunchKernelGGL(hymba_fwd, dim3(grid), dim3(NWAVES * 64), LDS_BYTES, stream, a);
    }
}
```

```cpp
#include <hip/hip_runtime.h>
#include <cstdio>
#include <cstdint>
namespace pg8 {
#define PG8_LAS __attribute__((address_space(3)))
typedef unsigned short bf16_t;
typedef short bf16x8 __attribute__((ext_vector_type(8)));
typedef float f32x4 __attribute__((ext_vector_type(4)));
typedef unsigned u32x4 __attribute__((ext_vector_type(4)));
constexpr int BM = 256, BK = 64, HALF = 128, HTB = HALF * BK * 2  , STAGE_BYTES = 8 * HTB, NXCD = 8, WGM = 8;

__host__ __device__ __forceinline__ int lds_byte(int r, int c) { const int st = (r >> 4) * 2 + (c >> 5), rr = r & 15, cc = c & 31, ob = rr * 64 + cc * 2; return st * 1024 + (ob ^ (((ob >> 9) & 1) << 5)); }
__host__ __device__ __forceinline__ void stage_rc(int b, int& R, int& C) { const int st = b / 1024, sb = b % 1024, swz = sb ^ (((sb >> 9) & 1) << 5); R = (st >> 1) * 16 + swz / 64; C = (st & 1) * 32 + (swz % 64) / 2; }
__host__ __device__ __forceinline__ int perm32(int rho) { const int n = rho >> 4, i = rho & 15; return 8 * (i >> 2) + 4 * n + (i & 3); }

struct Unit { int pm, pn; };
struct Gemm { const bf16_t* A; const bf16_t* Bt; int M, N, K; };

struct StaticOrder {
    int nM, nN, nwg, G, c;
    __host__ __device__ void init(int M, int N, int G_, int c_) { nM = M / BM; nN = N / BM; nwg = nM * nN; G = G_; c = c_; }
    __host__ __device__ bool next(int i, Unit& u) const {
        const long L = (long)i * G + c; if (L >= nwg) return false;
        int wgid = (int)L; { const int q = nwg / NXCD, r = nwg % NXCD, xcd = wgid % NXCD, off = wgid / NXCD; wgid = (xcd < r ? xcd * (q + 1) : r * (q + 1) + (xcd - r) * q) + off; }
        const int nig = WGM * nN, gid = wgid / nig, fm = gid * WGM, gsz = (nM - fm) < WGM ? (nM - fm) : WGM;
        u.pm = fm + ((wgid % nig) % gsz); u.pn = (wgid % nig) / gsz; return true;
    }
    __device__ __forceinline__ void a_ready(const Unit&) const {}
    __device__ __forceinline__ void done(const Unit&) const {}
};

__device__ __forceinline__ unsigned cvt_pk_bf16(float lo, float hi) { unsigned r; asm volatile("v_cvt_pk_bf16_f32 %0, %1, %2" : "=v"(r) : "v"(lo), "v"(hi)); return r; }
typedef float f32x2 __attribute__((ext_vector_type(2)));
struct EpiF32 {
    static constexpr bool PERM = false, AFTER_DRAIN = false;
    float* C; int ldc;
    __device__ __forceinline__ void operator()(const f32x4 (&acc)[2][2][4][2], const Unit& u, int wr, int wc, int fr, int fq) const {
        const int row0 = u.pm * BM + wr * 64 + fr, col0 = u.pn * BM + wc * 32 + 4 * fq;
#pragma unroll
        for (int ai = 0; ai < 2; ++ai)
#pragma unroll
            for (int m = 0; m < 4; ++m) { float* rowp = C + (size_t)(row0 + ai * HALF + m * 16) * ldc + col0;
#pragma unroll
                for (int bj = 0; bj < 2; ++bj)
#pragma unroll
                    for (int n = 0; n < 2; ++n) *(f32x4*)(rowp + bj * HALF + n * 16) = acc[ai][bj][m][n]; }
    }
};
struct EpiIn {
    static constexpr bool PERM = true, AFTER_DRAIN = false;
    unsigned char* ws; size_t off_r, off_q, off_lora, off_vt;
    __device__ __forceinline__ void operator()(const f32x4 (&acc)[2][2][4][2], const Unit& u, int wr, int wc, int fr, int fq) const {
        bf16_t* base; int ldc = 1024, rowt, colt, mode = 0; float sc = 1.f;
        if (u.pn >= 64) { const int tile = u.pn - 64, grp = tile >> 2; rowt = u.pm * BM; colt = (tile & 3) * BM;
            size_t off;
            if (grp < 4) off = off_r + (size_t)grp * (32u << 20);
            else if (grp == 4) { off = off_q; sc = 0.18033688011112042f; mode = 1; }
            else if (grp == 5) { off = off_q + (32u << 20); mode = 1; }
            else if (grp == 6) { off = off_q + (96u << 20); mode = 1; }
            else { off = off_lora; ldc = 256; colt = 0; }
            base = (bf16_t*)(ws + off);
        } else { base = (bf16_t*)(ws + off_vt); rowt = (u.pm - 93) * BM; colt = u.pn * BM; mode = 2; }
        const int row0 = rowt + wr * 64 + fr, col0 = colt + wc * 32 + 8 * fq;
#pragma unroll
        for (int ai = 0; ai < 2; ++ai)
#pragma unroll
            for (int m = 0; m < 4; ++m) { const int r = row0 + ai * HALF + m * 16;
#pragma unroll
                for (int bj = 0; bj < 2; ++bj) { const int c = col0 + bj * HALF; f32x4 v0 = acc[ai][bj][m][0] * sc, v1 = acc[ai][bj][m][1] * sc;
                    u32x4 w; w.x = cvt_pk_bf16(v0[0], v0[1]); w.y = cvt_pk_bf16(v0[2], v0[3]); w.z = cvt_pk_bf16(v1[0], v1[1]); w.w = cvt_pk_bf16(v1[2], v1[3]);
                    size_t o;
                    if (mode == 0) o = (size_t)r * ldc + c;
                    else if (mode == 1) o = ((size_t)((r >> 13) * 16 + (c >> 6)) * 8192 + (r & 8191)) * 64 + (c & 63);
                    else o = ((size_t)(((c >> 13) * 16 + (r >> 6)) * 256 + ((c & 8191) >> 5)) * 64 + (r & 63)) * 32 + (c & 31);
                    *(u32x4*)(base + o) = w; } }
    }
};
struct SchedIn {
    int G, c;
    __device__ __forceinline__ bool next(int i, Unit& u) const {
        const int L = i * G + c; if (L >= 2112) return false;
        if (L < 1856) { const int nwg = 1856, nM = 64, nN = 29; int wgid = L; { const int q = nwg / NXCD, r = nwg % NXCD, xcd = wgid % NXCD, off = wgid / NXCD; wgid = (xcd < r ? xcd * (q + 1) : r * (q + 1) + (xcd - r) * q) + off; }
            const int nig = WGM * nN, gid = wgid / nig, fm = gid * WGM, gsz = (nM - fm) < WGM ? (nM - fm) : WGM;
            u.pm = fm + ((wgid % nig) % gsz); u.pn = 64 + (wgid % nig) / gsz; }
        else { const int l2 = L - 1856; u.pm = 93 + (l2 & 3); u.pn = l2 >> 2; }
        return true;
    }
    __device__ __forceinline__ void a_ready(const Unit&) const {}
    __device__ __forceinline__ void done(const Unit&) const {}
};
struct EpiFinal {
    static constexpr bool PERM = false, AFTER_DRAIN = false;
    float* __restrict__ out; const float* __restrict__ h1; const bf16_t* __restrict__ ple; int ldc;
    __device__ __forceinline__ void operator()(const f32x4 (&acc)[2][2][4][2], const Unit& u, int wr, int wc, int fr, int fq) const {
        typedef unsigned u32x2v __attribute__((ext_vector_type(2)));
        const int row0 = u.pm * BM + wr * 64 + fr, col0 = u.pn * BM + wc * 32 + 4 * fq;
#pragma unroll
        for (int ai = 0; ai < 2; ++ai)
#pragma unroll
            for (int mp = 0; mp < 2; ++mp) { f32x4 hv[2][2][2]; u32x2v pv[2][2][2];
#pragma unroll
                for (int mm = 0; mm < 2; ++mm) { const size_t ro = (size_t)(row0 + ai * HALF + (2 * mp + mm) * 16) * ldc + col0;
#pragma unroll
                    for (int bj = 0; bj < 2; ++bj)
#pragma unroll
                        for (int n = 0; n < 2; ++n) { const size_t o = ro + bj * HALF + n * 16; hv[mm][bj][n] = __builtin_nontemporal_load((const f32x4*)(h1 + o)); pv[mm][bj][n] = __builtin_nontemporal_load((const u32x2v*)(ple + o)); } }
#pragma unroll
                for (int mm = 0; mm < 2; ++mm) { const int m = 2 * mp + mm; const size_t ro = (size_t)(row0 + ai * HALF + m * 16) * ldc + col0;
#pragma unroll
                    for (int bj = 0; bj < 2; ++bj)
#pragma unroll
                        for (int n = 0; n < 2; ++n) { const size_t o = ro + bj * HALF + n * 16; const f32x4 h = hv[mm][bj][n]; const u32x2v pw = pv[mm][bj][n];
                            const f32x4 a = acc[ai][bj][m][n]; f32x4 pl; pl[0] = __uint_as_float(pw.x << 16); pl[1] = __uint_as_float(pw.x & 0xffff0000u); pl[2] = __uint_as_float(pw.y << 16); pl[3] = __uint_as_float(pw.y & 0xffff0000u);
                            f32x4 r;
#pragma unroll
                            for (int e = 0; e < 4; ++e) r[e] = h[e] + pl[e] * __builtin_amdgcn_rcpf(1.0f + __expf(-a[e]));
                            *(f32x4*)(out + o) = r; } } }
    }
};
template <class Epi, class Sched, bool ALIGN_EPI = false, bool SP2 = false>
__device__ __forceinline__ void gemm_phase(PG8_LAS unsigned char* lds, const Gemm g, const Sched& S, const Epi& E) {
    const int tid = threadIdx.x, wid = __builtin_amdgcn_readfirstlane(tid >> 6), lane = tid & 63, wr = wid >> 2, wc = wid & 3, fr = lane & 15, fq = lane >> 4;
    const int K = g.K, nt = K / BK;
    unsigned voffA[2], voffB[2];
#pragma unroll
    for (int i = 0; i < 2; ++i) { int R, C; stage_rc(tid * 16 + i * 8192, R, C); const int Rb = Epi::PERM ? ((R & ~31) + perm32(R & 31)) : R;
        voffA[i] = (unsigned)(R * K + C) * 2u; voffB[i] = (unsigned)(Rb * K + C) * 2u; }
    const size_t kstep = (size_t)(BK * 2);
    const size_t hstep = (size_t)HALF * K * 2;
    const size_t tstep = 2 * hstep;
    const unsigned ldsw = (unsigned)wid * 1024u;
    const int aoff = lds_byte(wr * 64 + fr, fq * 8), boff = lds_byte(wc * 32 + fr, fq * 8);
#define PG8_SA(b, h) (((b) * 2 + (h)) * HTB)
#define PG8_SB(b, h) ((4 + (b) * 2 + (h)) * HTB)
#define PG8_STAGE(bufoff, gbase, voff) do { _Pragma("unroll") for (int _i = 0; _i < 2; ++_i) \
        __builtin_amdgcn_global_load_lds((const unsigned*)((const char*)(gbase) + (voff)[_i]), (PG8_LAS unsigned*)(lds + (bufoff) + ldsw + _i * 8192), 16, 0, 0); } while (0)
#define PG8_LDA(dst, b, h) do { _Pragma("unroll") for (int m = 0; m < 4; ++m) _Pragma("unroll") for (int k = 0; k < 2; ++k) dst[m][k] = *(const PG8_LAS bf16x8*)(lds + PG8_SA(b, h) + aoff + m * 2048 + k * 1024); } while (0)
#define PG8_LDB(dst, b, h) do { _Pragma("unroll") for (int n = 0; n < 2; ++n) _Pragma("unroll") for (int k = 0; k < 2; ++k) dst[n][k] = *(const PG8_LAS bf16x8*)(lds + PG8_SB(b, h) + boff + n * 2048 + k * 1024); } while (0)
#define PG8_MMA(ai, bj, At, Bt) do { __builtin_amdgcn_s_setprio(1); _Pragma("unroll") for (int m = 0; m < 4; ++m) _Pragma("unroll") for (int n = 0; n < 2; ++n) _Pragma("unroll") for (int k = 0; k < 2; ++k) \
        acc[ai][bj][m][n] = __builtin_amdgcn_mfma_f32_16x16x32_bf16(Bt[n][k], At[m][k], acc[ai][bj][m][n], 0, 0, 0); __builtin_amdgcn_s_setprio(0); } while (0)
#define PG8_WAIT_V(n) asm volatile("s_waitcnt vmcnt(" #n ")" ::: "memory")
#define PG8_WAIT_L(n) asm volatile("s_waitcnt lgkmcnt(" #n ")" ::: "memory")
#define PG8_BAR __builtin_amdgcn_s_barrier()
#define PG8_SCHED __builtin_amdgcn_sched_barrier(0)
    Unit cur, nxt; int ui = 0;
    if (!S.next(0, cur)) return;
    f32x4 acc[2][2][4][2];
#pragma unroll
    for (int a = 0; a < 2; ++a)
#pragma unroll
        for (int b = 0; b < 2; ++b)
#pragma unroll
            for (int m = 0; m < 4; ++m)
#pragma unroll
                for (int n = 0; n < 2; ++n) acc[a][b][m][n] = (f32x4){0.f, 0.f, 0.f, 0.f};
    bf16x8 At[4][2], B0[2][2], B1[2][2];
    const char* cA = (const char*)g.A + (size_t)cur.pm * tstep; const char* cB = (const char*)g.Bt + (size_t)cur.pn * tstep;
    S.a_ready(cur);
    if constexpr (SP2) {
        PG8_STAGE(PG8_SB(0, 0), cB, voffB); PG8_STAGE(PG8_SB(0, 1), cB + hstep, voffB); PG8_STAGE(PG8_SA(0, 0), cA, voffA); PG8_STAGE(PG8_SA(0, 1), cA + hstep, voffA);
        if (wr == 1) PG8_BAR;
        PG8_WAIT_V(2); PG8_BAR;
        PG8_STAGE(PG8_SB(1, 0), cB + kstep, voffB); PG8_STAGE(PG8_SA(1, 0), cA + kstep, voffA); PG8_STAGE(PG8_SB(1, 1), cB + hstep + kstep, voffB);
        PG8_WAIT_V(6); PG8_BAR;
    } else {
        PG8_STAGE(PG8_SB(0, 0), cB, voffB); PG8_STAGE(PG8_SA(0, 0), cA, voffA); PG8_STAGE(PG8_SB(0, 1), cB + hstep, voffB); PG8_STAGE(PG8_SA(0, 1), cA + hstep, voffA);
        if (wr == 1) PG8_BAR;
        PG8_WAIT_V(4); PG8_BAR;
        PG8_STAGE(PG8_SB(1, 0), cB + kstep, voffB); PG8_STAGE(PG8_SA(1, 0), cA + kstep, voffA); PG8_STAGE(PG8_SB(1, 1), cB + hstep + kstep, voffB);
        PG8_WAIT_V(6); PG8_BAR;
    }
    for (;;) {
        const bool has_next = S.next(ui + 1, nxt);
        const char* nA = has_next ? (const char*)g.A + (size_t)nxt.pm * tstep : cA; const char* nB = has_next ? (const char*)g.Bt + (size_t)nxt.pn * tstep : cB;
        for (int t = 0; t < nt; t += 2) {
            const bool last = (t == nt - 2);
            const char* a1 = cA + (size_t)(t + 1) * kstep;
            const char* a2 = last ? nA : cA + (size_t)(t + 2) * kstep; const char* b2 = last ? nB : cB + (size_t)(t + 2) * kstep;
            const char* a3 = a2 + kstep; const char* b3 = b2 + kstep;
            if (last && has_next) S.a_ready(nxt);
            if constexpr (SP2) {
            PG8_LDB(B0, 0, 0); PG8_LDB(B1, 0, 1); PG8_SCHED; PG8_LDA(At, 0, 0); PG8_STAGE(PG8_SA(1, 1), a1 + hstep, voffA);
            PG8_WAIT_V(8); PG8_WAIT_L(0); PG8_BAR; PG8_MMA(0, 0, At, B0); PG8_MMA(0, 1, At, B1); PG8_BAR; PG8_SCHED;
            PG8_LDA(At, 0, 1); PG8_STAGE(PG8_SB(0, 0), b2, voffB); PG8_STAGE(PG8_SB(0, 1), b2 + hstep, voffB); PG8_STAGE(PG8_SA(0, 0), a2, voffA);
            PG8_WAIT_V(8); PG8_WAIT_L(0); PG8_BAR; PG8_MMA(1, 0, At, B0); PG8_MMA(1, 1, At, B1); PG8_BAR; PG8_SCHED;
            PG8_LDB(B0, 1, 0); PG8_LDB(B1, 1, 1); PG8_SCHED; PG8_LDA(At, 1, 0); PG8_STAGE(PG8_SA(0, 1), a2 + hstep, voffA);
            PG8_WAIT_V(8); PG8_WAIT_L(0); PG8_BAR; PG8_MMA(0, 0, At, B0); PG8_MMA(0, 1, At, B1); PG8_BAR; PG8_SCHED;
            PG8_LDA(At, 1, 1); PG8_STAGE(PG8_SB(1, 0), b3, voffB); PG8_STAGE(PG8_SB(1, 1), b3 + hstep, voffB); PG8_STAGE(PG8_SA(1, 0), a3, voffA);
            PG8_WAIT_V(8); PG8_WAIT_L(0); PG8_BAR; PG8_MMA(1, 0, At, B0); PG8_MMA(1, 1, At, B1); PG8_BAR; PG8_SCHED;
            } else {
            PG8_LDB(B0, 0, 0); PG8_SCHED; PG8_LDA(At, 0, 0); PG8_STAGE(PG8_SA(1, 1), a1 + hstep, voffA);
            PG8_WAIT_L(8); PG8_BAR; PG8_WAIT_L(0); PG8_MMA(0, 0, At, B0); PG8_BAR; PG8_SCHED;
            PG8_LDB(B1, 0, 1); PG8_STAGE(PG8_SB(0, 0), b2, voffB);
            PG8_BAR; PG8_WAIT_L(0); PG8_MMA(0, 1, At, B1); PG8_BAR;
            PG8_LDA(At, 0, 1); PG8_STAGE(PG8_SA(0, 0), a2, voffA);
            PG8_BAR; PG8_WAIT_L(0); PG8_MMA(1, 0, At, B0); PG8_BAR; PG8_SCHED;
            PG8_STAGE(PG8_SB(0, 1), b2 + hstep, voffB);
            PG8_WAIT_V(6); PG8_BAR; PG8_MMA(1, 1, At, B1); PG8_BAR;
            PG8_LDB(B0, 1, 0); PG8_SCHED; PG8_LDA(At, 1, 0); PG8_STAGE(PG8_SA(0, 1), a2 + hstep, voffA);
            PG8_WAIT_L(8); PG8_BAR; PG8_WAIT_L(0); PG8_MMA(0, 0, At, B0); PG8_BAR; PG8_SCHED;
            PG8_LDB(B1, 1, 1); PG8_STAGE(PG8_SB(1, 0), b3, voffB);
            PG8_BAR; PG8_WAIT_L(0); PG8_MMA(0, 1, At, B1); PG8_BAR;
            PG8_LDA(At, 1, 1); PG8_STAGE(PG8_SA(1, 0), a3, voffA);
            PG8_BAR; PG8_WAIT_L(0); PG8_MMA(1, 0, At, B0); PG8_BAR; PG8_SCHED;
            PG8_STAGE(PG8_SB(1, 1), b3 + hstep, voffB);
            PG8_WAIT_V(6); PG8_BAR; PG8_MMA(1, 1, At, B1); PG8_BAR;
            }
        }
        if constexpr (ALIGN_EPI) { if (wr == 0) PG8_BAR; }
        if constexpr (!Epi::AFTER_DRAIN) { E(acc, cur, wr, wc, fr, fq); S.done(cur); }
        if (!has_next) break;
#pragma unroll
        for (int a = 0; a < 2; ++a)
#pragma unroll
            for (int b = 0; b < 2; ++b)
#pragma unroll
                for (int m = 0; m < 4; ++m)
#pragma unroll
                    for (int n = 0; n < 2; ++n) acc[a][b][m][n] = (f32x4){0.f, 0.f, 0.f, 0.f};
        cur = nxt; cA = nA; cB = nB; ++ui;
        if constexpr (ALIGN_EPI) { if (wr == 1) PG8_BAR; }
    }
    PG8_WAIT_V(0);
    if constexpr (!ALIGN_EPI) { if (wr == 0) PG8_BAR; }
    PG8_BAR;
    if constexpr (Epi::AFTER_DRAIN) { E.fused(acc, cur, wr, wc, fr, fq, lds, wid, lane); S.done(cur); }
#undef PG8_SA
#undef PG8_SB
#undef PG8_STAGE
#undef PG8_LDA
#undef PG8_LDB
#undef PG8_MMA
#undef PG8_WAIT_V
#undef PG8_WAIT_L
#undef PG8_BAR
#undef PG8_SCHED
}
}

constexpr int NWAVES = 8;
constexpr int BATCH = 2, SEQ = 8192, DM = 2048, M = BATCH * SEQ, RW = 1024, NH = 16, HD = 64, PLE_DIM = 256, INW = 8320;
constexpr float RMS_EPS = 1e-6f, LNX_EPS = 64e-5f, L2_EPS = 1e-12f;
constexpr float SB_CUT = -150.1f;
#ifndef MK_N_LAUNCHES
#define MK_N_LAUNCHES 1
#endif
constexpr int N_PHASES = 8;
constexpr size_t MiB = 1u << 20;
constexpr size_t WS_CTL = 0, CTL_ZERO_BYTES = 64 * 1024;
constexpr size_t WS_Z = 1 * MiB;
constexpr size_t WS_WDEC = WS_Z, WS_ACO = WS_Z + 64 * MiB;
constexpr size_t WS_H1B = WS_Z;
constexpr size_t WS_W2T = 98 * MiB, WS_W3T = 106 * MiB, WS_WPT = 114 * MiB, WS_PB = 115 * MiB;
constexpr size_t WS_R = 123 * MiB, WS_K = 155 * MiB, WS_V = 187 * MiB, WS_G = 219 * MiB;
constexpr size_t WS_Q = 251 * MiB, WS_KS = 283 * MiB, WS_VT = 315 * MiB, WS_GS = 347 * MiB;
constexpr size_t WS_LORA = 379 * MiB;
constexpr size_t WS_MIX = 387 * MiB;
constexpr size_t WS_YRAW = WS_Q;
constexpr size_t WS_MIXOUT = WS_R;
constexpr size_t WS_PLERAW = WS_Q;
constexpr size_t WS_PLEN = WS_MIX;
constexpr size_t WS_END = 484 * MiB;
constexpr int CW_BAR = 1024;
constexpr int RING_OFF = 0, RING_BYTES = 131072;
constexpr int LDSCTL_OFF = 147456 - 512, MISC_OFF = LDSCTL_OFF + 320;
constexpr int LDS_BYTES = 147456;

#define GAS __attribute__((address_space(1)))
#define LAS __attribute__((address_space(3)))
typedef unsigned short bf16;
typedef unsigned v4u __attribute__((ext_vector_type(4)));
typedef float f32x4 __attribute__((ext_vector_type(4)));
typedef short bf16x8 __attribute__((ext_vector_type(8)));
typedef GAS unsigned gu32;
typedef GAS unsigned long long gu64;
#define RLX_AGENT __ATOMIC_RELAXED, __HIP_MEMORY_SCOPE_AGENT
#define LDS_WAIT() asm volatile("s_waitcnt lgkmcnt(0)" ::: "memory")
#define VM_WAIT() asm volatile("s_waitcnt vmcnt(0)" ::: "memory")
__device__ __forceinline__ unsigned long long rt() { return __builtin_amdgcn_s_memrealtime(); }
typedef float f32x2_t __attribute__((ext_vector_type(2))); typedef __bf16 bf16x2_t __attribute__((ext_vector_type(2)));
__device__ __forceinline__ unsigned pk2(float lo, float hi) { const f32x2_t v = {lo, hi}; const bf16x2_t b = __builtin_convertvector(v, bf16x2_t); return __builtin_bit_cast(unsigned, b); }
__device__ __forceinline__ unsigned f2bf(float f) { return pk2(f, 0.f) & 0xffffu; }

#define XB_TMO      128
#define XB_XCNT(j)  (256  + 64 * (j))
#define XB_XSUB(j)  (1280 + 64 * (j))
#define XB_XGEN(j)  (2304 + 64 * (j))
#define XB_TOP      3328
#define XB_TOPGEN   3392
#define XCD_BAR_WORDS 3456
#define XB_SPIN_CAP (1u << 18)

__device__ __forceinline__ unsigned xb_ld(unsigned* p)              { return __hip_atomic_load(p, __ATOMIC_RELAXED, __HIP_MEMORY_SCOPE_AGENT); }
__device__ __forceinline__ unsigned xb_add(unsigned* p, unsigned v) { return __hip_atomic_fetch_add(p, v, __ATOMIC_RELAXED, __HIP_MEMORY_SCOPE_AGENT); }
__device__ __forceinline__ unsigned xb_xcc_id() { return (unsigned)__builtin_amdgcn_s_getreg((3 << 11) | 20) & 0xFu; }
#define XB_SPIN(cond, bar) do { unsigned _sp = 0; while (cond) { __builtin_amdgcn_s_sleep(1); \
    if ((++_sp & 255u) == 0u) { if (xb_ld(&(bar)[XB_TMO])) break; if (_sp > XB_SPIN_CAP) { atomicAdd(&(bar)[XB_TMO], 1u); break; } } } } while (0)

struct XcdBarrier {
    unsigned* bar; unsigned x;
    volatile LAS unsigned* st;
};

__device__ __forceinline__ XcdBarrier xcd_barrier_post(unsigned* bar, volatile LAS unsigned* st) {
    XcdBarrier b; b.bar = bar; b.x = xb_xcc_id(); b.st = st;
    if (threadIdx.x == 0) (void)xb_add(&bar[XB_XCNT(b.x)], 1u);
    return b;
}
__device__ __forceinline__ void xcd_barrier_complete(unsigned* bar, unsigned x, unsigned& nloc, unsigned& nx) {
    const unsigned G = gridDim.x * gridDim.y * gridDim.z;
    unsigned sum, cnt, mine, sp = 0u;
    for (;;) {
        sum = 0u; cnt = 0u; mine = 0u;
#pragma unroll
        for (unsigned j = 0; j < 16; ++j) { const unsigned c = xb_ld(&bar[XB_XCNT(j)]); sum += c; cnt += (c > 0u) ? 1u : 0u; mine = (j == x) ? c : mine; }
        if (sum == G) break;
        __builtin_amdgcn_s_sleep(1);
        if ((++sp & 255u) == 0u) { if (xb_ld(&bar[XB_TMO])) break; if (sp > XB_SPIN_CAP) { atomicAdd(&bar[XB_TMO], 1u); break; } }
    }
    nloc = mine > 0u ? mine : 1u; nx = cnt > 0u ? cnt : 1u;
}

__device__ __forceinline__ void xcd_barrier(const XcdBarrier& b) {
    asm volatile("s_waitcnt vmcnt(0)" ::: "memory");
    __syncthreads();
    if (threadIdx.x == 0) {
        unsigned* bar = b.bar;
        __builtin_amdgcn_s_waitcnt(0);
        unsigned nloc = b.st[0], nx = b.st[1];
        if (nloc == 0u) { xcd_barrier_complete(bar, b.x, nloc, nx); b.st[0] = nloc; b.st[1] = nx; }
        const unsigned old = xb_add(&bar[XB_XSUB(b.x)], 1u);
        const unsigned gen = old / nloc;
        if (old + 1u == (gen + 1u) * nloc) {
            __builtin_amdgcn_fence(__ATOMIC_RELEASE, "agent");
            asm volatile("s_waitcnt vmcnt(0)" ::: "memory");
            const unsigned og = xb_add(&bar[XB_TOP], 1u);
            const unsigned tg = og / nx;
            if (og + 1u == (tg + 1u) * nx) xb_add(&bar[XB_TOPGEN], 1u);
            else XB_SPIN(xb_ld(&bar[XB_TOPGEN]) == tg, bar);
            __builtin_amdgcn_fence(__ATOMIC_ACQUIRE, "agent");
            xb_add(&bar[XB_XGEN(b.x)], 1u);
            asm volatile("s_waitcnt vmcnt(0)" ::: "memory");
        } else {
            XB_SPIN(xb_ld(&bar[XB_XGEN(b.x)]) == gen, bar);
            __builtin_amdgcn_fence(__ATOMIC_ACQUIRE, "agent");
            asm volatile("s_waitcnt vmcnt(0)" ::: "memory");
        }
    }
    __syncthreads();
}

typedef float f32x16 __attribute__((ext_vector_type(16)));
typedef unsigned u32x2 __attribute__((ext_vector_type(2)));
typedef unsigned u32x4 __attribute__((ext_vector_type(4)));
struct Frame {
    LAS unsigned char* lds; volatile LAS unsigned* MISC; gu32* ctl;
    int tid, lane, wave, vcu, G;
};
__device__ __forceinline__ float bf2f(bf16 b) { return __uint_as_float((unsigned)b << 16); }
__device__ __forceinline__ float bflo(unsigned w) { return __uint_as_float(w << 16); }
__device__ __forceinline__ float bfhi(unsigned w) { return __uint_as_float(w & 0xffff0000u); }
template <int CTRL, int RMASK> __device__ __forceinline__ float dppadd(float x) {
    const int m = __builtin_amdgcn_update_dpp(0, __builtin_bit_cast(int, x), CTRL, RMASK, 0xF, false);
    return x + __builtin_bit_cast(float, m);
}
__device__ __forceinline__ float dpp_sum63(float x) {
    x = dppadd<0xB1, 0xF>(x); x = dppadd<0x4E, 0xF>(x); x = dppadd<0x141, 0xF>(x); x = dppadd<0x140, 0xF>(x);
    x = dppadd<0x142, 0xA>(x); x = dppadd<0x143, 0xC>(x); return x;
}
__device__ __forceinline__ float rdlane(float x, int l) { return __builtin_bit_cast(float, __builtin_amdgcn_readlane(__builtin_bit_cast(int, x), l)); }
__device__ __forceinline__ float wave_allsum(float x) { return rdlane(dpp_sum63(x), 63); }
__device__ __forceinline__ float row16_allsum(float x) { x = dppadd<0xB1, 0xF>(x); x = dppadd<0x4E, 0xF>(x); x = dppadd<0x141, 0xF>(x); x = dppadd<0x140, 0xF>(x); return x; }

constexpr int PT = 72, MATB = 64 * PT * 2;
constexpr int LB_KQ = 0, LB_RQ = 1, LB_BK = 2, LB_KK = 3, LB_BD = 4, LB_KD = 5, LB_V = 6, LB_LA = 7, LB_AUK = 8, LB_ARB = 9, LB_ARK = 10, LB_PA = 11;
constexpr int LB_LB = LB_BK, LB_PB = LB_KK;
constexpr int LB_X1 = 12;
constexpr int L_G = 13 * MATB, L_SEG = L_G + 64 * 64 * 4, L_CT = L_SEG + 8 * 64 * 4;
static_assert(L_CT + 640 * 4 <= LDSCTL_OFF, "chunk LDS map");
#define PBAR() do { asm volatile("s_waitcnt lgkmcnt(0)" ::: "memory"); __builtin_amdgcn_s_barrier(); asm volatile("" ::: "memory"); } while (0)
constexpr size_t WS_NCT = WS_Z, WS_MCT = WS_Z + 32 * MiB, WS_QC = WS_Z + 64 * MiB, WS_YLOC = 451 * MiB, WS_BON = 483 * MiB, WS_SC = WS_R;
typedef short v4i16_t __attribute__((ext_vector_type(4)));
__device__ __forceinline__ bf16x8 ldA(const LAS unsigned char* X, int m0, int ks, int lane) { return *(const LAS bf16x8*)(X + ((m0 + (lane & 15)) * PT + 32 * ks + 8 * (lane >> 4)) * 2); }
__device__ __forceinline__ bf16x8 ldTr(const LAS unsigned char* X, int c0, int ks, int lane) {
    const int g = lane >> 4, i = lane & 15, q = i >> 2, p = i & 3;
    const LAS unsigned char* a = X + ((32 * ks + 8 * g + q) * PT + c0 + 4 * p) * 2;
    const v4i16_t lo = __builtin_amdgcn_ds_read_tr16_b64_v4i16((LAS v4i16_t*)a), hi = __builtin_amdgcn_ds_read_tr16_b64_v4i16((LAS v4i16_t*)(a + 4 * PT * 2));
    return (bf16x8){lo[0], lo[1], lo[2], lo[3], hi[0], hi[1], hi[2], hi[3]};
}
__device__ __forceinline__ void stRM(LAS unsigned char* X, int m0, int n0, const f32x4& acc, int lane) {
    const int n = lane & 15, q = lane >> 4;
    const unsigned w01 = pk2(acc[0], acc[1]), w23 = pk2(acc[2], acc[3]); LAS unsigned char* p = X + ((m0 + 4 * q) * PT + n0 + n) * 2;
    *(LAS unsigned short*)(p) = (unsigned short)w01; *(LAS unsigned short*)(p + PT * 2) = (unsigned short)(w01 >> 16); *(LAS unsigned short*)(p + 2 * PT * 2) = (unsigned short)w23; *(LAS unsigned short*)(p + 3 * PT * 2) = (unsigned short)(w23 >> 16);
}
#define MMA16(a, b, c) __builtin_amdgcn_mfma_f32_16x16x32_bf16(a, b, c, 0, 0, 0)

__device__ __forceinline__ void p0_transpose_tile64(const float* W, int ldw, int k0, int sn0, bf16* WT, int K, int dn0, LAS unsigned char* scr, int lane) {
    const int rsub = lane >> 4, c4 = (lane & 15) * 4;
    f32x4 v[16];
#pragma unroll
    for (int i = 0; i < 16; ++i) v[i] = sn0 >= 0 ? *(const GAS f32x4*)(W + (size_t)(k0 + 4 * i + rsub) * ldw + sn0 + c4) : (f32x4){0.f, 0.f, 0.f, 0.f};
#pragma unroll
    for (int i = 0; i < 16; ++i) { u32x2 w; w.x = pk2(v[i].x, v[i].y); w.y = pk2(v[i].z, v[i].w); *(LAS u32x2*)(scr + ((4 * i + rsub) * PT + c4) * 2) = w; }
    LDS_WAIT(); asm volatile("" ::: "memory");
#pragma unroll
    for (int cb = 0; cb < 4; ++cb)
#pragma unroll
        for (int ks = 0; ks < 2; ++ks) { const bf16x8 f = ldTr(scr, 16 * cb, ks, lane);
            *(GAS bf16x8*)(WT + (size_t)(dn0 + 16 * cb + (lane & 15)) * K + k0 + 32 * ks + 8 * (lane >> 4)) = f; }
    LDS_WAIT(); asm volatile("" ::: "memory");
}
__device__ __forceinline__ int w1_src_col(int n) {
    if (n < 3072) return n;
    if (n < 4096) return 3200 + (n - 3072);
    if (n < 5120) return 4224 + (n - 4096);
    if (n < 6144) return 5248 + (n - 5120);
    if (n < 7168) return 7296 + (n - 6144);
    if (n < 7296) return 3072 + (n - 7168);
    if (n < 7424) return -1;
    return 6272 + (n - 7424);
}
struct In { const float *x, *p, *g_pre, *w_in, *mu, *w0, *w_up, *a0, *a_up, *k_k, *k_a, *r_k, *lnx_w, *lnx_b, *w_out, *g_post, *w_ple, *w_plg, *g_ple; };

__device__ __forceinline__ void p0_prologue(Frame& F, const In& I, unsigned char* ws) {
    LAS unsigned char* scr = F.lds + RING_OFF + F.wave * 16384;
    const int gw = F.vcu * NWAVES + F.wave, NGW = F.G * NWAVES, lane = F.lane;
    bf16* Z = (bf16*)(ws + WS_Z); bf16* W1T = Z + (size_t)64 * 256 * DM;
    for (int it = gw; it < 132 * 32; it += NGW) { const int nb = it % 132, kb = it / 132; p0_transpose_tile64(I.w_in, INW, kb * 64, w1_src_col(nb * 64), W1T, DM, nb * 64, scr, lane); }
    for (int m = 2 * gw; m < M; m += 2 * NGW) {
        const GAS f32x4* gr = (const GAS f32x4*)I.g_pre + lane;
        f32x4 v[2][8]; float s[2] = {0.f, 0.f};
#pragma unroll
        for (int r = 0; r < 2; ++r) { const GAS f32x4* xr = (const GAS f32x4*)(I.x + (size_t)(m + r) * DM) + lane;
#pragma unroll
            for (int j = 0; j < 8; ++j) v[r][j] = xr[64 * j]; }
#pragma unroll
        for (int r = 0; r < 2; ++r)
#pragma unroll
            for (int j = 0; j < 8; ++j) s[r] += (v[r][j].x * v[r][j].x + v[r][j].y * v[r][j].y) + (v[r][j].z * v[r][j].z + v[r][j].w * v[r][j].w);
#pragma unroll
        for (int r = 0; r < 2; ++r) { const float rinv = 1.0f / sqrtf(wave_allsum(s[r]) * (1.0f / DM) + RMS_EPS);
            GAS u32x2* o8 = (GAS u32x2*)(Z + (size_t)(m + r) * DM) + lane;
#pragma unroll
            for (int j = 0; j < 8; ++j) { const f32x4 g = gr[64 * j]; u32x2 o; o.x = pk2(v[r][j].x * rinv * g.x, v[r][j].y * rinv * g.y); o.y = pk2(v[r][j].z * rinv * g.z, v[r][j].w * rinv * g.w); o8[64 * j] = o; } }
    }
}
__device__ __forceinline__ void p1_tail_convert(Frame& F, const In& I, unsigned char* ws, int wg0) {
    if ((int)blockIdx.x < wg0) return;
    LAS unsigned char* scr = F.lds + RING_OFF + F.wave * 16384;
    const int gw = ((int)blockIdx.x - wg0) * NWAVES + F.wave, NGW = (F.G - wg0) * NWAVES, lane = F.lane;
    constexpr int I_2 = 32 * 32, I_3 = 32 * 32, I_P = 32 * 4;
    for (int it = gw; it < I_2 + I_3 + I_P; it += NGW) {
        int r = it;
        if (r < I_2) { const int nb = r % 32, kb = r / 32; p0_transpose_tile64(I.w_out, DM, kb * 64, nb * 64, (bf16*)(ws + WS_W2T), DM, nb * 64, scr, lane); continue; } r -= I_2;
        if (r < I_3) { const int nb = r % 32, kb = r / 32; p0_transpose_tile64(I.w_plg, DM, kb * 64, nb * 64, (bf16*)(ws + WS_W3T), DM, nb * 64, scr, lane); continue; } r -= I_3;
        { const int nb = r % 32, kb = r / 32; p0_transpose_tile64(I.w_ple, DM, kb * 64, nb * 64, (bf16*)(ws + WS_WPT), PLE_DIM, nb * 64, scr, lane); }
    }
    { const GAS f32x4* pr = (const GAS f32x4*)I.p; GAS u32x2* po = (GAS u32x2*)(ws + WS_PB); const int n4 = M * PLE_DIM / 4;
      for (int i = gw * 64 + lane; i < n4; i += NGW * 64) { const f32x4 v = pr[i]; u32x2 o; o.x = pk2(v.x, v.y); o.y = pk2(v.z, v.w); po[i] = o; } }
}

__device__ __forceinline__ int crow(int r, int hi) { return (r & 3) + 8 * (r >> 2) + 4 * hi; }
struct AttSet { bf16x8 k[4]; u32x2 v[8]; };
#define ALD16(dst, ptr, off) asm volatile("global_load_dwordx4 %0, %1, off offset:" #off : "=v"(dst) : "v"(ptr))
#define ALD8(dst, ptr, off) asm volatile("global_load_dwordx2 %0, %1, off offset:" #off : "=v"(dst) : "v"(ptr))
#define ATT_ISSUE(S, s0_) do { const bf16* kp_ = kp0 + (size_t)(s0_) * 64; const bf16* vp_ = vt0 + (size_t)(s0_) * 64; \
        ALD16(S.k[0], kp_, 0); ALD16(S.k[1], kp_, 32); ALD16(S.k[2], kp_, 64); ALD16(S.k[3], kp_, 96); \
        ALD8(S.v[0], vp_, 0); ALD8(S.v[1], vp_, 16); ALD8(S.v[2], vp_, 32); ALD8(S.v[3], vp_, 48); ALD8(S.v[4], vp_, 2048); ALD8(S.v[5], vp_, 2064); ALD8(S.v[6], vp_, 2080); ALD8(S.v[7], vp_, 2096); } while (0)
#define ATT_WAIT(S, N) asm volatile("s_waitcnt vmcnt(" #N ")" : "+v"(S.k[0]), "+v"(S.k[1]), "+v"(S.k[2]), "+v"(S.k[3]), "+v"(S.v[0]), "+v"(S.v[1]), "+v"(S.v[2]), "+v"(S.v[3]), "+v"(S.v[4]), "+v"(S.v[5]), "+v"(S.v[6]), "+v"(S.v[7]))
template <bool DIAG> __device__ __forceinline__ void attn_block(const AttSet& S, const bf16x8 (&qf)[4], f32x16& o0, f32x16& o1, float& R, int r32, int hi) {
    f32x16 p = {};
#pragma unroll
    for (int d0 = 0; d0 < 4; ++d0) p = __builtin_amdgcn_mfma_f32_32x32x16_bf16(S.k[d0], qf[d0], p, 0, 0, 0);
    float l1[16], lb[16];
#pragma unroll
    for (int r = 0; r < 16; ++r) { const float z = p[r]; const float sp = fmaxf(z, 0.f) + __builtin_amdgcn_logf(1.0f + __builtin_amdgcn_exp2f(-fabsf(z)));
        if (DIAG) { const bool valid = crow(r, hi) < r32; l1[r] = valid ? -sp : 0.f; lb[r] = valid ? (z - sp) : -INFINITY; } else { l1[r] = -sp; lb[r] = z - sp; } }
    float oth[4], tot[4];
#pragma unroll
    for (int g = 0; g < 4; ++g) { const float mine = (l1[4 * g] + l1[4 * g + 1]) + (l1[4 * g + 2] + l1[4 * g + 3]);
        auto rr = __builtin_amdgcn_permlane32_swap(__float_as_uint(mine), __float_as_uint(mine), false, false);
        const float lo = __uint_as_float(rr[0]), up = __uint_as_float(rr[1]); oth[g] = hi ? lo : up; tot[g] = lo + up; }
    float T[4]; T[3] = 0.f; T[2] = tot[3]; T[1] = T[2] + tot[2]; T[0] = T[1] + tot[1];
    float w[16];
#pragma unroll
    for (int g = 0; g < 4; ++g) { float e = T[g] + (hi ? 0.f : oth[g]) + R;
        w[4 * g + 3] = __builtin_amdgcn_exp2f(lb[4 * g + 3] + e); e += l1[4 * g + 3];
        w[4 * g + 2] = __builtin_amdgcn_exp2f(lb[4 * g + 2] + e); e += l1[4 * g + 2];
        w[4 * g + 1] = __builtin_amdgcn_exp2f(lb[4 * g + 1] + e); e += l1[4 * g + 1];
        w[4 * g + 0] = __builtin_amdgcn_exp2f(lb[4 * g + 0] + e); }
    R += T[0] + tot[0];
    u32x4 pb0, pb1;
    pb0.x = pk2(w[0], w[1]); pb0.y = pk2(w[2], w[3]); pb0.z = pk2(w[4], w[5]); pb0.w = pk2(w[6], w[7]);
    pb1.x = pk2(w[8], w[9]); pb1.y = pk2(w[10], w[11]); pb1.z = pk2(w[12], w[13]); pb1.w = pk2(w[14], w[15]);
    const bf16x8 pB0 = __builtin_bit_cast(bf16x8, pb0), pB1 = __builtin_bit_cast(bf16x8, pb1);
#define VA(dt, s) __builtin_bit_cast(bf16x8, (u32x4){S.v[4 * dt + 2 * s].x, S.v[4 * dt + 2 * s].y, S.v[4 * dt + 2 * s + 1].x, S.v[4 * dt + 2 * s + 1].y})
    o0 = __builtin_amdgcn_mfma_f32_32x32x16_bf16(VA(0, 0), pB0, o0, 0, 0, 0); o0 = __builtin_amdgcn_mfma_f32_32x32x16_bf16(VA(0, 1), pB1, o0, 0, 0, 0);
    o1 = __builtin_amdgcn_mfma_f32_32x32x16_bf16(VA(1, 0), pB0, o1, 0, 0, 0); o1 = __builtin_amdgcn_mfma_f32_32x32x16_bf16(VA(1, 1), pB1, o1, 0, 0, 0);
#undef VA
}
__device__ __forceinline__ void attn_tile(const bf16* Q, const bf16* KS, const bf16* VT, const bf16* GS, bf16* MIX, int b, int h, int qt, int lane) {
    const int r32 = lane & 31, hi = lane >> 5, t0 = qt * 32; const size_t rowb = (size_t)b * SEQ;
    const size_t bh = (size_t)b * 16 + h;
    const bf16* vt0 = VT + (bh * 256 * 64 + r32) * 32 + 4 * hi;
    const bf16* kp0 = KS + (bh * 8192 + r32) * 64 + hi * 8;
    bf16x8 qf[4]; AttSet A, B;
    { const bf16* qp = Q + (bh * 8192 + t0 + r32) * 64 + hi * 8; ALD16(qf[0], qp, 0); ALD16(qf[1], qp, 32); ALD16(qf[2], qp, 64); ALD16(qf[3], qp, 96); }
    ATT_ISSUE(A, qt * 32);
    ATT_ISSUE(B, (qt > 0 ? qt - 1 : 0) * 32);
    asm volatile("s_waitcnt vmcnt(12)" : "+v"(qf[0]), "+v"(qf[1]), "+v"(qf[2]), "+v"(qf[3]));
    ATT_WAIT(A, 12);
    f32x16 o0 = {}, o1 = {}; float R = 0.f;
    attn_block<true>(A, qf, o0, o1, R, r32, hi);
    for (int kb = qt - 1; kb >= 0; ) {
        ATT_ISSUE(A, (kb > 0 ? kb - 1 : 0) * 32); ATT_WAIT(B, 12);
        attn_block<false>(B, qf, o0, o1, R, r32, hi);
        if (__all(R < SB_CUT)) break;
        if (--kb < 0) break;
        ATT_ISSUE(B, (kb > 0 ? kb - 1 : 0) * 32); ATT_WAIT(A, 12);
        attn_block<false>(A, qf, o0, o1, R, r32, hi);
        if (__all(R < SB_CUT)) break;
        --kb;
    }
    ATT_WAIT(A, 0); ATT_WAIT(B, 0);
    const size_t row = rowb + t0 + r32;
#pragma unroll
    for (int dt = 0; dt < 2; ++dt)
#pragma unroll
        for (int g = 0; g < 4; ++g) { const int d = dt * 32 + 8 * g + 4 * hi; const u32x2 gw = *(const GAS u32x2*)(GS + (bh * 8192 + t0 + r32) * 64 + d);
            float gv[4] = {bflo(gw.x), bfhi(gw.x), bflo(gw.y), bfhi(gw.y)}; float ov[4];
#pragma unroll
            for (int e = 0; e < 4; ++e) { const float o = dt ? o1[4 * g + e] : o0[4 * g + e]; ov[e] = o * gv[e] * __builtin_amdgcn_rcpf(1.0f + __builtin_amdgcn_exp2f(-1.4426950408889634f * gv[e])); }
            u32x2 st; st.x = pk2(ov[0], ov[1]); st.y = pk2(ov[2], ov[3]); *(GAS u32x2*)(MIX + row * 2048 + 1024 + h * 64 + d) = st; }
}
#undef ALD16
#undef ALD8
#undef ATT_ISSUE
#undef ATT_WAIT
__device__ __forceinline__ void p2_attention(Frame& F, unsigned char* ws, int wg0) {
    const bf16 *Q = (const bf16*)(ws + WS_Q), *KS = (const bf16*)(ws + WS_KS), *VT = (const bf16*)(ws + WS_VT), *GS = (const bf16*)(ws + WS_GS); bf16* MIX = (bf16*)(ws + WS_MIX);
    if ((int)blockIdx.x < wg0) return;
    const int gw = ((int)blockIdx.x - wg0) * NWAVES + F.wave, NGW = (F.G - wg0) * NWAVES;
    for (int u = gw; u < BATCH * NH * (SEQ / 32); u += NGW) { const int qt = u & 255, bh = u >> 8; attn_tile(Q, KS, VT, GS, MIX, bh >> 4, bh & 15, qt, F.lane); }
}

struct PreRegs { v4u rc, rp, kc, kp, vc, vp, lc0, lc1, lp0, lp1; f32x4 wu0, wu1, au0, au1; };

__device__ __forceinline__ void p3a_prepass(Frame& F, const In& I, unsigned char* ws) {
    const int tid = F.tid, lane = F.lane, wave = F.wave;
    LAS unsigned char* L = F.lds + RING_OFF;
#define LBUF(i) (L + (i) * MATB)
    const bf16 *Rb = (const bf16*)(ws + WS_R), *Kb = (const bf16*)(ws + WS_K), *Vb = (const bf16*)(ws + WS_V), *LORA = (const bf16*)(ws + WS_LORA);
    bf16* NCT = (bf16*)(ws + WS_NCT); bf16* MCT = (bf16*)(ws + WS_MCT); bf16* QC = (bf16*)(ws + WS_QC); bf16* YLOC = (bf16*)(ws + WS_YLOC); float* BON = (float*)(ws + WS_BON);
    const int st = tid >> 3, k8 = (tid & 7) * 8;
    const int m0 = (wave & 3) * 16, nb = (wave >> 2) * 32;
    const int tn = lane & 15, tq = lane >> 4;
    auto LOAD = [&](int unit, PreRegs& g) {
        const int bh = unit >> 7, c = unit & 127, b = bh >> 4, h = bh & 15; const int t = c * 64 + st; const size_t row = (size_t)b * SEQ + t; const size_t o = row * 1024 + h * 64 + k8;
        g.rc = *(const GAS v4u*)(Rb + o); g.kc = *(const GAS v4u*)(Kb + o); g.vc = *(const GAS v4u*)(Vb + o);
        const size_t lo = row * 256 + 2 * k8;
        g.lc0 = *(const GAS v4u*)(LORA + lo); g.lc1 = *(const GAS v4u*)(LORA + lo + 8);
        if (t > 0) { g.rp = *(const GAS v4u*)(Rb + o - 1024); g.kp = *(const GAS v4u*)(Kb + o - 1024); g.vp = *(const GAS v4u*)(Vb + o - 1024); g.lp0 = *(const GAS v4u*)(LORA + lo - 256); g.lp1 = *(const GAS v4u*)(LORA + lo - 256 + 8); }
        else { g.rp = (v4u){0u, 0u, 0u, 0u}; g.kp = g.rp; g.vp = g.rp; g.lp0 = g.rp; g.lp1 = g.rp; }
        const size_t wo = (size_t)st * 1024 + h * 64 + k8;
        g.wu0 = *(const GAS f32x4*)(I.w_up + wo); g.wu1 = *(const GAS f32x4*)(I.w_up + wo + 4); g.au0 = *(const GAS f32x4*)(I.a_up + wo); g.au1 = *(const GAS f32x4*)(I.a_up + wo + 4);
    };
    PreRegs g;
    const int per = 4096 / F.G;
    const int nmine = per + ((4096 - per * F.G) > F.vcu ? 1 : 0);
    auto UNIT = [&](int ui) { return ui < per ? F.vcu * per + ui : per * F.G + F.vcu; };
    if (nmine > 0) LOAD(UNIT(0), g);
    const LAS float* CT = (const LAS float*)(L + L_CT); int cur_h = -1;
    for (int ui = 0; ui < nmine; ++ui) {
        const int unit = UNIT(ui);
        const int bh = unit >> 7, c = unit & 127, b = bh >> 4, h = bh & 15; const size_t row0 = (size_t)b * SEQ + c * 64; const int ch0 = h * 64;
        if (h != cur_h) { cur_h = h; LAS float* ctw = (LAS float*)(L + L_CT);
            for (int e = tid; e < 640; e += NWAVES * 64) { float v;
                if (e < 384) { const int a_ = e >> 6, cc = ch0 + (e & 63); v = a_ == 0 ? I.mu[cc] : a_ == 1 ? I.mu[1024 + cc] : a_ == 2 ? I.mu[2048 + cc] : a_ == 3 ? I.k_k[cc] : a_ == 4 ? I.k_a[cc] : I.r_k[cc]; }
                else if (e < 512) v = I.mu[3072 + (e - 384)]; else if (e < 576) v = I.w0[ch0 + (e - 512)]; else v = I.a0[ch0 + (e - 576)];
                ctw[e] = v; }
            PBAR(); }
        { const unsigned lcw[8] = {g.lc0.x, g.lc0.y, g.lc0.z, g.lc0.w, g.lc1.x, g.lc1.y, g.lc1.z, g.lc1.w}, lpw[8] = {g.lp0.x, g.lp0.y, g.lp0.z, g.lp0.w, g.lp1.x, g.lp1.y, g.lp1.z, g.lp1.w};
          const int j0 = 2 * k8; const bool isw = j0 < 64; float lv[16];
#pragma unroll
          for (int e = 0; e < 16; ++e) { const float cur = (e & 1) ? bfhi(lcw[e >> 1]) : bflo(lcw[e >> 1]), prev = (e & 1) ? bfhi(lpw[e >> 1]) : bflo(lpw[e >> 1]);
              const float sv = cur + (prev - cur) * CT[384 + j0 + e]; const float e2 = __expf(2.0f * sv); lv[e] = isw ? (1.0f - 2.0f * __builtin_amdgcn_rcpf(e2 + 1.0f)) : sv; }
          v4u w0_, w1_; w0_.x = pk2(lv[0], lv[1]); w0_.y = pk2(lv[2], lv[3]); w0_.z = pk2(lv[4], lv[5]); w0_.w = pk2(lv[6], lv[7]); w1_.x = pk2(lv[8], lv[9]); w1_.y = pk2(lv[10], lv[11]); w1_.z = pk2(lv[12], lv[13]); w1_.w = pk2(lv[14], lv[15]);
          LAS unsigned char* dst = isw ? LBUF(LB_LA) : LBUF(LB_AUK); const int jc = isw ? j0 : j0 - 64;
          *(LAS v4u*)(dst + (st * PT + jc) * 2) = w0_; *(LAS v4u*)(dst + (st * PT + jc + 8) * 2) = w1_;
          v4u u_; u_.x = pk2(g.wu0.x, g.wu0.y); u_.y = pk2(g.wu0.z, g.wu0.w); u_.z = pk2(g.wu1.x, g.wu1.y); u_.w = pk2(g.wu1.z, g.wu1.w); *(LAS v4u*)(LBUF(LB_ARB) + (st * PT + k8) * 2) = u_;
          u_.x = pk2(g.au0.x, g.au0.y); u_.y = pk2(g.au0.z, g.au0.w); u_.z = pk2(g.au1.x, g.au1.y); u_.w = pk2(g.au1.z, g.au1.w); *(LAS v4u*)(LBUF(LB_ARK) + (st * PT + k8) * 2) = u_; }
        PBAR();
#pragma unroll
        for (int ti = 0; ti < 2; ++ti) { const int n0 = nb + 16 * ti; f32x4 xw = {0.f, 0.f, 0.f, 0.f}, xa = xw;
#pragma unroll
            for (int ks = 0; ks < 2; ++ks) { xw = MMA16(ldA(LBUF(LB_LA), m0, ks, lane), ldTr(LBUF(LB_ARB), n0, ks, lane), xw); xa = MMA16(ldA(LBUF(LB_AUK), m0, ks, lane), ldTr(LBUF(LB_ARK), n0, ks, lane), xa); }
            const float w0c = CT[512 + n0 + tn], a0c = CT[576 + n0 + tn]; f32x4 av;
#pragma unroll
            for (int r = 0; r < 4; ++r) { *(LAS float*)(L + L_G + ((m0 + 4 * tq + r) * 64 + n0 + tn) * 4) = -0.60653065971263342f * __builtin_amdgcn_rcpf(1.0f + __expf(-(xw[r] + w0c))); av[r] = __builtin_amdgcn_rcpf(1.0f + __expf(-(xa[r] + a0c))); }
            stRM(LBUF(LB_PA), m0, n0, av, lane); }
        PBAR();
        float rs[8], kt[8], kk[8], bb[8], vs[8], lw[8];
        { const unsigned rcw[4] = {g.rc.x, g.rc.y, g.rc.z, g.rc.w}, rpw[4] = {g.rp.x, g.rp.y, g.rp.z, g.rp.w}, kcw[4] = {g.kc.x, g.kc.y, g.kc.z, g.kc.w}, kpw[4] = {g.kp.x, g.kp.y, g.kp.z, g.kp.w};
          const unsigned vcw[4] = {g.vc.x, g.vc.y, g.vc.z, g.vc.w}, vpw[4] = {g.vp.x, g.vp.y, g.vp.z, g.vp.w};
          const v4u aw = *(const LAS v4u*)(LBUF(LB_PA) + (st * PT + k8) * 2); const unsigned acw[4] = {aw.x, aw.y, aw.z, aw.w};
          const f32x4 l0 = *(const LAS f32x4*)(L + L_G + (st * 64 + k8) * 4), l1 = *(const LAS f32x4*)(L + L_G + (st * 64 + k8 + 4) * 4);
          float ss = 0.f, bon = 0.f; float av[8], ks[8];
#pragma unroll
          for (int e = 0; e < 8; ++e) { const int cch = k8 + e; const int w2 = e >> 1; const bool hi = e & 1;
              const float rc = hi ? bfhi(rcw[w2]) : bflo(rcw[w2]), rp = hi ? bfhi(rpw[w2]) : bflo(rpw[w2]), kc = hi ? bfhi(kcw[w2]) : bflo(kcw[w2]), kp = hi ? bfhi(kpw[w2]) : bflo(kpw[w2]);
              const float vc = hi ? bfhi(vcw[w2]) : bflo(vcw[w2]), vp = hi ? bfhi(vpw[w2]) : bflo(vpw[w2]); av[e] = hi ? bfhi(acw[w2]) : bflo(acw[w2]);
              rs[e] = rc + (rp - rc) * CT[cch]; ks[e] = kc + (kp - kc) * CT[64 + cch]; vs[e] = vc + (vp - vc) * CT[128 + cch];
              kk[e] = ks[e] * CT[192 + cch]; ss += kk[e] * kk[e]; kt[e] = ks[e] * (1.0f + (av[e] - 1.0f) * CT[256 + cch]); bon += rs[e] * kt[e] * CT[320 + cch]; }
          ss = dppadd<0xB1, 0xF>(ss); ss = dppadd<0x4E, 0xF>(ss); ss = dppadd<0x141, 0xF>(ss);
          bon = dppadd<0xB1, 0xF>(bon); bon = dppadd<0x4E, 0xF>(bon); bon = dppadd<0x141, 0xF>(bon);
          const float inv = 1.0f / sqrtf(ss + L2_EPS);
#pragma unroll
          for (int e = 0; e < 8; ++e) { kk[e] *= inv; bb[e] = av[e] * kk[e]; }
          lw[0] = l0.x; lw[1] = l0.y; lw[2] = l0.z; lw[3] = l0.w; lw[4] = l1.x; lw[5] = l1.y; lw[6] = l1.z; lw[7] = l1.w;
          if ((tid & 7) == 0) BON[(row0 + st) * 16 + h] = bon; }
        if (ui + 1 < nmine) LOAD(UNIT(ui + 1), g);
        PBAR();
        { const int k = tid & 63, sg = tid >> 6; LAS float* Gp = (LAS float*)(L + L_G); LAS float* Sg = (LAS float*)(L + L_SEG);
          float v8[8]; float run = 0.f;
#pragma unroll
          for (int i = 0; i < 8; ++i) { run += Gp[(sg * 8 + i) * 64 + k]; v8[i] = run; }
          Sg[sg * 64 + k] = run;
          PBAR();
          float pre = 0.f;
#pragma unroll
          for (int s2 = 0; s2 < 7; ++s2) pre += (s2 < sg) ? Sg[s2 * 64 + k] : 0.f;
#pragma unroll
          for (int i = 0; i < 8; ++i) Gp[(sg * 8 + i) * 64 + k] = v8[i] + pre; }
        PBAR();
        { const LAS float* Gp = (const LAS float*)(L + L_G); float gg[8], gc[8];
          { const f32x4 a0 = *(const LAS f32x4*)(Gp + st * 64 + k8), a1 = *(const LAS f32x4*)(Gp + st * 64 + k8 + 4), c0 = *(const LAS f32x4*)(Gp + 63 * 64 + k8), c1 = *(const LAS f32x4*)(Gp + 63 * 64 + k8 + 4);
            gg[0] = a0.x; gg[1] = a0.y; gg[2] = a0.z; gg[3] = a0.w; gg[4] = a1.x; gg[5] = a1.y; gg[6] = a1.z; gg[7] = a1.w; gc[0] = c0.x; gc[1] = c0.y; gc[2] = c0.z; gc[3] = c0.w; gc[4] = c1.x; gc[5] = c1.y; gc[6] = c1.z; gc[7] = c1.w; }
          float o[7][8];
#pragma unroll
          for (int e = 0; e < 8; ++e) { const float eg = __expf(gg[e]), egm = __expf(gg[e] - lw[e]), ei = __expf(-gg[e]), ed = __expf(gc[e] - gg[e]);
              o[LB_KQ][e] = kk[e] * egm; o[LB_RQ][e] = rs[e] * eg; o[LB_BK][e] = bb[e] * ei; o[LB_KK][e] = kt[e] * ei; o[LB_BD][e] = bb[e] * ed; o[LB_KD][e] = kt[e] * ed; o[LB_V][e] = vs[e]; }
#pragma unroll
          for (int mtx = 0; mtx < 7; ++mtx) { v4u w; w.x = pk2(o[mtx][0], o[mtx][1]); w.y = pk2(o[mtx][2], o[mtx][3]); w.z = pk2(o[mtx][4], o[mtx][5]); w.w = pk2(o[mtx][6], o[mtx][7]);
              *(LAS v4u*)(LBUF(mtx) + (st * PT + k8) * 2) = w; } }
        PBAR();
        f32x4 Pacc[2];
#pragma unroll
        for (int ti = 0; ti < 2; ++ti) { const int n0 = nb + 16 * ti; f32x4 ub = {0.f, 0.f, 0.f, 0.f}, uk = ub, rb = ub, rk = ub;
#pragma unroll
            for (int ks = 0; ks < 2; ++ks) { const bf16x8 aq = ldA(LBUF(LB_KQ), m0, ks, lane), ar = ldA(LBUF(LB_RQ), m0, ks, lane), b1 = ldA(LBUF(LB_BK), n0, ks, lane), b2 = ldA(LBUF(LB_KK), n0, ks, lane);
                ub = MMA16(aq, b1, ub); uk = MMA16(aq, b2, uk); rb = MMA16(ar, b1, rb); rk = MMA16(ar, b2, rk); }
#pragma unroll
            for (int r = 0; r < 4; ++r) { const int t = m0 + 4 * tq + r, j = n0 + tn; if (!(j < t)) { ub[r] = 0.f; uk[r] = 0.f; } if (!(j <= t)) { rb[r] = 0.f; rk[r] = 0.f; } Pacc[ti][r] = (t == j ? 1.0f : 0.0f) - ub[r]; }
            stRM(LBUF(LB_LA), m0, n0, ub, lane); stRM(LBUF(LB_AUK), m0, n0, uk, lane); stRM(LBUF(LB_ARB), m0, n0, rb, lane); stRM(LBUF(LB_ARK), m0, n0, rk, lane); stRM(LBUF(LB_PA), m0, n0, Pacc[ti], lane); }
        PBAR();
#define SQR(dst, src) do { _Pragma("unroll") for (int ti = 0; ti < 2; ++ti) { const int n0 = nb + 16 * ti; f32x4 a_ = {0.f, 0.f, 0.f, 0.f}; \
            _Pragma("unroll") for (int ks = 0; ks < 2; ++ks) a_ = MMA16(ldA(LBUF(src), m0, ks, lane), ldTr(LBUF(src), n0, ks, lane), a_); stRM(LBUF(dst), m0, n0, a_, lane); } } while (0)
#define PUPD(pdst, psrc, lsrc) do { _Pragma("unroll") for (int ti = 0; ti < 2; ++ti) { const int n0 = nb + 16 * ti; \
            _Pragma("unroll") for (int ks = 0; ks < 2; ++ks) Pacc[ti] = MMA16(ldA(LBUF(psrc), m0, ks, lane), ldTr(LBUF(lsrc), n0, ks, lane), Pacc[ti]); stRM(LBUF(pdst), m0, n0, Pacc[ti], lane); } } while (0)
        SQR(LB_LB, LB_LA);
#pragma unroll
        for (int ti = 0; ti < 2; ++ti) { const int n0 = nb + 16 * ti; f32x4 a_ = {0.f, 0.f, 0.f, 0.f};
#pragma unroll
            for (int ks = 0; ks < 2; ++ks) a_ = MMA16(ldA(LBUF(LB_AUK), m0, ks, lane), ldTr(LBUF(LB_V), n0, ks, lane), a_);
            stRM(LBUF(LB_X1), m0, n0, a_, lane); }
        PBAR();
        PUPD(LB_PB, LB_PA, LB_LB); SQR(LB_LA, LB_LB); PBAR();
        PUPD(LB_PA, LB_PB, LB_LA); SQR(LB_LB, LB_LA); PBAR();
        PUPD(LB_PB, LB_PA, LB_LB); SQR(LB_LA, LB_LB); PBAR();
        PUPD(LB_PA, LB_PB, LB_LA); SQR(LB_LB, LB_LA); PBAR();
        PUPD(LB_PB, LB_PA, LB_LB); PBAR();
#undef SQR
#undef PUPD
#pragma unroll
        for (int ti = 0; ti < 2; ++ti) { const int n0 = nb + 16 * ti; f32x4 u_ = {0.f, 0.f, 0.f, 0.f}, w_ = u_;
#pragma unroll
            for (int ks = 0; ks < 2; ++ks) { const bf16x8 at = ldA(LBUF(LB_PB), m0, ks, lane); u_ = MMA16(at, ldTr(LBUF(LB_X1), n0, ks, lane), u_); w_ = MMA16(at, ldTr(LBUF(LB_KQ), n0, ks, lane), w_); }
            u_ = -u_; stRM(LBUF(LB_PA), m0, n0, u_, lane); stRM(LBUF(LB_LB), m0, n0, w_, lane); }
        PBAR();
        const size_t ub16 = (size_t)unit * 4096;
#pragma unroll
        for (int ti = 0; ti < 2; ++ti) { const int n0 = nb + 16 * ti;
            f32x4 qa = {0.f, 0.f, 0.f, 0.f}, ya = qa, ma = qa, na = qa;
#pragma unroll
            for (int ks = 0; ks < 2; ++ks) { const bf16x8 wq = ldTr(LBUF(LB_LB), m0, ks, lane), arb = ldA(LBUF(LB_ARB), n0, ks, lane), u0 = ldTr(LBUF(LB_PA), m0, ks, lane), vv = ldTr(LBUF(LB_V), m0, ks, lane), ark = ldA(LBUF(LB_ARK), n0, ks, lane);
                qa = MMA16(wq, arb, qa); ya = MMA16(u0, arb, ya); ya = MMA16(vv, ark, ya);
                const bf16x8 bdn = ldTr(LBUF(LB_BD), n0, ks, lane), bdm = ldTr(LBUF(LB_BD), m0, ks, lane), kdm = ldTr(LBUF(LB_KD), m0, ks, lane), u0n = ldTr(LBUF(LB_PA), n0, ks, lane), vn = ldTr(LBUF(LB_V), n0, ks, lane);
                ma = MMA16(wq, bdn, ma); na = MMA16(bdm, u0n, na); na = MMA16(kdm, vn, na); }
            { const u32x2 rq = *(const LAS u32x2*)(LBUF(LB_RQ) + ((n0 + tn) * PT + m0 + 4 * tq) * 2);
              u32x2 qo; qo.x = pk2(bflo(rq.x) - qa[0], bfhi(rq.x) - qa[1]); qo.y = pk2(bflo(rq.y) - qa[2], bfhi(rq.y) - qa[3]);
              const size_t o = (row0 + n0 + tn) * 1024 + ch0 + m0 + 4 * tq;
              *(GAS u32x2*)(QC + o) = qo; u32x2 yo; yo.x = pk2(ya[0], ya[1]); yo.y = pk2(ya[2], ya[3]); *(GAS u32x2*)(YLOC + o) = yo; }
            { const LAS float* Gp = (const LAS float*)(L + L_G); float mv[4];
#pragma unroll
              for (int r = 0; r < 4; ++r) { const int k = m0 + 4 * tq + r, kp = n0 + tn; mv[r] = (k == kp ? __expf(Gp[63 * 64 + k]) : 0.f) - ma[r]; }
              u32x2 mo; mo.x = pk2(mv[0], mv[1]); mo.y = pk2(mv[2], mv[3]);
              *(GAS u32x2*)(MCT + ub16 + (size_t)(n0 + tn) * 64 + m0 + 8 * (tq & 1) + 4 * (tq >> 1)) = mo; }
            { u32x2 no; no.x = pk2(na[0], na[1]); no.y = pk2(na[2], na[3]); *(GAS u32x2*)(NCT + ub16 + (size_t)(n0 + tn) * 64 + m0 + 4 * tq) = no; } }
        PBAR();
    }
#undef LBUF
}

constexpr int ST_MROW = 144, ST_NROW = 136, ST_SLOT = 64 * ST_MROW + 32 * ST_NROW;
static_assert(7 * ST_SLOT <= LDSCTL_OFF, "state ring");
__device__ __forceinline__ void p3b_state(Frame& F, unsigned char* ws) {
    const int lane = F.lane, wave = F.wave;
    if (blockIdx.x >= 64) return;
    const int bh = blockIdx.x >> 1, vh = blockIdx.x & 1, r32 = lane & 31, hi = lane >> 5;
    const bf16* NCT = (const bf16*)(ws + WS_NCT); const bf16* MCT = (const bf16*)(ws + WS_MCT); bf16* SC = (bf16*)(ws + WS_SC);
    LAS unsigned char* L = F.lds + RING_OFF;
    v4u ld[12];
    auto GLOAD = [&](int c) {
        const size_t ub = (size_t)(bh * 128 + c) * 4096;
#pragma unroll
        for (int i = 0; i < 8; ++i) ld[i] = *(const GAS v4u*)(MCT + ub + (size_t)(i * 64 + lane) * 8);
#pragma unroll
        for (int i = 0; i < 4; ++i) ld[8 + i] = *(const GAS v4u*)(NCT + ub + (size_t)vh * 2048 + (size_t)(i * 64 + lane) * 8);
    };
    auto LWRITE = [&](int slot) {
        LAS unsigned char* sb = L + slot * ST_SLOT;
#pragma unroll
        for (int i = 0; i < 8; ++i) { const int p = i * 64 + lane; *(LAS v4u*)(sb + (p >> 3) * ST_MROW + (p & 7) * 16) = ld[i]; }
#pragma unroll
        for (int i = 0; i < 4; ++i) { const int p = i * 64 + lane; *(LAS v4u*)(sb + 64 * ST_MROW + (p >> 3) * ST_NROW + (p & 7) * 16) = ld[8 + i]; }
    };
    __syncthreads();
    if (wave > 0) {
        const int k = wave - 1;
        GLOAD(k); LWRITE(k);
        PBAR();
        for (int c = 0; c < 128; ++c) {
            const int ph = c % 7;
            if (ph == k && c + 7 < 128) GLOAD(c + 7);
            if (ph == (k + 4) % 7 && c >= 4 && c + 3 < 128) { asm volatile("s_waitcnt vmcnt(0)" ::: "memory"); LWRITE(k); }
            PBAR();
        }
        return;
    }
    f32x16 T0 = {}, T1 = {};
    PBAR();
    for (int c = 0; c < 128; ++c) {
        const LAS unsigned char* sb = L + (c % 7) * ST_SLOT;
        bf16x8 mf[2][2][2]; f32x16 a0, a1;
#pragma unroll
        for (int i = 0; i < 2; ++i)
#pragma unroll
            for (int j = 0; j < 2; ++j)
#pragma unroll
                for (int s2 = 0; s2 < 2; ++s2) mf[i][j][s2] = *(const LAS bf16x8*)(sb + (32 * i + r32) * ST_MROW + (16 * (2 * j + s2) + 8 * hi) * 2);
#pragma unroll
        for (int gq = 0; gq < 4; ++gq) { const LAS unsigned char* np_ = sb + 64 * ST_MROW + r32 * ST_NROW + (8 * gq + 4 * hi) * 2;
            const u32x2 x0 = *(const LAS u32x2*)np_, x1 = *(const LAS u32x2*)(np_ + 64);
            a0[4 * gq] = bflo(x0.x); a0[4 * gq + 1] = bfhi(x0.x); a0[4 * gq + 2] = bflo(x0.y); a0[4 * gq + 3] = bfhi(x0.y);
            a1[4 * gq] = bflo(x1.x); a1[4 * gq + 1] = bfhi(x1.x); a1[4 * gq + 2] = bflo(x1.y); a1[4 * gq + 3] = bfhi(x1.y); }
        u32x4 tb[2][2];
#pragma unroll
        for (int s2 = 0; s2 < 2; ++s2) { tb[0][s2].x = pk2(T0[8 * s2], T0[8 * s2 + 1]); tb[0][s2].y = pk2(T0[8 * s2 + 2], T0[8 * s2 + 3]); tb[0][s2].z = pk2(T0[8 * s2 + 4], T0[8 * s2 + 5]); tb[0][s2].w = pk2(T0[8 * s2 + 6], T0[8 * s2 + 7]);
            tb[1][s2].x = pk2(T1[8 * s2], T1[8 * s2 + 1]); tb[1][s2].y = pk2(T1[8 * s2 + 2], T1[8 * s2 + 3]); tb[1][s2].z = pk2(T1[8 * s2 + 4], T1[8 * s2 + 5]); tb[1][s2].w = pk2(T1[8 * s2 + 6], T1[8 * s2 + 7]); }
        { bf16* sp = SC + (size_t)(bh * 128 + c) * 4096 + (size_t)(vh * 32 + r32) * 64 + 4 * hi;
#pragma unroll
          for (int j = 0; j < 2; ++j)
#pragma unroll
              for (int s2 = 0; s2 < 2; ++s2) { *(GAS u32x2*)(sp + 32 * j + 16 * s2) = (u32x2){tb[j][s2].x, tb[j][s2].y}; *(GAS u32x2*)(sp + 32 * j + 16 * s2 + 8) = (u32x2){tb[j][s2].z, tb[j][s2].w}; } }
#pragma unroll
        for (int j = 0; j < 2; ++j)
#pragma unroll
            for (int s2 = 0; s2 < 2; ++s2) { const bf16x8 bfr = __builtin_bit_cast(bf16x8, tb[j][s2]);
                a0 = __builtin_amdgcn_mfma_f32_32x32x16_bf16(mf[0][j][s2], bfr, a0, 0, 0, 0); a1 = __builtin_amdgcn_mfma_f32_32x32x16_bf16(mf[1][j][s2], bfr, a1, 0, 0, 0); }
        T0 = a0; T1 = a1;
        PBAR();
    }
}

__device__ __forceinline__ void p4_post(Frame& F, const In& I, unsigned char* ws) {
    const int lane = F.lane, tn = lane & 15, tq = lane >> 4;
    const bf16 *SC = (const bf16*)(ws + WS_SC), *QC = (const bf16*)(ws + WS_QC), *YLOC = (const bf16*)(ws + WS_YLOC), *Vb = (const bf16*)(ws + WS_V), *Gb = (const bf16*)(ws + WS_G); const float* BON = (const float*)(ws + WS_BON);
    bf16* MIX = (bf16*)(ws + WS_MIX);
    const int gw = F.vcu * NWAVES + F.wave, NGW = F.G * NWAVES;
    for (int it = gw; it < 4096 * 4; it += NGW) {
        const int unit = it >> 2, n0 = (it & 3) * 16, bh = unit >> 7, c = unit & 127, b = bh >> 4, h = bh & 15; const size_t row = (size_t)b * SEQ + c * 64 + n0 + tn; const int ch0 = h * 64;
        const bf16* sc = SC + (size_t)unit * 4096;
        f32x4 acc[4] = {{0.f, 0.f, 0.f, 0.f}, {0.f, 0.f, 0.f, 0.f}, {0.f, 0.f, 0.f, 0.f}, {0.f, 0.f, 0.f, 0.f}};
#pragma unroll
        for (int ks = 0; ks < 2; ++ks) { const bf16x8 bq = *(const GAS bf16x8*)(QC + row * 1024 + ch0 + 32 * ks + 8 * tq);
#pragma unroll
            for (int mt = 0; mt < 4; ++mt) { const bf16x8 as = *(const GAS bf16x8*)(sc + (size_t)(16 * mt + tn) * 64 + 32 * ks + 8 * tq); acc[mt] = MMA16(as, bq, acc[mt]); } }
        float y[4][4]; float s = 0.f;
#pragma unroll
        for (int mt = 0; mt < 4; ++mt) { const u32x2 yl = *(const GAS u32x2*)(YLOC + row * 1024 + ch0 + 16 * mt + 4 * tq);
            y[mt][0] = acc[mt][0] + bflo(yl.x); y[mt][1] = acc[mt][1] + bfhi(yl.x); y[mt][2] = acc[mt][2] + bflo(yl.y); y[mt][3] = acc[mt][3] + bfhi(yl.y); s += (y[mt][0] + y[mt][1]) + (y[mt][2] + y[mt][3]); }
        s += __shfl_xor(s, 16); s += __shfl_xor(s, 32);
        const float mean = s * (1.0f / 64.0f); float q = 0.f;
#pragma unroll
        for (int mt = 0; mt < 4; ++mt)
#pragma unroll
            for (int r = 0; r < 4; ++r) { y[mt][r] -= mean; q += y[mt][r] * y[mt][r]; }
        q += __shfl_xor(q, 16); q += __shfl_xor(q, 32);
        const float rstd = 1.0f / sqrtf(q * (1.0f / 64.0f) + LNX_EPS);
        const float bon = BON[row * 16 + h]; const bool first = (c == 0) && (n0 + tn == 0);
#pragma unroll
        for (int mt = 0; mt < 4; ++mt) { const int cc = ch0 + 16 * mt + 4 * tq; const size_t o = row * 1024 + cc;
            const f32x4 lw = *(const GAS f32x4*)(I.lnx_w + cc), lb = *(const GAS f32x4*)(I.lnx_b + cc), mu = *(const GAS f32x4*)(I.mu + 2048 + cc);
            const u32x2 vc = *(const GAS u32x2*)(Vb + o), gg = *(const GAS u32x2*)(Gb + o); u32x2 vp = {0u, 0u}; if (!first) vp = *(const GAS u32x2*)(Vb + o - 1024);
            const float vcf[4] = {bflo(vc.x), bfhi(vc.x), bflo(vc.y), bfhi(vc.y)}, vpf[4] = {bflo(vp.x), bfhi(vp.x), bflo(vp.y), bfhi(vp.y)}, gf[4] = {bflo(gg.x), bfhi(gg.x), bflo(gg.y), bfhi(gg.y)};
            float ov[4];
#pragma unroll
            for (int r = 0; r < 4; ++r) { const float vsft = vcf[r] + (vpf[r] - vcf[r]) * mu[r]; ov[r] = (y[mt][r] * rstd * lw[r] + lb[r] + bon * vsft) * (gf[r] / (1.0f + __expf(-gf[r]))); }
            u32x2 st; st.x = pk2(ov[0], ov[1]); st.y = pk2(ov[2], ov[3]); *(GAS u32x2*)(MIX + row * 2048 + cc) = st; }
    }
}

__device__ __forceinline__ void p6_rows(Frame& F, const In& I, unsigned char* ws) {
    float* out = (float*)(ws + WS_MIXOUT);
    const float *MIXOUT = (const float*)(ws + WS_MIXOUT), *PLERAW = (const float*)(ws + WS_PLERAW); bf16 *H1B = (bf16*)(ws + WS_H1B), *PLEN = (bf16*)(ws + WS_PLEN);
    const int gw = F.vcu * NWAVES + F.wave, NGW = F.G * NWAVES, lane = F.lane;
    for (int m = gw; m < M; m += NGW) {
        { const GAS f32x4* mr = (const GAS f32x4*)(MIXOUT + (size_t)m * DM) + lane; const GAS f32x4* xr = (const GAS f32x4*)(I.x + (size_t)m * DM) + lane; const GAS f32x4* gr = (const GAS f32x4*)I.g_post + lane;
          f32x4 v[8]; float s = 0.f;
#pragma unroll
          for (int j = 0; j < 8; ++j) { v[j] = mr[64 * j]; s += (v[j].x * v[j].x + v[j].y * v[j].y) + (v[j].z * v[j].z + v[j].w * v[j].w); }
          const float rinv = 1.0f / sqrtf(wave_allsum(s) * (1.0f / DM) + RMS_EPS);
          GAS f32x4* orow = (GAS f32x4*)(out + (size_t)m * DM) + lane; GAS u32x2* hb = (GAS u32x2*)(H1B + (size_t)m * DM) + lane;
#pragma unroll
          for (int j = 0; j < 8; ++j) { const f32x4 g = gr[64 * j], x = xr[64 * j]; f32x4 hh; hh.x = x.x + v[j].x * rinv * g.x; hh.y = x.y + v[j].y * rinv * g.y; hh.z = x.z + v[j].z * rinv * g.z; hh.w = x.w + v[j].w * rinv * g.w;
              orow[64 * j] = hh; u32x2 o; o.x = pk2(hh.x, hh.y); o.y = pk2(hh.z, hh.w); hb[64 * j] = o; } }
        { const GAS f32x4* pr = (const GAS f32x4*)(PLERAW + (size_t)m * DM) + lane; const GAS f32x4* gr = (const GAS f32x4*)I.g_ple + lane;
          f32x4 v[8]; float s = 0.f;
#pragma unroll
          for (int j = 0; j < 8; ++j) { v[j] = pr[64 * j]; s += (v[j].x * v[j].x + v[j].y * v[j].y) + (v[j].z * v[j].z + v[j].w * v[j].w); }
          const float rinv = 1.0f / sqrtf(wave_allsum(s) * (1.0f / DM) + RMS_EPS);
          GAS u32x2* pn = (GAS u32x2*)(PLEN + (size_t)m * DM) + lane;
#pragma unroll
          for (int j = 0; j < 8; ++j) { const f32x4 g = gr[64 * j]; u32x2 o; o.x = pk2(v[j].x * rinv * g.x, v[j].y * rinv * g.y); o.y = pk2(v[j].z * rinv * g.z, v[j].w * rinv * g.w); pn[64 * j] = o; } }
    }
}

struct Args { const float* in[19]; float* out; unsigned char* ws; int ph_lo, ph_hi, li, pad; };
__global__ void __launch_bounds__(NWAVES * 64, 2) hymba_fwd(Args args) {
    extern __shared__ __attribute__((aligned(16))) unsigned char lds[];
    Frame F;
    F.lds = (LAS unsigned char*)lds; F.MISC = (volatile LAS unsigned*)(F.lds + MISC_OFF);
    F.tid = threadIdx.x; F.lane = F.tid & 63; F.wave = __builtin_amdgcn_readfirstlane(F.tid >> 6);
    F.G = gridDim.x; { const int bx = blockIdx.x; F.vcu = (F.G % 8 == 0) ? (bx % 8) * (F.G / 8) + bx / 8 : bx; }
    unsigned char* ws = args.ws; F.ctl = (gu32*)(ws + WS_CTL);
    In I; I.x = args.in[0]; I.p = args.in[1]; I.g_pre = args.in[2]; I.w_in = args.in[3]; I.mu = args.in[4]; I.w0 = args.in[5]; I.w_up = args.in[6]; I.a0 = args.in[7]; I.a_up = args.in[8];
    I.k_k = args.in[9]; I.k_a = args.in[10]; I.r_k = args.in[11]; I.lnx_w = args.in[12]; I.lnx_b = args.in[13]; I.w_out = args.in[14]; I.g_post = args.in[15]; I.w_ple = args.in[16]; I.w_plg = args.in[17]; I.g_ple = args.in[18];
    for (int u = F.tid; u < (LDS_BYTES - LDSCTL_OFF) / 4; u += NWAVES * 64) ((LAS unsigned*)(F.lds + LDSCTL_OFF))[u] = 0u;
    __syncthreads();
    const bool multi = (args.ph_hi - args.ph_lo) > 1;
    XcdBarrier bar; bar.bar = (unsigned*)(F.ctl + CW_BAR); bar.x = 0; bar.st = nullptr;
    if (multi) bar = xcd_barrier_post((unsigned*)(F.ctl + CW_BAR), F.MISC + 8);
    const int lo = args.ph_lo, hi = args.ph_hi;
#define IN(k) (lo <= (k) && (k) < hi)
#define BOTH(k) (IN(k) && IN((k) + 1))
    bf16* Z = (bf16*)(ws + WS_Z);
    if (IN(0)) { p0_prologue(F, I, ws); if (BOTH(0)) xcd_barrier(bar); }
    if (IN(1)) {
        pg8::Gemm g{Z, Z, M, 8448, DM}; pg8::SchedIn S{F.G, (int)blockIdx.x};
        pg8::EpiIn E{ws, WS_R, WS_Q, WS_LORA, WS_VT};
        pg8::gemm_phase<pg8::EpiIn, pg8::SchedIn, true, true>(F.lds + RING_OFF, g, S, E);
        __syncthreads();
        p1_tail_convert(F, I, ws, (F.G == 256) ? 64 : 0);
        if (BOTH(1)) xcd_barrier(bar);
    }
    if (IN(2)) { p3a_prepass(F, I, ws); if (BOTH(2)) xcd_barrier(bar); }
    if (IN(3)) { p3b_state(F, ws); p2_attention(F, ws, 64); if (BOTH(3)) xcd_barrier(bar); }
    if (IN(4)) { p4_post(F, I, ws); if (BOTH(4)) xcd_barrier(bar); }
    if (IN(5)) {
        { pg8::Gemm g{(const bf16*)(ws + WS_MIX), (const bf16*)(ws + WS_W2T), M, DM, DM}; pg8::StaticOrder S; S.init(M, DM, F.G, (int)blockIdx.x);
          pg8::EpiF32 E{(float*)(ws + WS_MIXOUT), DM};
          pg8::gemm_phase<pg8::EpiF32, pg8::StaticOrder, true, true>(F.lds + RING_OFF, g, S, E); }
        __syncthreads();
        { pg8::Gemm g{(const bf16*)(ws + WS_PB), (const bf16*)(ws + WS_WPT), M, DM, PLE_DIM}; pg8::StaticOrder S; S.init(M, DM, F.G, (int)blockIdx.x);
          pg8::EpiF32 E{(float*)(ws + WS_PLERAW), DM};
          pg8::gemm_phase<pg8::EpiF32, pg8::StaticOrder, true, true>(F.lds + RING_OFF, g, S, E); }
        if (BOTH(5)) xcd_barrier(bar);
    }
    if (IN(6)) { p6_rows(F, I, ws); if (BOTH(6)) xcd_barrier(bar); }
    if (IN(7)) {
        pg8::Gemm g{(const bf16*)(ws + WS_H1B), (const bf16*)(ws + WS_W3T), M, DM, DM}; pg8::StaticOrder S; S.init(M, DM, F.G, (int)blockIdx.x);
        pg8::EpiFinal E{args.out, (const float*)(ws + WS_MIXOUT), (const bf16*)(ws + WS_PLEN), DM};
        pg8::gemm_phase<pg8::EpiFinal, pg8::StaticOrder, true, true>(F.lds + RING_OFF, g, S, E);
    }
#undef IN
#undef BOTH
}

extern "C" void kernel_launch(void* const* d_in, const int* in_sizes, int n_in, void* d_out, int out_size, void* d_ws, size_t ws_size, hipStream_t stream) {
    static int grid = 0;
    if (grid == 0) {
        if (n_in != 19 || in_sizes[0] != M * DM || out_size != M * DM || ws_size < WS_END) { fprintf(stderr, "kernel_launch: unexpected shapes (n_in %d, in0 %d, out %d, ws %zu); nothing launched\n", n_in, n_in > 0 ? in_sizes[0] : -1, out_size, ws_size); grid = -1; return; }
        int dev = 0, cus = 0, per_cu = 0;
        if (hipGetDevice(&dev) != hipSuccess || hipDeviceGetAttribute(&cus, hipDeviceAttributeMultiprocessorCount, dev) != hipSuccess) { grid = -1; return; }
        if (hipFuncSetAttribute((const void*)hymba_fwd, hipFuncAttributeMaxDynamicSharedMemorySize, LDS_BYTES) != hipSuccess) { fprintf(stderr, "kernel_launch: hipFuncSetAttribute failed\n"); grid = -1; return; }
        if (hipOccupancyMaxActiveBlocksPerMultiprocessor(&per_cu, (const void*)hymba_fwd, NWAVES * 64, LDS_BYTES) != hipSuccess || per_cu < 1) { fprintf(stderr, "kernel_launch: occupancy query says %d\n", per_cu); }
        (void)hipGetLastError();
        grid = cus;
    }
    if (grid < 0) return;
    if (hipMemsetAsync((char*)d_ws + WS_CTL, 0, CTL_ZERO_BYTES, stream) != hipSuccess) return;
    Args a{};
    for (int i = 0; i < 19; ++i) a.in[i] = (const float*)d_in[i];
    a.out = (float*)d_out; a.ws = (unsigned char*)d_ws;
    constexpr int NL = MK_N_LAUNCHES;
    for (int li = 0; li < NL; ++li) {
        a.ph_lo = (NL == 1) ? 0 : li; a.ph_hi = (NL == 1) ? N_PHASES : li + 1; a.li = li;
        hipLaunchKernelGGL(hymba_fwd, dim3(grid), dim3(NWAVES * 64), LDS_BYTES, stream, a);
    }
}
```
